# Optimizing an MI355X kernel written in HIP

```python
import jax
import jax.numpy as jnp
from jax import lax
import numpy as np

D_MODEL = 1024
BATCH = 4
SEQ = 8192
DEPTH = 2

GRID_W = 64
CTX_LEN = 256
N_MIXERS = 2
EPS = 1e-6
NA_HEADS = 16
NA_HEAD_DIM = D_MODEL // NA_HEADS
WIN_H = 8
WIN_W = 16
HG_HEADS = 8
HG_EXPAND = 128
HG_FDIM = HG_HEADS * HG_EXPAND
HG_HEAD_V = D_MODEL // HG_HEADS
CHUNK = 64
D_FF = -(-(8 * D_MODEL) // (3 * 256)) * 256
N_NA_LAYERS = (DEPTH + 1) // 2
N_HG_LAYERS = DEPTH // 2

kernel_name = 'hybrid_na_hgrn2_dit_block'


def rms_norm(x, g):
    xf = x.astype(jnp.float32)
    y = xf * lax.rsqrt(jnp.mean(xf * xf, axis=-1, keepdims=True) + EPS)
    return (y * g.astype(jnp.float32)).astype(x.dtype)


def ada_mod(cvec, w, b):
    return jnp.split(jax.nn.silu(cvec) @ w + b, 6, axis=-1)


def swiglu(h, w_in, w_out):
    a, u = jnp.split(h @ w_in, 2, axis=-1)
    return (jax.nn.silu(a) * u) @ w_out


def na_mixer(h_lat, h_ctx, w_qkv, w_o, q_gain, k_gain, rpb, need_ctx_out):
    B, T, _ = h_lat.shape
    rows = T // GRID_W
    kh = min(WIN_H, rows)
    scale = NA_HEAD_DIM ** -0.5

    def qkv(h):
        n = h.shape[1]
        q, k, v = jnp.split(h @ w_qkv, 3, axis=-1)
        q = rms_norm(q.reshape(B, n, NA_HEADS, NA_HEAD_DIM), q_gain) * scale
        k = rms_norm(k.reshape(B, n, NA_HEADS, NA_HEAD_DIM), k_gain)
        return q, k, v.reshape(B, n, NA_HEADS, NA_HEAD_DIM)

    q_c, k_c, v_c = qkv(h_ctx)
    q_l, k_l, v_l = qkv(h_lat)

    out_ctx = None
    if need_ctx_out:
        s = jnp.einsum('bqhd,bkhd->bhqk', q_c, k_c)
        p = jax.nn.softmax(s.astype(jnp.float32), axis=-1).astype(v_c.dtype)
        o_c = jnp.einsum('bhqk,bkhd->bqhd', p, v_c)
        out_ctx = o_c.reshape(B, h_ctx.shape[1], D_MODEL) @ w_o

    grid = lambda a: a.reshape(B, rows, GRID_W, NA_HEADS, NA_HEAD_DIM)
    q_g, k_g, v_g = grid(q_l), grid(k_l), grid(v_l)
    row_start = jnp.clip(jnp.arange(rows) - kh // 2, 0, rows - kh)
    cols = jnp.arange(GRID_W)
    col_idx = jnp.clip(cols - WIN_W // 2, 0, GRID_W - WIN_W)[:, None] + jnp.arange(WIN_W)
    rpb_x = rpb[:, :, col_idx - cols[:, None] + (WIN_W - 1)]
    n_loc = kh * WIN_W

    def row_block(r):
        rs = row_start[r]
        q_row = lax.dynamic_index_in_dim(q_g, r, axis=1, keepdims=False)
        k_win = lax.dynamic_slice_in_dim(k_g, rs, kh, axis=1)[:, :, col_idx]
        v_win = lax.dynamic_slice_in_dim(v_g, rs, kh, axis=1)[:, :, col_idx]
        bias = rpb_x[:, rs + jnp.arange(kh) - r + (WIN_H - 1)]
        s_loc = jnp.einsum('bqhd,bjqwhd->bhqjw', q_row, k_win) + bias.transpose(0, 2, 1, 3)[None]
        s_ctx = jnp.einsum('bqhd,bkhd->bhqk', q_row, k_c)
        s = jnp.concatenate([s_loc.reshape(B, NA_HEADS, GRID_W, n_loc), s_ctx], axis=-1)
        p = jax.nn.softmax(s.astype(jnp.float32), axis=-1).astype(v_win.dtype)
        p_loc = p[..., :n_loc].reshape(B, NA_HEADS, GRID_W, kh, WIN_W)
        return (jnp.einsum('bhqjw,bjqwhd->bqhd', p_loc, v_win)
                + jnp.einsum('bhqk,bkhd->bqhd', p[..., n_loc:], v_c))

    o = lax.map(row_block, jnp.arange(rows))
    out_lat = o.transpose(1, 0, 2, 3, 4).reshape(B, T, D_MODEL) @ w_o
    return out_lat, out_ctx


def forget_gate(f_pre, lb):
    f32 = f_pre.astype(jnp.float32)
    log_f = jnp.logaddexp(jnp.log(lb), jnp.log1p(-lb) + jax.nn.log_sigmoid(f32))
    k = (1.0 - lb) * jax.nn.sigmoid(-f32)
    return k.astype(f_pre.dtype), log_f


def chunked_gated_scan(q, k, v, log_f, s0):
    B, N, H, _ = q.shape
    dv = v.shape[-1]
    nc = N // CHUNK
    chunks = lambda a: a.reshape(B, nc, CHUNK, H, a.shape[-1]).transpose(1, 0, 3, 2, 4)
    lower = jnp.tril(jnp.ones((CHUNK, CHUNK), dtype=bool))[:, :, None]

    def step(S, xs):
        qc, kc, vc, gc = xs
        b = jnp.cumsum(gc, axis=2)
        decay = jnp.exp(jnp.where(lower, b[:, :, :, None, :] - b[:, :, None, :, :], -jnp.inf))
        a = jnp.einsum('bhtk,bhtsk,bhsk->bhts', qc, decay, kc)
        o = jnp.einsum('bhts,bhsv->bhtv', a, vc) + jnp.einsum('bhtk,bhkv->bhtv', qc * jnp.exp(b), S)
        b_end = b[:, :, -1]
        S_new = (jnp.exp(b_end)[..., None] * S
                 + jnp.einsum('bhsk,bhsv->bhkv', kc * jnp.exp(b_end[:, :, None] - b), vc))
        return S_new, o

    s_fin, o = lax.scan(step, s0, (chunks(q), chunks(k), chunks(v), chunks(log_f)))
    return o.transpose(1, 0, 3, 2, 4).reshape(B, N, H, dv).astype(v.dtype), s_fin


def hgrn2_mixer(h_lat, h_ctx, w_in, lb, norm_g, w_o, need_ctx_out):
    B = h_lat.shape[0]
    splits = [HG_FDIM, HG_FDIM + D_MODEL, HG_FDIM + 2 * D_MODEL, 2 * HG_FDIM + 2 * D_MODEL]

    def project(h):
        n = h.shape[1]
        q, v, g, f_fwd, f_bwd = jnp.split(h @ w_in, splits, axis=-1)
        heads = lambda a: a.reshape(B, n, HG_HEADS, -1)
        return heads(jax.nn.silu(q)), heads(v), g, heads(f_fwd), heads(f_bwd)

    def bidirectional(q, v, f_fwd, f_bwd, s_fwd, s_bwd):
        k_f, lf_f = forget_gate(f_fwd, lb[0])
        k_b, lf_b = forget_gate(f_bwd, lb[1])
        o_f, s_fwd = chunked_gated_scan(q, k_f, v, lf_f, s_fwd)
        o_b, s_bwd = chunked_gated_scan(q[:, ::-1], k_b[:, ::-1], v[:, ::-1], lf_b[:, ::-1], s_bwd)
        return o_f + o_b[:, ::-1], s_fwd, s_bwd

    def readout(o, g):
        n = o.shape[1]
        return (rms_norm(o, norm_g).reshape(B, n, D_MODEL) * jax.nn.silu(g)) @ w_o

    zero = jnp.zeros((B, HG_HEADS, HG_EXPAND, HG_HEAD_V), jnp.float32)
    q_c, v_c, g_c, ff_c, fb_c = project(h_ctx)
    o_c, s_fwd, s_bwd = bidirectional(q_c, v_c, ff_c, fb_c, zero, zero)
    q_l, v_l, g_l, ff_l, fb_l = project(h_lat)
    o_l, _, _ = bidirectional(q_l, v_l, ff_l, fb_l, s_fwd, s_bwd)
    out_lat = readout(o_l, g_l)
    out_ctx = readout(o_c, g_c) if need_ctx_out else None
    return out_lat, out_ctx


def setup_inputs(seed: int = 0) -> dict:
    key = jax.random.key(seed)
    ks = jax.random.split(key, 20)
    f32 = jnp.float32

    def w(k, shape, fan_in):
        return jax.random.normal(k, shape, f32) * fan_in ** -0.5

    def gain(k, shape):
        return 1.0 + 0.02 * jax.random.normal(k, shape, f32)

    return {
        'x': jax.random.normal(ks[0], (BATCH, SEQ, D_MODEL), f32),
        'c': jax.random.normal(ks[1], (BATCH, D_MODEL), f32),
        'ctx': jax.random.normal(ks[2], (BATCH, CTX_LEN, D_MODEL), f32),
        'c_ctx': jax.random.normal(ks[3], (D_MODEL,), f32),
        'ada_w': w(ks[4], (DEPTH, D_MODEL, 6 * D_MODEL), D_MODEL),
        'ada_b': 0.02 * jax.random.normal(ks[5], (DEPTH, 6 * D_MODEL), f32),
        'norm1_g': gain(ks[6], (DEPTH, D_MODEL)),
        'norm2_g': gain(ks[7], (DEPTH, D_MODEL)),
        'na_w_qkv': w(ks[8], (N_NA_LAYERS, D_MODEL, 3 * D_MODEL), D_MODEL),
        'na_w_o': w(ks[9], (N_NA_LAYERS, D_MODEL, D_MODEL), D_MODEL),
        'na_q_gain': gain(ks[10], (N_NA_LAYERS, NA_HEAD_DIM)),
        'na_k_gain': gain(ks[11], (N_NA_LAYERS, NA_HEAD_DIM)),
        'na_rpb': 0.2 * jax.random.normal(ks[12], (N_NA_LAYERS, NA_HEADS, 2 * WIN_H - 1, 2 * WIN_W - 1), f32),
        'hg_w_in': w(ks[13], (N_HG_LAYERS, D_MODEL, 3 * HG_FDIM + 2 * D_MODEL), D_MODEL),
        'hg_lower': 0.5 * jax.random.normal(ks[14], (DEPTH, 2, HG_FDIM), f32),
        'hg_norm_g': gain(ks[15], (N_HG_LAYERS, HG_HEAD_V)),
        'hg_w_o': w(ks[16], (N_HG_LAYERS, D_MODEL, D_MODEL), D_MODEL),
        'ffn_w_in': w(ks[17], (DEPTH, D_MODEL, 2 * D_FF), D_MODEL),
        'ffn_w_out': w(ks[18], (DEPTH, D_FF, D_MODEL), D_FF),
    }


def reference(x, c, ctx, c_ctx, ada_w, ada_b, norm1_g, norm2_g, na_w_qkv, na_w_o, na_q_gain,
              na_k_gain, na_rpb, hg_w_in, hg_lower, hg_norm_g, hg_w_o, ffn_w_in, ffn_w_out):
    lbs = jnp.cumsum(jax.nn.softmax(hg_lower.astype(jnp.float32), axis=0), axis=0)
    lbs = (lbs - lbs[:1]).reshape(DEPTH, 2, HG_HEADS, HG_EXPAND)
    x_lat, x_ctx = x, ctx
    for i in range(DEPTH):
        last = i == DEPTH - 1
        j = i // N_MIXERS
        sh1, sc1, g1, sh2, sc2, g2 = [m[:, None, :] for m in ada_mod(c, ada_w[i], ada_b[i])]
        csh1, csc1, cg1, csh2, csc2, cg2 = ada_mod(c_ctx, ada_w[i], ada_b[i])
        h_lat = rms_norm(x_lat, norm1_g[i]) * (1 + sc1) + sh1
        h_ctx = rms_norm(x_ctx, norm1_g[i]) * (1 + csc1) + csh1
        if i % N_MIXERS == 0:
            out_lat, out_ctx = na_mixer(h_lat, h_ctx, na_w_qkv[j], na_w_o[j], na_q_gain[j],
                                        na_k_gain[j], na_rpb[j], not last)
        else:
            out_lat, out_ctx = hgrn2_mixer(h_lat, h_ctx, hg_w_in[j], lbs[i], hg_norm_g[j],
                                           hg_w_o[j], not last)
        x_lat = x_lat + g1 * out_lat
        x_lat = x_lat + g2 * swiglu(rms_norm(x_lat, norm2_g[i]) * (1 + sc2) + sh2, ffn_w_in[i], ffn_w_out[i])
        if not last:
            x_ctx = x_ctx + cg1 * out_ctx
            x_ctx = x_ctx + cg2 * swiglu(rms_norm(x_ctx, norm2_g[i]) * (1 + csc2) + csh2,
                                         ffn_w_in[i], ffn_w_out[i])
    return x_lat
```

```cpp
#include <hip/hip_runtime.h>
#include <cstdint>
#include <cstdio>

constexpr int D = 1024, BATCH = 4, SEQ = 8192, CTX = 256, MLAT = BATCH * SEQ, MCTX = BATCH * CTX, MTOT = MLAT + MCTX;
constexpr int DFF = 2816, NAH = 16, HGH = 8, GW = 64, ROWS = SEQ / GW;
constexpr float EPS = 1e-6f;
typedef unsigned short bf16_t;
typedef unsigned short f16_t;

__device__ __forceinline__ bf16_t f2bf(float f) { unsigned u = __builtin_bit_cast(unsigned, f); return (bf16_t)((u + 0x7fffu + ((u >> 16) & 1u)) >> 16); }
__device__ __forceinline__ float bf2f(bf16_t h) { return __builtin_bit_cast(float, (unsigned)h << 16); }
__device__ __forceinline__ f16_t f2h(float f) { _Float16 h = (_Float16)f; return __builtin_bit_cast(unsigned short, h); }
__device__ __forceinline__ float h2f(f16_t u) { return (float)__builtin_bit_cast(_Float16, u); }
__device__ __forceinline__ float silu_f(float x) { return x / (1.f + __expf(-x)); }
__device__ __forceinline__ float sigmoid_f(float x) { return 1.f / (1.f + __expf(-x)); }
__device__ __forceinline__ int row_slot(int row) { return row < MLAT ? (row >> 13) : 4; }
__device__ __forceinline__ int row_batch(int row) { return row < MLAT ? (row >> 13) : ((row - MLAT) >> 8); }

__global__ void k_mod(const float* c, const float* c_ctx, const float* ada_w, const float* ada_b, float* mod) {
    __shared__ float sv[5][D];
    const int l = blockIdx.y, j = blockIdx.x * 256 + threadIdx.x;
    for (int i = threadIdx.x; i < 5 * D; i += 256) { const int s = i / D, k = i % D; const float v = s < 4 ? c[s * D + k] : c_ctx[k]; sv[s][k] = silu_f(v); }
    __syncthreads();
    float acc[5] = {0.f, 0.f, 0.f, 0.f, 0.f};
    const float* w = ada_w + (size_t)l * D * 6 * D + j;
    for (int k = 0; k < D; ++k) { const float wv = w[(size_t)k * 6 * D];
#pragma unroll
        for (int s = 0; s < 5; ++s) acc[s] += sv[s][k] * wv; }
    const float bv = ada_b[l * 6 * D + j];
#pragma unroll
    for (int s = 0; s < 5; ++s) mod[((size_t)l * 5 + s) * 6 * D + j] = acc[s] + bv;
}
__global__ void k_lbs(const float* hg_lower, float* lb) {
    const int i = blockIdx.x * 256 + threadIdx.x;
    if (i < 2 * D) lb[i] = sigmoid_f(hg_lower[2 * D + i] - hg_lower[i]);
}
__global__ void k_prep(const float* xlat, const float* xctx, const float* g, const float* modl, int sh_idx, int sc_idx, bf16_t* A, int nrows) {
    const int row = blockIdx.x * 4 + (threadIdx.x >> 6), lane = threadIdx.x & 63;
    if (row >= nrows) return;
    const float* xr = row < MLAT ? xlat + (size_t)row * D : xctx + (size_t)(row - MLAT) * D;
    float v[16]; float ss = 0.f;
#pragma unroll
    for (int i = 0; i < 16; ++i) { v[i] = xr[lane + 64 * i]; ss += v[i] * v[i]; }
#pragma unroll
    for (int o = 1; o < 64; o <<= 1) ss += __shfl_xor(ss, o);
    const float rinv = rsqrtf(ss * (1.f / D) + EPS);
    const float* mp = modl + (size_t)row_slot(row) * 6 * D;
#pragma unroll
    for (int i = 0; i < 16; ++i) { const int col = lane + 64 * i;
        const float y = v[i] * rinv * g[col];
        A[(size_t)row * D + col] = f2bf(y * (1.f + mp[sc_idx * D + col]) + mp[sh_idx * D + col]); }
}
enum { MODE_BF16 = 0, MODE_RES = 1, MODE_SWIGLU = 2, MODE_HG = 3 };
struct GemmArgs {
    const bf16_t* A; const float* W; bf16_t* C;
    const float* res_lat; const float* res_ctx; float* out_lat; float* out_ctx; const float* gate;
    const float* lb;
    int lda, ldw, K, N, ldc, pad;
};
template <int MODE> __global__ void __launch_bounds__(256) k_gemm(GemmArgs g) {
    __shared__ float As[16][68]; __shared__ float Bs[16][68]; __shared__ float Bs2[16][68];
    const int tid = threadIdx.x, tx = tid & 15, ty = tid >> 4;
    const int m0 = blockIdx.y * 64, n0 = blockIdx.x * 64;
    float acc[4][4] = {}, acc2[4][4] = {};
    for (int k0 = 0; k0 < g.K; k0 += 16) {
        { const int r = tid >> 2, kk = (tid & 3) * 4; const bf16_t* ap = g.A + (size_t)(m0 + r) * g.lda + k0 + kk;
          const ushort4 a4 = *(const ushort4*)ap; As[kk + 0][r] = bf2f(a4.x); As[kk + 1][r] = bf2f(a4.y); As[kk + 2][r] = bf2f(a4.z); As[kk + 3][r] = bf2f(a4.w); }
        { const int kk = tid >> 4, n4 = (tid & 15) * 4; const float4 b4 = *(const float4*)(g.W + (size_t)(k0 + kk) * g.ldw + n0 + n4);
          Bs[kk][n4] = b4.x; Bs[kk][n4 + 1] = b4.y; Bs[kk][n4 + 2] = b4.z; Bs[kk][n4 + 3] = b4.w;
          if (MODE == MODE_SWIGLU) { const float4 c4 = *(const float4*)(g.W + (size_t)(k0 + kk) * g.ldw + DFF + n0 + n4);
              Bs2[kk][n4] = c4.x; Bs2[kk][n4 + 1] = c4.y; Bs2[kk][n4 + 2] = c4.z; Bs2[kk][n4 + 3] = c4.w; } }
        __syncthreads();
#pragma unroll
        for (int kk = 0; kk < 16; ++kk) {
            float a[4], b[4], b2[4];
#pragma unroll
            for (int i = 0; i < 4; ++i) a[i] = As[kk][ty * 4 + i];
#pragma unroll
            for (int j = 0; j < 4; ++j) { b[j] = Bs[kk][tx * 4 + j]; if (MODE == MODE_SWIGLU) b2[j] = Bs2[kk][tx * 4 + j]; }
#pragma unroll
            for (int i = 0; i < 4; ++i)
#pragma unroll
                for (int j = 0; j < 4; ++j) { acc[i][j] += a[i] * b[j]; if (MODE == MODE_SWIGLU) acc2[i][j] += a[i] * b2[j]; }
        }
        __syncthreads();
    }
#pragma unroll
    for (int i = 0; i < 4; ++i) {
        const int row = m0 + ty * 4 + i;
#pragma unroll
        for (int j = 0; j < 4; ++j) {
            const int col = n0 + tx * 4 + j; const float v = acc[i][j];
            if (MODE == MODE_BF16) g.C[(size_t)row * g.ldc + col] = f2bf(v);
            else if (MODE == MODE_SWIGLU) g.C[(size_t)row * g.ldc + col] = f2bf(silu_f(v) * acc2[i][j]);
            else if (MODE == MODE_RES) {
                const float gt = g.gate[(size_t)row_slot(row) * 6 * D + col];
                const float r = row < MLAT ? g.res_lat[(size_t)row * D + col] : g.res_ctx[(size_t)(row - MLAT) * D + col];
                float* o = row < MLAT ? g.out_lat + (size_t)row * D + col : g.out_ctx + (size_t)(row - MLAT) * D + col;
                *o = r + gt * v;
            } else {
                const int t = col >> 10; unsigned short o;
                if (t == 0 || t == 2) o = f2bf(silu_f(v));
                else if (t == 1) o = f2bf(v);
                else { const float lbv = g.lb[(t - 3) * D + (col & 1023)]; o = f2h((1.f - lbv) * sigmoid_f(-v)); }
                g.C[(size_t)row * g.ldc + col] = o;
            }
        }
    }
}
__global__ void k_qknorm(bf16_t* QKV, const float* qg, const float* kg) {
    const int idx = blockIdx.x * 256 + threadIdx.x;
    if (idx >= MTOT * 32) return;
    const int row = idx >> 5, w = (idx >> 4) & 1, h = idx & 15;
    bf16_t* p = QKV + (size_t)row * 3072 + w * D + h * 64;
    float v[64]; float ss = 0.f;
#pragma unroll
    for (int i = 0; i < 64; ++i) { v[i] = bf2f(p[i]); ss += v[i] * v[i]; }
    const float rinv = rsqrtf(ss * (1.f / 64.f) + EPS) * (w == 0 ? 0.125f : 1.f);
    const float* gg = w == 0 ? qg : kg;
#pragma unroll
    for (int i = 0; i < 64; ++i) p[i] = f2bf(v[i] * rinv * gg[i]);
}
__global__ void __launch_bounds__(64) k_attn(const bf16_t* QKV, const float* rpb, bf16_t* O) {
    const int idx = blockIdx.x * 64 + threadIdx.x;
    if (idx >= MTOT * NAH) return;
    const int h = idx & 15, row = idx >> 4;
    float q[64], o[64]; float m = -INFINITY, l = 0.f;
    { const bf16_t* qp = QKV + (size_t)row * 3072 + h * 64;
#pragma unroll
      for (int i = 0; i < 64; ++i) { q[i] = bf2f(qp[i]); o[i] = 0.f; } }
    const int b = row_batch(row);
    auto visit = [&](int krow, float bias) {
        const bf16_t* kp = QKV + (size_t)krow * 3072 + D + h * 64; const bf16_t* vp = kp + D;
        float s = 0.f;
#pragma unroll
        for (int i = 0; i < 64; ++i) s += q[i] * bf2f(kp[i]);
        s += bias;
        const float mn = fmaxf(m, s), f = __expf(m - mn), p = __expf(s - mn);
        l = l * f + p;
#pragma unroll
        for (int i = 0; i < 64; ++i) o[i] = o[i] * f + p * bf2f(vp[i]);
        m = mn;
    };
    if (row < MLAT) {
        const int t = row & (SEQ - 1), r = t >> 6, c = t & 63;
        int rs = r - 4; rs = rs < 0 ? 0 : (rs > ROWS - 8 ? ROWS - 8 : rs);
        int cs = c - 8; cs = cs < 0 ? 0 : (cs > GW - 16 ? GW - 16 : cs);
        for (int j = 0; j < 8; ++j)
            for (int w = 0; w < 16; ++w) {
                const int kr = rs + j, kc = cs + w;
                visit(b * SEQ + kr * GW + kc, rpb[(h * 15 + (kr - r + 7)) * 31 + (kc - c + 15)]);
            }
    }
    for (int kk = 0; kk < CTX; ++kk) visit(MLAT + b * CTX + kk, 0.f);
    const float rl = 1.f / l;
    bf16_t* op = O + (size_t)row * D + h * 64;
#pragma unroll
    for (int i = 0; i < 64; ++i) op[i] = f2bf(o[i] * rl);
}
__global__ void __launch_bounds__(128) k_hgscan(unsigned short* HGO, const float* norm_g) {
    __shared__ float sq[2][128], sk[2][128], red[2][2];
    const int b = blockIdx.x >> 3, h = blockIdx.x & 7, v = threadIdx.x;
    const int NS = CTX + SEQ;
    const float ng = norm_g[v];
    for (int dir = 0; dir < 2; ++dir) {
        float S[128];
#pragma unroll
        for (int k = 0; k < 128; ++k) S[k] = 0.f;
        auto rowof = [&](int step) { int row; if (step < CTX) { const int j = dir == 0 ? step : CTX - 1 - step; row = MLAT + b * CTX + j; } else { const int t = dir == 0 ? step - CTX : SEQ - 1 - (step - CTX); row = b * SEQ + t; } return row; };
        { const int row = rowof(0); const unsigned short* p = HGO + (size_t)row * 5120 + h * 128;
          sq[0][v] = bf2f(p[v]); sk[0][v] = h2f(p[(3 + dir) * D + v]); }
        __syncthreads();
        for (int step = 0; step < NS; ++step) {
            const int cur = step & 1, row = rowof(step);
            unsigned short* p = HGO + (size_t)row * 5120 + h * 128;
            const float vv = bf2f(p[D + v]);
            if (step + 1 < NS) { const int rn = rowof(step + 1); const unsigned short* pn = HGO + (size_t)rn * 5120 + h * 128;
                sq[cur ^ 1][v] = bf2f(pn[v]); sk[cur ^ 1][v] = h2f(pn[(3 + dir) * D + v]); }
            float o = 0.f;
#pragma unroll
            for (int k = 0; k < 128; ++k) { const float kk = sk[cur][k]; S[k] = (1.f - kk) * S[k] + kk * vv; o += sq[cur][k] * S[k]; }
            if (row < MLAT) {
                if (dir == 0) { p[3 * D + v] = f2bf(o); }
                else {
                    const float ot = o + bf2f(p[3 * D + v]);
                    float ss = ot * ot;
#pragma unroll
                    for (int off = 1; off < 64; off <<= 1) ss += __shfl_xor(ss, off);
                    if ((v & 63) == 0) red[cur][v >> 6] = ss;
                    __syncthreads();
                    const float tot = red[cur][0] + red[cur][1];
                    const float rinv = rsqrtf(tot * (1.f / 128.f) + EPS);
                    const float gv = bf2f(p[2 * D + v]);
                    p[v] = f2bf(ot * rinv * ng * gv);
                }
            }
            __syncthreads();
        }
    }
}

extern "C" void kernel_launch(void* const* d_in, const int* in_sizes, int n_in, void* d_out, int out_size, void* d_ws, size_t ws_size, hipStream_t stream) {
    const float* x = (const float*)d_in[0]; const float* c = (const float*)d_in[1]; const float* ctx = (const float*)d_in[2]; const float* c_ctx = (const float*)d_in[3];
    const float* ada_w = (const float*)d_in[4]; const float* ada_b = (const float*)d_in[5]; const float* norm1_g = (const float*)d_in[6]; const float* norm2_g = (const float*)d_in[7];
    const float* w_qkv = (const float*)d_in[8]; const float* w_o = (const float*)d_in[9]; const float* q_gain = (const float*)d_in[10]; const float* k_gain = (const float*)d_in[11];
    const float* rpb = (const float*)d_in[12]; const float* hg_w_in = (const float*)d_in[13]; const float* hg_lower = (const float*)d_in[14]; const float* hg_norm_g = (const float*)d_in[15];
    const float* hg_w_o = (const float*)d_in[16]; const float* ffn_w_in = (const float*)d_in[17]; const float* ffn_w_out = (const float*)d_in[18];
    float* out = (float*)d_out;
    unsigned char* ws = (unsigned char*)d_ws;
    const size_t MiB = 1u << 20;
    float* mod = (float*)(ws + 0);
    float* lb = (float*)(ws + 1 * MiB);
    float* XCTX = (float*)(ws + 4 * MiB);
    bf16_t* ABUF = (bf16_t*)(ws + 62 * MiB);
    bf16_t* R1 = (bf16_t*)(ws + 128 * MiB);

    k_mod<<<dim3(6 * D / 256, 2), 256, 0, stream>>>(c, c_ctx, ada_w, ada_b, mod);
    k_lbs<<<8, 256, 0, stream>>>(hg_lower, lb);
    const float* mod0 = mod; const float* mod1 = mod + 5 * 6 * D;
    k_prep<<<MTOT / 4, 256, 0, stream>>>(x, ctx, norm1_g, mod0, 0, 1, ABUF, MTOT);
    { GemmArgs g{}; g.A = ABUF; g.lda = D; g.W = w_qkv; g.ldw = 3 * D; g.K = D; g.N = 3 * D; g.C = R1; g.ldc = 3 * D;
      k_gemm<MODE_BF16><<<dim3(3 * D / 64, MTOT / 64), 256, 0, stream>>>(g); }
    k_qknorm<<<MTOT * 32 / 256, 256, 0, stream>>>(R1, q_gain, k_gain);
    k_attn<<<MTOT * NAH / 64, 64, 0, stream>>>(R1, rpb, ABUF);
    { GemmArgs g{}; g.A = ABUF; g.lda = D; g.W = w_o; g.ldw = D; g.K = D; g.N = D; g.res_lat = x; g.res_ctx = ctx; g.out_lat = out; g.out_ctx = XCTX; g.gate = mod0 + 2 * D;
      k_gemm<MODE_RES><<<dim3(D / 64, MTOT / 64), 256, 0, stream>>>(g); }
    k_prep<<<MTOT / 4, 256, 0, stream>>>(out, XCTX, norm2_g, mod0, 3, 4, ABUF, MTOT);
    { GemmArgs g{}; g.A = ABUF; g.lda = D; g.W = ffn_w_in; g.ldw = 2 * DFF; g.K = D; g.N = DFF; g.C = R1; g.ldc = DFF;
      k_gemm<MODE_SWIGLU><<<dim3(DFF / 64, MTOT / 64), 256, 0, stream>>>(g); }
    { GemmArgs g{}; g.A = R1; g.lda = DFF; g.W = ffn_w_out; g.ldw = D; g.K = DFF; g.N = D; g.res_lat = out; g.res_ctx = XCTX; g.out_lat = out; g.out_ctx = XCTX; g.gate = mod0 + 5 * D;
      k_gemm<MODE_RES><<<dim3(D / 64, MTOT / 64), 256, 0, stream>>>(g); }
    k_prep<<<MTOT / 4, 256, 0, stream>>>(out, XCTX, norm1_g + D, mod1, 0, 1, ABUF, MTOT);
    { GemmArgs g{}; g.A = ABUF; g.lda = D; g.W = hg_w_in; g.ldw = 5 * D; g.K = D; g.N = 5 * D; g.C = R1; g.ldc = 5 * D; g.lb = lb;
      k_gemm<MODE_HG><<<dim3(5 * D / 64, MTOT / 64), 256, 0, stream>>>(g); }
    k_hgscan<<<BATCH * HGH, 128, 0, stream>>>(R1, hg_norm_g);
    { GemmArgs g{}; g.A = R1; g.lda = 5 * D; g.W = hg_w_o; g.ldw = D; g.K = D; g.N = D; g.res_lat = out; g.res_ctx = XCTX; g.out_lat = out; g.out_ctx = XCTX; g.gate = mod1 + 2 * D;
      k_gemm<MODE_RES><<<dim3(D / 64, MLAT / 64), 256, 0, stream>>>(g); }
    k_prep<<<MLAT / 4, 256, 0, stream>>>(out, XCTX, norm2_g + D, mod1, 3, 4, ABUF, MLAT);
    { GemmArgs g{}; g.A = ABUF; g.lda = D; g.W = ffn_w_in + (size_t)D * 2 * DFF; g.ldw = 2 * DFF; g.K = D; g.N = DFF; g.C = R1; g.ldc = DFF;
      k_gemm<MODE_SWIGLU><<<dim3(DFF / 64, MLAT / 64), 256, 0, stream>>>(g); }
    { GemmArgs g{}; g.A = R1; g.lda = DFF; g.W = ffn_w_out + (size_t)DFF * D; g.ldw = D; g.K = DFF; g.N = D; g.res_lat = out; g.res_ctx = XCTX; g.out_lat = out; g.out_ctx = XCTX; g.gate = mod1 + 5 * D;
      k_gemm<MODE_RES><<<dim3(D / 64, MLAT / 64), 256, 0, stream>>>(g); }
}
```

```cpp
#include <hip/hip_runtime.h>
#include <cstdint>
#include <cstdio>

constexpr int D = 1024, BATCH = 4, SEQ = 8192, CTX = 256, MLAT = BATCH * SEQ, MCTX = BATCH * CTX, MTOT = MLAT + MCTX;
constexpr int DFF = 2816, NAH = 16, HGH = 8, GW = 64, ROWS = SEQ / GW;
constexpr float EPS = 1e-6f;
typedef unsigned short bf16_t;
typedef unsigned short f16_t;
#define GAS __attribute__((address_space(1)))
#define LAS __attribute__((address_space(3)))
typedef unsigned v4u __attribute__((ext_vector_type(4)));
typedef unsigned v2u __attribute__((ext_vector_type(2)));
typedef float f32x4 __attribute__((ext_vector_type(4)));
typedef float f32x2 __attribute__((ext_vector_type(2)));
typedef _Float16 h16x2 __attribute__((ext_vector_type(2)));

__device__ __forceinline__ bf16_t f2bf(float f) { unsigned u = __builtin_bit_cast(unsigned, f); return (bf16_t)((u + 0x7fffu + ((u >> 16) & 1u)) >> 16); }
__device__ __forceinline__ float bf2f(bf16_t h) { return __builtin_bit_cast(float, (unsigned)h << 16); }
__device__ __forceinline__ f16_t f2h(float f) { _Float16 h = (_Float16)f; return __builtin_bit_cast(unsigned short, h); }
__device__ __forceinline__ float h2f(f16_t u) { return (float)__builtin_bit_cast(_Float16, u); }
__device__ __forceinline__ unsigned pk_h2(float lo, float hi) { f32x2 v = {lo, hi}; h16x2 h = __builtin_convertvector(v, h16x2); return __builtin_bit_cast(unsigned, h); }
__device__ __forceinline__ float silu_f(float x) { return x / (1.f + __expf(-x)); }
__device__ __forceinline__ float sigmoid_f(float x) { return 1.f / (1.f + __expf(-x)); }
__device__ __forceinline__ float fast_sigmoid(float x) { return __builtin_amdgcn_rcpf(1.f + __builtin_amdgcn_exp2f(-1.4426950408889634f * x)); }
__device__ __forceinline__ float fast_silu(float x) { return x * fast_sigmoid(x); }
__device__ __forceinline__ int row_slot(int row) { return row < MLAT ? (row >> 13) : 4; }
__device__ __forceinline__ int row_batch(int row) { return row < MLAT ? (row >> 13) : ((row - MLAT) >> 8); }

constexpr size_t MiB = 1u << 20, KiB = 1024;
constexpr size_t WS_CTL = 0, CTL_ZERO_BYTES = 64 * KiB;
constexpr size_t WS_MOD = 64 * KiB;
constexpr size_t WS_LB = 320 * KiB;
constexpr size_t WS_GV = 336 * KiB;
constexpr size_t WS_BIAS_F0 = 448 * KiB;
constexpr size_t WS_BIAS_HG = 576 * KiB;
constexpr size_t WS_BIAS_F1 = 704 * KiB;
constexpr size_t WS_PART = 1 * MiB;
constexpr size_t WS_XCTX = 4 * MiB;
constexpr size_t WS_WQKV = 8 * MiB, WS_WO0 = 14 * MiB, WS_WHGIN = 16 * MiB, WS_WHGO = 26 * MiB;
constexpr size_t WS_WFIN0 = 28 * MiB, WS_WFIN1 = 39 * MiB, WS_WFOUT0 = 50 * MiB, WS_WFOUT1 = 50 * MiB + 5632 * KiB;
constexpr size_t WS_ABUF = 62 * MiB;
constexpr size_t WS_R1 = 128 * MiB;
constexpr size_t WS_STATE = 458 * MiB;
constexpr size_t WS_END = 512 * MiB;
static_assert(WS_WFOUT1 + (size_t)D * DFF * 2 <= WS_ABUF && WS_ABUF + (size_t)MTOT * D * 2 <= WS_R1 && WS_R1 + (size_t)MTOT * 5120 * 2 <= WS_STATE, "ws map");
static_assert(WS_PART + (size_t)MTOT * 16 * 4 <= WS_XCTX && WS_BIAS_F1 + 5 * 5632 * 4 <= WS_PART && WS_MOD + 2 * 5 * 6144 * 4 <= WS_LB, "ws map small");

namespace pg8 {
#define PG8_LAS __attribute__((address_space(3)))
typedef short bf16x8 __attribute__((ext_vector_type(8)));
typedef unsigned u32x4 __attribute__((ext_vector_type(4)));
constexpr int BM = 256, BK = 64, HALF = 128, HTB = HALF * BK * 2  , STAGE_BYTES = 8 * HTB, NXCD = 8, WGM = 8;

__host__ __device__ __forceinline__ int lds_byte(int r, int c) { const int st = (r >> 4) * 2 + (c >> 5), rr = r & 15, cc = c & 31, ob = rr * 64 + cc * 2; return st * 1024 + (ob ^ (((ob >> 9) & 1) << 5)); }
__host__ __device__ __forceinline__ void stage_rc(int b, int& R, int& C) { const int st = b / 1024, sb = b % 1024, swz = sb ^ (((sb >> 9) & 1) << 5); R = (st >> 1) * 16 + swz / 64; C = (st & 1) * 32 + (swz % 64) / 2; }
__host__ __device__ __forceinline__ int perm32(int rho) { const int n = rho >> 4, i = rho & 15; return 8 * (i >> 2) + 4 * n + (i & 3); }

struct Unit { int pm, pn; };
struct Gemm { const bf16_t* A; const bf16_t* Bt; int M, N, K, lda; };

struct StaticOrder {
    int nM, nN, nwg, G, c;
    __host__ __device__ void init(int M, int N, int G_, int c_) { nM = M / BM; nN = N / BM; nwg = nM * nN; G = G_; c = c_; }
    __host__ __device__ bool next(int i, Unit& u) const {
        const long L = (long)i * G + c; if (L >= nwg) return false;
        int wgid = (int)L; { const int q = nwg / NXCD, r = nwg % NXCD, xcd = wgid % NXCD, off = wgid / NXCD; wgid = (xcd < r ? xcd * (q + 1) : r * (q + 1) + (xcd - r) * q) + off; }
        const int nig = WGM * nN, gid = wgid / nig, fm = gid * WGM, gsz = (nM - fm) < WGM ? (nM - fm) : WGM;
        u.pm = fm + ((wgid % nig) % gsz); u.pn = (wgid % nig) / gsz; return true;
    }
    __device__ __forceinline__ void a_ready(const Unit&) const {}
    __device__ __forceinline__ void done(const Unit&) const {}
};
__device__ __forceinline__ unsigned cvt_pk_bf16(float lo, float hi) { unsigned r; asm volatile("v_cvt_pk_bf16_f32 %0, %1, %2" : "=v"(r) : "v"(lo), "v"(hi)); return r; }

__device__ __forceinline__ float quad_sum(float s) { s += __shfl_xor(s, 16); s += __shfl_xor(s, 32); return s; }
__device__ __forceinline__ float sq4(f32x4 v) { return (v[0] * v[0] + v[1] * v[1]) + (v[2] * v[2] + v[3] * v[3]); }
__device__ __forceinline__ u32x4 pack8(f32x4 a, f32x4 b) { u32x4 w; w.x = cvt_pk_bf16(a[0], a[1]); w.y = cvt_pk_bf16(a[2], a[3]); w.z = cvt_pk_bf16(b[0], b[1]); w.w = cvt_pk_bf16(b[2], b[3]); return w; }
__device__ __forceinline__ float row_rinv(const float* part, int row) {
    const f32x4* p = (const f32x4*)(part + (size_t)row * 16); const f32x4 a = p[0], b = p[1], c = p[2], d = p[3];
    const float s = ((a[0] + a[1]) + (a[2] + a[3])) + ((b[0] + b[1]) + (b[2] + b[3])) + ((c[0] + c[1]) + (c[2] + c[3])) + ((d[0] + d[1]) + (d[2] + d[3]));
    return rsqrtf(s * (1.f / D) + EPS);
}

struct EpiQKV {
    static constexpr bool PERM = true, AFTER_DRAIN = false;
    bf16_t* QKV; const float* qg; const float* kg; float qscale;
    __device__ __forceinline__ void operator()(const f32x4 (&acc)[2][2][4][2], const Unit& u, int wr, int wc, int fr, int fq) const {
        const int type = u.pn >> 2, head = (u.pn & 3) * 4 + wc;
        const int row0 = u.pm * BM + wr * 64 + fr;
        bf16_t* base = QKV + (size_t)type * D + head * 64 + 8 * fq;
        f32x4 gv[2][2];
        if (type < 2) { const float* gp = (type == 0 ? qg : kg) + 8 * fq;
#pragma unroll
            for (int bj = 0; bj < 2; ++bj)
#pragma unroll
                for (int n = 0; n < 2; ++n) gv[bj][n] = *(const f32x4*)(gp + 32 * bj + 4 * n); }
        const float sc = type == 0 ? qscale : 1.f;
#pragma unroll
        for (int ai = 0; ai < 2; ++ai)
#pragma unroll
            for (int m = 0; m < 4; ++m) {
                bf16_t* rowp = base + (size_t)(row0 + ai * HALF + m * 16) * 3072;
                f32x4 v00 = acc[ai][0][m][0], v01 = acc[ai][0][m][1], v10 = acc[ai][1][m][0], v11 = acc[ai][1][m][1];
                if (type < 2) {
                    const float ss = quad_sum((sq4(v00) + sq4(v01)) + (sq4(v10) + sq4(v11)));
                    const float r = rsqrtf(ss * (1.f / 64.f) + EPS) * sc;
                    v00 = v00 * r * gv[0][0]; v01 = v01 * r * gv[0][1]; v10 = v10 * r * gv[1][0]; v11 = v11 * r * gv[1][1];
                }
                *(u32x4*)(rowp) = pack8(v00, v01); *(u32x4*)(rowp + 32) = pack8(v10, v11);
            }
    }
};
struct EpiRes {
    static constexpr bool PERM = true, AFTER_DRAIN = false;
    const float* res_lat; const float* res_ctx; float* out_lat; float* out_ctx; const float* gate; const float* Gn; bf16_t* Aout; float* part;
    __device__ __forceinline__ void operator()(const f32x4 (&acc)[2][2][4][2], const Unit& u, int wr, int wc, int fr, int fq) const {
        const bool lat = u.pm < MLAT / BM; const int slot = lat ? (u.pm >> 5) : 4;
        const size_t trow = lat ? (size_t)u.pm * BM : (size_t)u.pm * BM - MLAT;
        const float* res = (lat ? res_lat : res_ctx) + trow * D; float* out = (lat ? out_lat : out_ctx) + trow * D;
        const int col0 = u.pn * BM + wc * 32 + 8 * fq;
        f32x4 gt[2][2], gn[2][2];
#pragma unroll
        for (int bj = 0; bj < 2; ++bj)
#pragma unroll
            for (int n = 0; n < 2; ++n) { gt[bj][n] = *(const f32x4*)(gate + (size_t)slot * 6 * D + col0 + bj * HALF + 4 * n);
                gn[bj][n] = Gn ? *(const f32x4*)(Gn + (size_t)slot * D + col0 + bj * HALF + 4 * n) : (f32x4){0.f, 0.f, 0.f, 0.f}; }
#pragma unroll
        for (int ai = 0; ai < 2; ++ai)
#pragma unroll
            for (int m = 0; m < 4; ++m) {
                const int r = wr * 64 + ai * HALF + m * 16 + fr; const size_t off = (size_t)r * D + col0;
                f32x4 x[2][2]; float ss = 0.f;
#pragma unroll
                for (int bj = 0; bj < 2; ++bj)
#pragma unroll
                    for (int n = 0; n < 2; ++n) { const f32x4 rv = *(const f32x4*)(res + off + bj * HALF + 4 * n); x[bj][n] = rv + gt[bj][n] * acc[ai][bj][m][n];
                        *(f32x4*)(out + off + bj * HALF + 4 * n) = x[bj][n]; ss += sq4(x[bj][n]); }
                if (Gn) {
                    ss = quad_sum(ss);
                    const size_t grow = (size_t)u.pm * BM + r;
                    if (fq == 0) part[grow * 16 + u.pn * 4 + wc] = ss;
                    bf16_t* ap = Aout + grow * D + col0;
                    *(u32x4*)(ap) = pack8(x[0][0] * gn[0][0], x[0][1] * gn[0][1]); *(u32x4*)(ap + HALF) = pack8(x[1][0] * gn[1][0], x[1][1] * gn[1][1]);
                }
            }
    }
};
struct EpiSwiglu {
    static constexpr bool PERM = true, AFTER_DRAIN = false;
    const float* part; const float* bias; bf16_t* HID;
    __device__ __forceinline__ void operator()(const f32x4 (&acc)[2][2][4][2], const Unit& u, int wr, int wc, int fr, int fq) const {
        const bool lat = u.pm < MLAT / BM; const int slot = lat ? (u.pm >> 5) : 4;
        const int c0 = wc * 32 + 8 * fq;
        const float* bp = bias + (size_t)slot * 2 * DFF + u.pn * BM + c0;
        f32x4 ba[2], bu[2];
#pragma unroll
        for (int n = 0; n < 2; ++n) { ba[n] = *(const f32x4*)(bp + 4 * n); bu[n] = *(const f32x4*)(bp + HALF + 4 * n); }
#pragma unroll
        for (int ai = 0; ai < 2; ++ai)
#pragma unroll
            for (int m = 0; m < 4; ++m) {
                const int row = u.pm * BM + wr * 64 + ai * HALF + m * 16 + fr;
                const float rinv = row_rinv(part, row);
                f32x4 h[2];
#pragma unroll
                for (int n = 0; n < 2; ++n) { const f32x4 a = acc[ai][0][m][n] * rinv + ba[n], uu = acc[ai][1][m][n] * rinv + bu[n];
#pragma unroll
                    for (int j = 0; j < 4; ++j) h[n][j] = fast_silu(a[j]) * uu[j]; }
                *(u32x4*)(HID + (size_t)row * DFF + u.pn * HALF + c0) = pack8(h[0], h[1]);
            }
    }
};
struct EpiHg {
    static constexpr bool PERM = true, AFTER_DRAIN = false;
    const float* part; const float* bias; unsigned short* HGO; const float* lb;
    __device__ __forceinline__ void operator()(const f32x4 (&acc)[2][2][4][2], const Unit& u, int wr, int wc, int fr, int fq) const {
        const bool lat = u.pm < MLAT / BM; const int slot = lat ? (u.pm >> 5) : 4;
        const int type = u.pn >> 2, col0 = u.pn * BM + wc * 32 + 8 * fq;
        f32x4 bv[2][2], lbv[2][2];
#pragma unroll
        for (int bj = 0; bj < 2; ++bj)
#pragma unroll
            for (int n = 0; n < 2; ++n) { bv[bj][n] = *(const f32x4*)(bias + (size_t)slot * 5 * D + col0 + bj * HALF + 4 * n);
                lbv[bj][n] = type >= 3 ? *(const f32x4*)(lb + (col0 - 3 * D) + bj * HALF + 4 * n) : (f32x4){0.f, 0.f, 0.f, 0.f}; }
#pragma unroll
        for (int ai = 0; ai < 2; ++ai)
#pragma unroll
            for (int m = 0; m < 4; ++m) {
                const int row = u.pm * BM + wr * 64 + ai * HALF + m * 16 + fr;
                const float rinv = row_rinv(part, row);
#pragma unroll
                for (int bj = 0; bj < 2; ++bj) {
                    f32x4 v0 = acc[ai][bj][m][0] * rinv + bv[bj][0], v1 = acc[ai][bj][m][1] * rinv + bv[bj][1]; u32x4 w;
                    if (type == 1) w = pack8(v0, v1);
                    else if (type < 3) {
#pragma unroll
                        for (int j = 0; j < 4; ++j) { v0[j] = fast_silu(v0[j]); v1[j] = fast_silu(v1[j]); }
                        w = pack8(v0, v1);
                    } else {
#pragma unroll
                        for (int j = 0; j < 4; ++j) { v0[j] = (1.f - lbv[bj][0][j]) * fast_sigmoid(-v0[j]); v1[j] = (1.f - lbv[bj][1][j]) * fast_sigmoid(-v1[j]); }
                        w.x = pk_h2(v0[0], v0[1]); w.y = pk_h2(v0[2], v0[3]); w.z = pk_h2(v1[0], v1[1]); w.w = pk_h2(v1[2], v1[3]);
                    }
                    *(u32x4*)(HGO + (size_t)row * 5 * D + col0 + bj * HALF) = w;
                }
            }
    }
};

template <class Epi, class Sched, bool ALIGN_EPI = false, bool SP2 = false>
__device__ __forceinline__ void gemm_phase(PG8_LAS unsigned char* lds, const Gemm g, const Sched& S, const Epi& E) {
    const int tid = threadIdx.x, wid = __builtin_amdgcn_readfirstlane(tid >> 6), lane = tid & 63, wr = wid >> 2, wc = wid & 3, fr = lane & 15, fq = lane >> 4;
    const int K = g.K, nt = K / BK;
    unsigned voffA[2], voffB[2];
#pragma unroll
    for (int i = 0; i < 2; ++i) { int R, C; stage_rc(tid * 16 + i * 8192, R, C); const int Rb = Epi::PERM ? ((R & ~31) + perm32(R & 31)) : R;
        voffA[i] = (unsigned)(R * g.lda + C) * 2u; voffB[i] = (unsigned)(Rb * K + C) * 2u; }
    const size_t kstep = (size_t)(BK * 2);
    const size_t hsA = (size_t)HALF * g.lda * 2, hsB = (size_t)HALF * K * 2;
    const size_t tsA = 2 * hsA, tsB = 2 * hsB;
    const unsigned ldsw = (unsigned)wid * 1024u;
    const int aoff = lds_byte(wr * 64 + fr, fq * 8), boff = lds_byte(wc * 32 + fr, fq * 8);
#define PG8_SA(b, h) (((b) * 2 + (h)) * HTB)
#define PG8_SB(b, h) ((4 + (b) * 2 + (h)) * HTB)
#define PG8_STAGE(bufoff, gbase, voff) do { _Pragma("unroll") for (int _i = 0; _i < 2; ++_i) \
        __builtin_amdgcn_global_load_lds((const unsigned*)((const char*)(gbase) + (voff)[_i]), (PG8_LAS unsigned*)(lds + (bufoff) + ldsw + _i * 8192), 16, 0, 0); } while (0)
#define PG8_LDA(dst, b, h) do { _Pragma("unroll") for (int m = 0; m < 4; ++m) _Pragma("unroll") for (int k = 0; k < 2; ++k) dst[m][k] = *(const PG8_LAS bf16x8*)(lds + PG8_SA(b, h) + aoff + m * 2048 + k * 1024); } while (0)
#define PG8_LDB(dst, b, h) do { _Pragma("unroll") for (int n = 0; n < 2; ++n) _Pragma("unroll") for (int k = 0; k < 2; ++k) dst[n][k] = *(const PG8_LAS bf16x8*)(lds + PG8_SB(b, h) + boff + n * 2048 + k * 1024); } while (0)
#define PG8_MMA(ai, bj, At, Bt) do { __builtin_amdgcn_s_setprio(1); _Pragma("unroll") for (int m = 0; m < 4; ++m) _Pragma("unroll") for (int n = 0; n < 2; ++n) _Pragma("unroll") for (int k = 0; k < 2; ++k) \
        acc[ai][bj][m][n] = __builtin_amdgcn_mfma_f32_16x16x32_bf16(Bt[n][k], At[m][k], acc[ai][bj][m][n], 0, 0, 0); __builtin_amdgcn_s_setprio(0); } while (0)
#define PG8_WAIT_V(n) asm volatile("s_waitcnt vmcnt(" #n ")" ::: "memory")
#define PG8_WAIT_L(n) asm volatile("s_waitcnt lgkmcnt(" #n ")" ::: "memory")
#define PG8_BAR __builtin_amdgcn_s_barrier()
#define PG8_SCHED __builtin_amdgcn_sched_barrier(0)
    Unit cur, nxt; int ui = 0;
    if (!S.next(0, cur)) return;
    f32x4 acc[2][2][4][2];
#pragma unroll
    for (int a = 0; a < 2; ++a)
#pragma unroll
        for (int b = 0; b < 2; ++b)
#pragma unroll
            for (int m = 0; m < 4; ++m)
#pragma unroll
                for (int n = 0; n < 2; ++n) acc[a][b][m][n] = (f32x4){0.f, 0.f, 0.f, 0.f};
    bf16x8 At[4][2], B0[2][2], B1[2][2];
    const char* cA = (const char*)g.A + (size_t)cur.pm * tsA; const char* cB = (const char*)g.Bt + (size_t)cur.pn * tsB;
    S.a_ready(cur);
    if constexpr (SP2) {
        PG8_STAGE(PG8_SB(0, 0), cB, voffB); PG8_STAGE(PG8_SB(0, 1), cB + hsB, voffB); PG8_STAGE(PG8_SA(0, 0), cA, voffA); PG8_STAGE(PG8_SA(0, 1), cA + hsA, voffA);
        if (wr == 1) PG8_BAR;
        PG8_WAIT_V(2); PG8_BAR;
        PG8_STAGE(PG8_SB(1, 0), cB + kstep, voffB); PG8_STAGE(PG8_SA(1, 0), cA + kstep, voffA); PG8_STAGE(PG8_SB(1, 1), cB + hsB + kstep, voffB);
        PG8_WAIT_V(6); PG8_BAR;
    } else {
        PG8_STAGE(PG8_SB(0, 0), cB, voffB); PG8_STAGE(PG8_SA(0, 0), cA, voffA); PG8_STAGE(PG8_SB(0, 1), cB + hsB, voffB); PG8_STAGE(PG8_SA(0, 1), cA + hsA, voffA);
        if (wr == 1) PG8_BAR;
        PG8_WAIT_V(4); PG8_BAR;
        PG8_STAGE(PG8_SB(1, 0), cB + kstep, voffB); PG8_STAGE(PG8_SA(1, 0), cA + kstep, voffA); PG8_STAGE(PG8_SB(1, 1), cB + hsB + kstep, voffB);
        PG8_WAIT_V(6); PG8_BAR;
    }
    for (;;) {
        const bool has_next = S.next(ui + 1, nxt);
        const char* nA = has_next ? (const char*)g.A + (size_t)nxt.pm * tsA : cA; const char* nB = has_next ? (const char*)g.Bt + (size_t)nxt.pn * tsB : cB;
        for (int t = 0; t < nt; t += 2) {
            const bool last = (t == nt - 2);
            const char* a1 = cA + (size_t)(t + 1) * kstep;
            const char* a2 = last ? nA : cA + (size_t)(t + 2) * kstep; const char* b2 = last ? nB : cB + (size_t)(t + 2) * kstep;
            const char* a3 = a2 + kstep; const char* b3 = b2 + kstep;
            if (last && has_next) S.a_ready(nxt);
            if constexpr (SP2) {
            PG8_LDB(B0, 0, 0); PG8_LDB(B1, 0, 1); PG8_SCHED; PG8_LDA(At, 0, 0); PG8_STAGE(PG8_SA(1, 1), a1 + hsA, voffA);
            PG8_WAIT_V(8); PG8_WAIT_L(0); PG8_BAR; PG8_MMA(0, 0, At, B0); PG8_MMA(0, 1, At, B1); PG8_BAR; PG8_SCHED;
            PG8_LDA(At, 0, 1); PG8_STAGE(PG8_SB(0, 0), b2, voffB); PG8_STAGE(PG8_SB(0, 1), b2 + hsB, voffB); PG8_STAGE(PG8_SA(0, 0), a2, voffA);
            PG8_WAIT_V(8); PG8_WAIT_L(0); PG8_BAR; PG8_MMA(1, 0, At, B0); PG8_MMA(1, 1, At, B1); PG8_BAR; PG8_SCHED;
            PG8_LDB(B0, 1, 0); PG8_LDB(B1, 1, 1); PG8_SCHED; PG8_LDA(At, 1, 0); PG8_STAGE(PG8_SA(0, 1), a2 + hsA, voffA);
            PG8_WAIT_V(8); PG8_WAIT_L(0); PG8_BAR; PG8_MMA(0, 0, At, B0); PG8_MMA(0, 1, At, B1); PG8_BAR; PG8_SCHED;
            PG8_LDA(At, 1, 1); PG8_STAGE(PG8_SB(1, 0), b3, voffB); PG8_STAGE(PG8_SB(1, 1), b3 + hsB, voffB); PG8_STAGE(PG8_SA(1, 0), a3, voffA);
            PG8_WAIT_V(8); PG8_WAIT_L(0); PG8_BAR; PG8_MMA(1, 0, At, B0); PG8_MMA(1, 1, At, B1); PG8_BAR; PG8_SCHED;
            } else {
            PG8_LDB(B0, 0, 0); PG8_SCHED; PG8_LDA(At, 0, 0); PG8_STAGE(PG8_SA(1, 1), a1 + hsA, voffA);
            PG8_WAIT_L(8); PG8_BAR; PG8_WAIT_L(0); PG8_MMA(0, 0, At, B0); PG8_BAR; PG8_SCHED;
            PG8_LDB(B1, 0, 1); PG8_STAGE(PG8_SB(0, 0), b2, voffB);
            PG8_BAR; PG8_WAIT_L(0); PG8_MMA(0, 1, At, B1); PG8_BAR;
            PG8_LDA(At, 0, 1); PG8_STAGE(PG8_SA(0, 0), a2, voffA);
            PG8_BAR; PG8_WAIT_L(0); PG8_MMA(1, 0, At, B0); PG8_BAR; PG8_SCHED;
            PG8_STAGE(PG8_SB(0, 1), b2 + hsB, voffB);
            PG8_WAIT_V(6); PG8_BAR; PG8_MMA(1, 1, At, B1); PG8_BAR;
            PG8_LDB(B0, 1, 0); PG8_SCHED; PG8_LDA(At, 1, 0); PG8_STAGE(PG8_SA(0, 1), a2 + hsA, voffA);
            PG8_WAIT_L(8); PG8_BAR; PG8_WAIT_L(0); PG8_MMA(0, 0, At, B0); PG8_BAR; PG8_SCHED;
            PG8_LDB(B1, 1, 1); PG8_STAGE(PG8_SB(1, 0), b3, voffB);
            PG8_BAR; PG8_WAIT_L(0); PG8_MMA(0, 1, At, B1); PG8_BAR;
            PG8_LDA(At, 1, 1); PG8_STAGE(PG8_SA(1, 0), a3, voffA);
            PG8_BAR; PG8_WAIT_L(0); PG8_MMA(1, 0, At, B0); PG8_BAR; PG8_SCHED;
            PG8_STAGE(PG8_SB(1, 1), b3 + hsB, voffB);
            PG8_WAIT_V(6); PG8_BAR; PG8_MMA(1, 1, At, B1); PG8_BAR;
            }
        }
        if constexpr (ALIGN_EPI) { if (wr == 0) PG8_BAR; }
        if constexpr (!Epi::AFTER_DRAIN) { E(acc, cur, wr, wc, fr, fq); S.done(cur); }
        if (!has_next) break;
#pragma unroll
        for (int a = 0; a < 2; ++a)
#pragma unroll
            for (int b = 0; b < 2; ++b)
#pragma unroll
                for (int m = 0; m < 4; ++m)
#pragma unroll
                    for (int n = 0; n < 2; ++n) acc[a][b][m][n] = (f32x4){0.f, 0.f, 0.f, 0.f};
        cur = nxt; cA = nA; cB = nB; ++ui;
        if constexpr (ALIGN_EPI) { if (wr == 1) PG8_BAR; }
    }
    PG8_WAIT_V(0);
    if constexpr (!ALIGN_EPI) { if (wr == 0) PG8_BAR; }
    PG8_BAR;
    if constexpr (Epi::AFTER_DRAIN) { E.fused(acc, cur, wr, wc, fr, fq, lds, wid, lane); S.done(cur); }
#undef PG8_SA
#undef PG8_SB
#undef PG8_STAGE
#undef PG8_LDA
#undef PG8_LDB
#undef PG8_MMA
#undef PG8_WAIT_V
#undef PG8_WAIT_L
#undef PG8_BAR
#undef PG8_SCHED
}

}


#define XB_TMO      128
#define XB_XCNT(j)  (256  + 64 * (j))
#define XB_XSUB(j)  (1280 + 64 * (j))
#define XB_XGEN(j)  (2304 + 64 * (j))
#define XB_TOP      3328
#define XB_TOPGEN   3392
#define XCD_BAR_WORDS 3456
#define XB_SPIN_CAP (1u << 20)

__device__ __forceinline__ unsigned xb_ld(unsigned* p)              { return __hip_atomic_load(p, __ATOMIC_RELAXED, __HIP_MEMORY_SCOPE_AGENT); }
__device__ __forceinline__ unsigned xb_add(unsigned* p, unsigned v) { return __hip_atomic_fetch_add(p, v, __ATOMIC_RELAXED, __HIP_MEMORY_SCOPE_AGENT); }
__device__ __forceinline__ unsigned xb_xcc_id() { return (unsigned)__builtin_amdgcn_s_getreg((3 << 11) | 20) & 0xFu; }
#define XB_SPIN(cond, bar) do { unsigned _sp = 0; while (cond) { __builtin_amdgcn_s_sleep(1); \
    if ((++_sp & 255u) == 0u) { if (xb_ld(&(bar)[XB_TMO])) break; if (_sp > XB_SPIN_CAP) { atomicAdd(&(bar)[XB_TMO], 1u); break; } } } } while (0)

struct XcdBarrier {
    unsigned* bar; unsigned x;
    volatile LAS unsigned* st;
};

__device__ __forceinline__ XcdBarrier xcd_barrier_post(unsigned* bar, volatile LAS unsigned* st) {
    XcdBarrier b; b.bar = bar; b.x = xb_xcc_id(); b.st = st;
    if (threadIdx.x == 0) (void)xb_add(&bar[XB_XCNT(b.x)], 1u);
    return b;
}
__device__ __forceinline__ void xcd_barrier_complete(unsigned* bar, unsigned x, unsigned& nloc, unsigned& nx) {
    const unsigned G = gridDim.x * gridDim.y * gridDim.z;
    unsigned sum, cnt, mine, sp = 0u;
    for (;;) {
        sum = 0u; cnt = 0u; mine = 0u;
#pragma unroll
        for (unsigned j = 0; j < 16; ++j) { const unsigned c = xb_ld(&bar[XB_XCNT(j)]); sum += c; cnt += (c > 0u) ? 1u : 0u; mine = (j == x) ? c : mine; }
        if (sum == G) break;
        __builtin_amdgcn_s_sleep(1);
        if ((++sp & 255u) == 0u) { if (xb_ld(&bar[XB_TMO])) break; if (sp > XB_SPIN_CAP) { atomicAdd(&bar[XB_TMO], 1u); break; } }
    }
    nloc = mine > 0u ? mine : 1u; nx = cnt > 0u ? cnt : 1u;
}

__device__ __forceinline__ void xcd_barrier(const XcdBarrier& b) {
    asm volatile("s_waitcnt vmcnt(0)" ::: "memory");
    __syncthreads();
    if (threadIdx.x == 0) {
        unsigned* bar = b.bar;
        __builtin_amdgcn_s_waitcnt(0);
        unsigned nloc = b.st[0], nx = b.st[1];
        if (nloc == 0u) { xcd_barrier_complete(bar, b.x, nloc, nx); b.st[0] = nloc; b.st[1] = nx; }
        const unsigned old = xb_add(&bar[XB_XSUB(b.x)], 1u);
        const unsigned gen = old / nloc;
        if (old + 1u == (gen + 1u) * nloc) {
            __builtin_amdgcn_fence(__ATOMIC_RELEASE, "agent");
            asm volatile("s_waitcnt vmcnt(0)" ::: "memory");
            const unsigned og = xb_add(&bar[XB_TOP], 1u);
            const unsigned tg = og / nx;
            if (og + 1u == (tg + 1u) * nx) xb_add(&bar[XB_TOPGEN], 1u);
            else XB_SPIN(xb_ld(&bar[XB_TOPGEN]) == tg, bar);
            __builtin_amdgcn_fence(__ATOMIC_ACQUIRE, "agent");
            xb_add(&bar[XB_XGEN(b.x)], 1u);
            asm volatile("s_waitcnt vmcnt(0)" ::: "memory");
        } else {
            XB_SPIN(xb_ld(&bar[XB_XGEN(b.x)]) == gen, bar);
            __builtin_amdgcn_fence(__ATOMIC_ACQUIRE, "agent");
            asm volatile("s_waitcnt vmcnt(0)" ::: "memory");
        }
    }
    __syncthreads();
}

constexpr int NWAVES = 8;
constexpr int RING_BYTES = 131072, MISC_OFF = RING_BYTES + 320, LDS_BYTES = 147456;
typedef GAS unsigned gu32;
#define LDS_WAIT() asm volatile("s_waitcnt lgkmcnt(0)" ::: "memory")
#define VM_WAIT() asm volatile("s_waitcnt vmcnt(0)" ::: "memory")
__device__ __forceinline__ unsigned pk2(float lo, float hi) { return (unsigned)f2bf(lo) | ((unsigned)f2bf(hi) << 16); }
__device__ __forceinline__ float wave_sum(float v) {
#pragma unroll
    for (int o = 1; o < 64; o <<= 1) v += __shfl_xor(v, o);
    return v;
}
struct Args { const float* in[19]; float* out; unsigned char* ws; int ph_lo, ph_hi; };

__device__ __forceinline__ void p0_transpose_item(const float* W, int K, int N, bf16_t* WT, int k0, int n0, int dst_row0, LAS float* scr, int lane) {
#pragma unroll 8
    for (int i = 0; i < 32; ++i) { const int kk = 2 * i + (lane >> 5); scr[kk * 33 + (lane & 31)] = W[(size_t)(k0 + kk) * N + n0 + (lane & 31)]; }
    LDS_WAIT(); asm volatile("" ::: "memory");
    const int c = lane & 7;
#pragma unroll
    for (int j = 0; j < 4; ++j) { const int n = (lane >> 3) + 8 * j; const LAS float* s = scr + (8 * c) * 33 + n;
        v4u o; o.x = pk2(s[0 * 33], s[1 * 33]); o.y = pk2(s[2 * 33], s[3 * 33]); o.z = pk2(s[4 * 33], s[5 * 33]); o.w = pk2(s[6 * 33], s[7 * 33]);
        *(v4u*)(WT + (size_t)(dst_row0 + n) * K + k0 + 8 * c) = o; }
    LDS_WAIT(); asm volatile("" ::: "memory");
}
__device__ __forceinline__ int perm_qkv(int n0) { const int t = n0 & 255, wc = t >> 6, bj = (t >> 5) & 1; return (n0 & ~255) + 128 * bj + 32 * wc; }
__device__ __forceinline__ int perm_ffn(int n0) { const int bj = n0 >= DFF ? 1 : 0, c = n0 - bj * DFF; return (c >> 7) * 256 + bj * 128 + (c & 127); }

__device__ __forceinline__ void naive_attn_item(const bf16_t* QKV, const float* rpb, bf16_t* O, int idx) {
    const int h = idx & 15, row = idx >> 4;
    float q[64], o[64]; float m = -INFINITY, l = 0.f;
    { const bf16_t* qp = QKV + (size_t)row * 3072 + h * 64;
#pragma unroll
      for (int i = 0; i < 64; ++i) { q[i] = bf2f(qp[i]); o[i] = 0.f; } }
    const int b = row_batch(row);
    auto visit = [&](int krow, float bias) {
        const bf16_t* kp = QKV + (size_t)krow * 3072 + D + h * 64; const bf16_t* vp = kp + D;
        float s = 0.f;
#pragma unroll
        for (int i = 0; i < 64; ++i) s += q[i] * bf2f(kp[i]);
        s += bias;
        const float mn = fmaxf(m, s), f = __expf(m - mn), p = __expf(s - mn);
        l = l * f + p;
#pragma unroll
        for (int i = 0; i < 64; ++i) o[i] = o[i] * f + p * bf2f(vp[i]);
        m = mn;
    };
    if (row < MLAT) {
        const int t = row & (SEQ - 1), r = t >> 6, c = t & 63;
        int rs = r - 4; rs = rs < 0 ? 0 : (rs > ROWS - 8 ? ROWS - 8 : rs);
        int cs = c - 8; cs = cs < 0 ? 0 : (cs > GW - 16 ? GW - 16 : cs);
        for (int j = 0; j < 8; ++j)
            for (int w = 0; w < 16; ++w) {
                const int kr = rs + j, kc = cs + w;
                visit(b * SEQ + kr * GW + kc, rpb[(h * 15 + (kr - r + 7)) * 31 + (kc - c + 15)]);
            }
    }
    for (int kk = 0; kk < CTX; ++kk) visit(MLAT + b * CTX + kk, 0.f);
    const float rl = 1.f / l;
    bf16_t* op = O + (size_t)row * D + h * 64;
#pragma unroll
    for (int i = 0; i < 64; ++i) op[i] = f2bf(o[i] * rl);
}
__device__ __forceinline__ void naive_hgscan(unsigned short* HGO, const float* norm_g, int bh, LAS float* sm) {
    LAS float (*sq)[128] = (LAS float (*)[128])sm; LAS float (*sk)[128] = (LAS float (*)[128])(sm + 256); LAS float (*red)[2] = (LAS float (*)[2])(sm + 512);
    const int b = bh >> 3, h = bh & 7, v = threadIdx.x & 127; const bool act = threadIdx.x < 128;
    const int NS = CTX + SEQ;
    const float ng = norm_g[v];
    for (int dir = 0; dir < 2; ++dir) {
        float S[128];
#pragma unroll
        for (int k = 0; k < 128; ++k) S[k] = 0.f;
        auto rowof = [&](int step) { int row; if (step < CTX) { const int j = dir == 0 ? step : CTX - 1 - step; row = MLAT + b * CTX + j; } else { const int t = dir == 0 ? step - CTX : SEQ - 1 - (step - CTX); row = b * SEQ + t; } return row; };
        { const int row = rowof(0); const unsigned short* p = HGO + (size_t)row * 5120 + h * 128;
          if (act) { sq[0][v] = bf2f(p[v]); sk[0][v] = h2f(p[(3 + dir) * D + v]); } }
        __syncthreads();
        for (int step = 0; step < NS; ++step) {
            const int cur = step & 1, row = rowof(step);
            unsigned short* p = HGO + (size_t)row * 5120 + h * 128;
            const float vv = bf2f(p[D + v]);
            if (step + 1 < NS) { const int rn = rowof(step + 1); const unsigned short* pn = HGO + (size_t)rn * 5120 + h * 128;
                if (act) { sq[cur ^ 1][v] = bf2f(pn[v]); sk[cur ^ 1][v] = h2f(pn[(3 + dir) * D + v]); } }
            float o = 0.f;
#pragma unroll
            for (int k = 0; k < 128; ++k) { const float kk = sk[cur][k]; S[k] = (1.f - kk) * S[k] + kk * vv; o += sq[cur][k] * S[k]; }
            if (row < MLAT) {
                if (dir == 0) { if (act) p[3 * D + v] = f2bf(o); }
                else {
                    const float ot = o + bf2f(p[3 * D + v]);
                    float ss = ot * ot;
#pragma unroll
                    for (int off = 1; off < 64; off <<= 1) ss += __shfl_xor(ss, off);
                    if (act && (v & 63) == 0) red[cur][v >> 6] = ss;
                    __syncthreads();
                    const float tot = red[cur][0] + red[cur][1];
                    const float rinv = rsqrtf(tot * (1.f / 128.f) + EPS);
                    const float gv = bf2f(p[2 * D + v]);
                    if (act) p[v] = f2bf(ot * rinv * ng * gv);
                }
            }
            __syncthreads();
        }
    }
}

__global__ void __launch_bounds__(NWAVES * 64, 2) mega(Args a) {
    extern __shared__ __attribute__((aligned(16))) unsigned char lds_raw[];
    LAS unsigned char* lds = (LAS unsigned char*)lds_raw;
    volatile LAS unsigned* MISC = (volatile LAS unsigned*)(lds + MISC_OFF);
    const int tid = threadIdx.x, lane = tid & 63, wave = __builtin_amdgcn_readfirstlane(tid >> 6);
    const int G = gridDim.x, bx = blockIdx.x;
    const int vcu = (G % 8 == 0) ? (bx % 8) * (G / 8) + bx / 8 : bx;
    unsigned char* ws = a.ws;
    const float* x = a.in[0]; const float* cvec = a.in[1]; const float* ctx = a.in[2]; const float* c_ctx = a.in[3];
    const float* ada_w = a.in[4]; const float* ada_b = a.in[5]; const float* norm1_g = a.in[6]; const float* norm2_g = a.in[7];
    const float* w_qkv = a.in[8]; const float* w_o = a.in[9]; const float* q_gain = a.in[10]; const float* k_gain = a.in[11];
    const float* hg_w_in = a.in[13]; const float* hg_lower = a.in[14];
    const float* hg_w_o = a.in[16]; const float* ffn_w_in = a.in[17]; const float* ffn_w_out = a.in[18];
    float* out = a.out;
    float* mod = (float*)(ws + WS_MOD); float* lbp = (float*)(ws + WS_LB); float* Gv = (float*)(ws + WS_GV);
    float* bias_f0 = (float*)(ws + WS_BIAS_F0); float* bias_hg = (float*)(ws + WS_BIAS_HG); float* bias_f1 = (float*)(ws + WS_BIAS_F1);
    float* part = (float*)(ws + WS_PART); float* XCTX = (float*)(ws + WS_XCTX);
    bf16_t* Wqkv_t = (bf16_t*)(ws + WS_WQKV); bf16_t* Wo0_t = (bf16_t*)(ws + WS_WO0); bf16_t* Whgin_t = (bf16_t*)(ws + WS_WHGIN); bf16_t* Whgo_t = (bf16_t*)(ws + WS_WHGO);
    bf16_t* Wfin0_t = (bf16_t*)(ws + WS_WFIN0); bf16_t* Wfin1_t = (bf16_t*)(ws + WS_WFIN1); bf16_t* Wfout0_t = (bf16_t*)(ws + WS_WFOUT0); bf16_t* Wfout1_t = (bf16_t*)(ws + WS_WFOUT1);
    bf16_t* ABUF = (bf16_t*)(ws + WS_ABUF); bf16_t* R1 = (bf16_t*)(ws + WS_R1);

    for (int u = tid; u < (LDS_BYTES - RING_BYTES) / 4; u += NWAVES * 64) ((LAS unsigned*)(lds + RING_BYTES))[u] = 0u;
    __syncthreads();
    XcdBarrier bar = xcd_barrier_post((unsigned*)(ws + WS_CTL) + 1024, MISC + 8);
    const int lo = a.ph_lo, hi = a.ph_hi;
#define IN(k) (lo <= (k) && (k) < hi)
#define SEAM(k) do { if (IN(k) && IN((k) + 1)) xcd_barrier(bar); } while (0)

    if (IN(0)) {
        if (bx < 192) {
            LAS float* sv = (LAS float*)lds; LAS float* red = (LAS float*)(lds + 20480);
            const int l = bx / 96, cb = bx % 96;
            for (int i = tid; i < 5 * D; i += 512) { const int s = i >> 10, k = i & 1023; const float v = s < 4 ? cvec[s * D + k] : c_ctx[k]; sv[i] = silu_f(v); }
            __syncthreads();
            const int col = tid & 63, kg = tid >> 6;
            float acc[5] = {0.f, 0.f, 0.f, 0.f, 0.f};
            const float* w = ada_w + (size_t)l * D * 6 * D + cb * 64 + col;
            for (int k = kg * 128; k < kg * 128 + 128; ++k) { const float wv = w[(size_t)k * 6 * D];
#pragma unroll
                for (int s = 0; s < 5; ++s) acc[s] += sv[s * D + k] * wv; }
#pragma unroll
            for (int s = 0; s < 5; ++s) red[(kg * 5 + s) * 64 + col] = acc[s];
            __syncthreads();
            if (tid < 320) { const int s = tid >> 6, c2 = tid & 63; float t = 0.f;
#pragma unroll
                for (int k2 = 0; k2 < 8; ++k2) t += red[(k2 * 5 + s) * 64 + c2];
                mod[((size_t)l * 5 + s) * 6 * D + cb * 64 + c2] = t + ada_b[l * 6 * D + cb * 64 + c2]; }
            __syncthreads();
        } else if (bx < 196) { const int i = (bx - 192) * 512 + tid; lbp[i] = sigmoid_f(hg_lower[2 * D + i] - hg_lower[i]); }
        {
            LAS float* scr = (LAS float*)(lds + wave * 16384);
            const int gw = vcu * NWAVES + wave, NGW = G * NWAVES;
            constexpr int I_QKV = 16 * 96, I_O = 16 * 32, I_HGIN = 16 * 160, I_FIN = 16 * 176, I_FOUT = 44 * 32;
            constexpr int NITEMS = I_QKV + 2 * I_O + I_HGIN + 2 * I_FIN + 2 * I_FOUT;
            for (int it = gw; it < NITEMS; it += NGW) {
                int r = it;
                if (r < I_QKV) { const int kb = r / 96, nb = r % 96; p0_transpose_item(w_qkv, D, 3 * D, Wqkv_t, kb * 64, nb * 32, perm_qkv(nb * 32), scr, lane); continue; } r -= I_QKV;
                if (r < I_O) { const int kb = r / 32, nb = r % 32; p0_transpose_item(w_o, D, D, Wo0_t, kb * 64, nb * 32, nb * 32, scr, lane); continue; } r -= I_O;
                if (r < I_O) { const int kb = r / 32, nb = r % 32; p0_transpose_item(hg_w_o, D, D, Whgo_t, kb * 64, nb * 32, nb * 32, scr, lane); continue; } r -= I_O;
                if (r < I_HGIN) { const int kb = r / 160, nb = r % 160; p0_transpose_item(hg_w_in, D, 5 * D, Whgin_t, kb * 64, nb * 32, nb * 32, scr, lane); continue; } r -= I_HGIN;
                if (r < 2 * I_FIN) { const int l = r / I_FIN, q = r % I_FIN, kb = q / 176, nb = q % 176;
                    p0_transpose_item(ffn_w_in + (size_t)l * D * 2 * DFF, D, 2 * DFF, l ? Wfin1_t : Wfin0_t, kb * 64, nb * 32, perm_ffn(nb * 32), scr, lane); continue; } r -= 2 * I_FIN;
                { const int l = r / I_FOUT, q = r % I_FOUT, kb = q / 32, nb = q % 32;
                    p0_transpose_item(ffn_w_out + (size_t)l * DFF * D, DFF, D, l ? Wfout1_t : Wfout0_t, kb * 64, nb * 32, nb * 32, scr, lane); }
            }
        }
    }
    SEAM(0);
    if (IN(1)) {
        const int gw = vcu * NWAVES + wave, NGW = G * NWAVES;
        { const int i = bx * 512 + tid;
          if (i < 2 * 2 * 5 * D) { const int col = i & 1023, s = (i >> 10) % 5, w = (i / (5 * D)) & 1, l = i / (10 * D);
              Gv[i] = (w == 0 ? norm1_g : norm2_g)[l * D + col] * (1.f + mod[((size_t)l * 5 + s) * 6 * D + (w == 0 ? 1 : 4) * D + col]); } }
        for (int n = gw; n < 16384; n += NGW) {
            const bf16_t* Bt; const float* shb; float* dst; int ldb, nn;
            if (n < 5632) { Bt = Wfin0_t; shb = mod + 3 * D; dst = bias_f0; ldb = 5632; nn = n; }
            else if (n < 10752) { Bt = Whgin_t; shb = mod + 5 * 6 * D; dst = bias_hg; ldb = 5120; nn = n - 5632; }
            else { Bt = Wfin1_t; shb = mod + 5 * 6 * D + 3 * D; dst = bias_f1; ldb = 5632; nn = n - 10752; }
            const v4u* wp = (const v4u*)(Bt + (size_t)nn * D + lane * 16); const v4u w0 = wp[0], w1 = wp[1];
            float wf[16];
#pragma unroll
            for (int j = 0; j < 4; ++j) { wf[2 * j] = __builtin_bit_cast(float, w0[j] << 16); wf[2 * j + 1] = __builtin_bit_cast(float, w0[j] & 0xffff0000u);
                wf[8 + 2 * j] = __builtin_bit_cast(float, w1[j] << 16); wf[8 + 2 * j + 1] = __builtin_bit_cast(float, w1[j] & 0xffff0000u); }
#pragma unroll
            for (int s = 0; s < 5; ++s) { const f32x4* sp = (const f32x4*)(shb + (size_t)s * 6 * D + lane * 16); float t = 0.f;
#pragma unroll
                for (int q = 0; q < 4; ++q) { const f32x4 sv = sp[q]; t += (sv[0] * wf[4 * q] + sv[1] * wf[4 * q + 1]) + (sv[2] * wf[4 * q + 2] + sv[3] * wf[4 * q + 3]); }
                t = wave_sum(t); if (lane == 0) dst[(size_t)s * ldb + nn] = t; }
        }
        for (int row = gw; row < MTOT; row += NGW) {
            const float* xr = row < MLAT ? x + (size_t)row * D : ctx + (size_t)(row - MLAT) * D;
            const f32x4* xp = (const f32x4*)xr + lane; f32x4 v[4]; float ss = 0.f;
#pragma unroll
            for (int j = 0; j < 4; ++j) { v[j] = xp[64 * j]; ss += pg8::sq4(v[j]); }
            const float rinv = rsqrtf(wave_sum(ss) * (1.f / D) + EPS);
            const float* mp = mod + (size_t)row_slot(row) * 6 * D;
#pragma unroll
            for (int j = 0; j < 4; ++j) { const int col = 4 * lane + 256 * j;
                const f32x4 g = *(const f32x4*)(norm1_g + col), sc = *(const f32x4*)(mp + D + col), sh = *(const f32x4*)(mp + col);
                const f32x4 y = (v[j] * rinv * g) * (sc + 1.f) + sh;
                v2u o; o.x = pk2(y[0], y[1]); o.y = pk2(y[2], y[3]); *(v2u*)(ABUF + (size_t)row * D + col) = o; }
        }
    }
    SEAM(1);
    const float* mod0 = mod; const float* mod1 = mod + 5 * 6 * D;
    if (IN(2)) {
        pg8::Gemm g{ABUF, Wqkv_t, MTOT, 3 * D, D, D}; pg8::StaticOrder S; S.init(MTOT, 3 * D, G, bx);
        pg8::EpiQKV E{R1, q_gain, k_gain, 0.125f};
        pg8::gemm_phase<pg8::EpiQKV, pg8::StaticOrder, true, true>(lds, g, S, E);
    }
    SEAM(2);
    if (IN(3)) { for (int idx = bx * 512 + tid; idx < MTOT * NAH; idx += G * 512) naive_attn_item(R1, a.in[12], ABUF, idx); }
    SEAM(3);
    if (IN(4)) {
        pg8::Gemm g{ABUF, Wo0_t, MTOT, D, D, D}; pg8::StaticOrder S; S.init(MTOT, D, G, bx);
        pg8::EpiRes E{x, ctx, out, XCTX, mod0 + 2 * D, Gv + (0 * 2 + 1) * 5 * D, ABUF, part};
        E.Aout = R1;
        pg8::gemm_phase<pg8::EpiRes, pg8::StaticOrder, true, true>(lds, g, S, E);
    }
    SEAM(4);
    bf16_t* A2 = R1; bf16_t* HID = R1 + (size_t)MTOT * D;
    if (IN(5)) {
        pg8::Gemm g{A2, Wfin0_t, MTOT, 2 * DFF, D, D}; pg8::StaticOrder S; S.init(MTOT, 2 * DFF, G, bx);
        pg8::EpiSwiglu E{part, bias_f0, HID};
        pg8::gemm_phase<pg8::EpiSwiglu, pg8::StaticOrder, true, true>(lds, g, S, E);
    }
    SEAM(5);
    if (IN(6)) {
        pg8::Gemm g{HID, Wfout0_t, MTOT, D, DFF, DFF}; pg8::StaticOrder S; S.init(MTOT, D, G, bx);
        pg8::EpiRes E{out, XCTX, out, XCTX, mod0 + 5 * D, Gv + (1 * 2 + 0) * 5 * D, ABUF, part};
        pg8::gemm_phase<pg8::EpiRes, pg8::StaticOrder, true, true>(lds, g, S, E);
    }
    SEAM(6);
    if (IN(7)) {
        pg8::Gemm g{ABUF, Whgin_t, MTOT, 5 * D, D, D}; pg8::StaticOrder S; S.init(MTOT, 5 * D, G, bx);
        pg8::EpiHg E{part, bias_hg, R1, lbp};
        pg8::gemm_phase<pg8::EpiHg, pg8::StaticOrder, true, true>(lds, g, S, E);
    }
    SEAM(7);
    if (IN(8)) { if (bx < BATCH * HGH) naive_hgscan(R1, a.in[15], bx, (LAS float*)lds); }
    SEAM(8);
    if (IN(9)) {
        pg8::Gemm g{R1, Whgo_t, MLAT, D, D, 5 * D}; pg8::StaticOrder S; S.init(MLAT, D, G, bx);
        pg8::EpiRes E{out, XCTX, out, XCTX, mod1 + 2 * D, Gv + (1 * 2 + 1) * 5 * D, ABUF, part};
        pg8::gemm_phase<pg8::EpiRes, pg8::StaticOrder, true, true>(lds, g, S, E);
    }
    SEAM(9);
    if (IN(10)) {
        pg8::Gemm g{ABUF, Wfin1_t, MLAT, 2 * DFF, D, D}; pg8::StaticOrder S; S.init(MLAT, 2 * DFF, G, bx);
        pg8::EpiSwiglu E{part, bias_f1, R1};
        pg8::gemm_phase<pg8::EpiSwiglu, pg8::StaticOrder, true, true>(lds, g, S, E);
    }
    SEAM(10);
    if (IN(11)) {
        pg8::Gemm g{R1, Wfout1_t, MLAT, D, DFF, DFF}; pg8::StaticOrder S; S.init(MLAT, D, G, bx);
        pg8::EpiRes E{out, XCTX, out, XCTX, mod1 + 5 * D, nullptr, nullptr, nullptr};
        pg8::gemm_phase<pg8::EpiRes, pg8::StaticOrder, true, true>(lds, g, S, E);
    }
#undef IN
#undef SEAM
}

extern "C" void kernel_launch(void* const* d_in, const int* in_sizes, int n_in, void* d_out, int out_size, void* d_ws, size_t ws_size, hipStream_t stream) {
    static int grid = 0;
    if (grid == 0) {
        if (n_in != 19 || out_size != MLAT * D || ws_size < WS_END) { fprintf(stderr, "kernel_launch: unexpected sizes n_in %d out %d ws %zu\n", n_in, out_size, ws_size); grid = -1; return; }
        int dev = 0, cus = 0, per_cu = 0;
        if (hipGetDevice(&dev) != hipSuccess || hipDeviceGetAttribute(&cus, hipDeviceAttributeMultiprocessorCount, dev) != hipSuccess) { grid = -1; return; }
        if (hipFuncSetAttribute((const void*)mega, hipFuncAttributeMaxDynamicSharedMemorySize, LDS_BYTES) != hipSuccess) { fprintf(stderr, "kernel_launch: hipFuncSetAttribute failed\n"); grid = -1; return; }
        if (hipOccupancyMaxActiveBlocksPerMultiprocessor(&per_cu, (const void*)mega, NWAVES * 64, LDS_BYTES) != hipSuccess || per_cu < 1) { fprintf(stderr, "kernel_launch: occupancy query says %d blocks per CU\n", per_cu); grid = -1; (void)hipGetLastError(); return; }
        (void)hipGetLastError();
        grid = cus;
    }
    if (grid < 0) return;
    (void)hipMemsetAsync((char*)d_ws + WS_CTL, 0, CTL_ZERO_BYTES, stream);
    Args a{};
    for (int i = 0; i < 19; ++i) a.in[i] = (const float*)d_in[i];
    a.out = (float*)d_out; a.ws = (unsigned char*)d_ws;
    auto run = [&](int lo, int hi) { a.ph_lo = lo; a.ph_hi = hi; hipLaunchKernelGGL(mega, dim3(grid), dim3(NWAVES * 64), LDS_BYTES, stream, a); };
    run(0, 12);
}
```

```cpp
#include <hip/hip_runtime.h>
#include <cstdint>
#include <cstdio>

constexpr int D = 1024, BATCH = 4, SEQ = 8192, CTX = 256, MLAT = BATCH * SEQ, MCTX = BATCH * CTX, MTOT = MLAT + MCTX;
constexpr int DFF = 2816, NAH = 16, HGH = 8, GW = 64, ROWS = SEQ / GW;
constexpr float EPS = 1e-6f;
typedef unsigned short bf16_t;
typedef unsigned short f16_t;
#define GAS __attribute__((address_space(1)))
#define LAS __attribute__((address_space(3)))
typedef unsigned v4u __attribute__((ext_vector_type(4)));
typedef unsigned v2u __attribute__((ext_vector_type(2)));
typedef float f32x4 __attribute__((ext_vector_type(4)));
typedef float f32x2 __attribute__((ext_vector_type(2)));
typedef _Float16 h16x2 __attribute__((ext_vector_type(2)));

__device__ __forceinline__ bf16_t f2bf(float f) { unsigned u = __builtin_bit_cast(unsigned, f); return (bf16_t)((u + 0x7fffu + ((u >> 16) & 1u)) >> 16); }
__device__ __forceinline__ float bf2f(bf16_t h) { return __builtin_bit_cast(float, (unsigned)h << 16); }
__device__ __forceinline__ f16_t f2h(float f) { _Float16 h = (_Float16)f; return __builtin_bit_cast(unsigned short, h); }
__device__ __forceinline__ float h2f(f16_t u) { return (float)__builtin_bit_cast(_Float16, u); }
__device__ __forceinline__ unsigned pk2(float lo, float hi) { return (unsigned)f2bf(lo) | ((unsigned)f2bf(hi) << 16); }
__device__ __forceinline__ unsigned pk_h2(float lo, float hi) { f32x2 v = {lo, hi}; h16x2 h = __builtin_convertvector(v, h16x2); return __builtin_bit_cast(unsigned, h); }
__device__ __forceinline__ float silu_f(float x) { return x / (1.f + __expf(-x)); }
__device__ __forceinline__ float sigmoid_f(float x) { return 1.f / (1.f + __expf(-x)); }
__device__ __forceinline__ float fast_sigmoid(float x) { return __builtin_amdgcn_rcpf(1.f + __builtin_amdgcn_exp2f(-1.4426950408889634f * x)); }
__device__ __forceinline__ float fast_silu(float x) { return x * fast_sigmoid(x); }
__device__ __forceinline__ int row_slot(int row) { return row < MLAT ? (row >> 13) : 4; }
__device__ __forceinline__ int row_batch(int row) { return row < MLAT ? (row >> 13) : ((row - MLAT) >> 8); }

constexpr size_t MiB = 1u << 20, KiB = 1024;
constexpr size_t WS_CTL = 0, CTL_ZERO_BYTES = 64 * KiB;
constexpr size_t WS_MOD = 64 * KiB;
constexpr size_t WS_LB = 320 * KiB;
constexpr size_t WS_GV = 336 * KiB;
constexpr size_t WS_BIAS_F0 = 448 * KiB;
constexpr size_t WS_BIAS_HG = 576 * KiB;
constexpr size_t WS_BIAS_F1 = 704 * KiB;
constexpr size_t WS_PART = 1 * MiB;
constexpr size_t WS_XCTX = 4 * MiB;
constexpr size_t WS_WQKV = 8 * MiB, WS_WO0 = 14 * MiB, WS_WHGIN = 16 * MiB, WS_WHGO = 26 * MiB;
constexpr size_t WS_WFIN0 = 28 * MiB, WS_WFIN1 = 39 * MiB, WS_WFOUT0 = 50 * MiB, WS_WFOUT1 = 50 * MiB + 5632 * KiB;
constexpr size_t WS_ABUF = 62 * MiB;
constexpr size_t WS_R1 = 128 * MiB;
constexpr size_t WS_STATE = 458 * MiB;
constexpr size_t WS_END = 512 * MiB;
static_assert(WS_WFOUT1 + (size_t)D * DFF * 2 <= WS_ABUF && WS_ABUF + (size_t)MTOT * D * 2 <= WS_R1 && WS_R1 + (size_t)MTOT * 5120 * 2 <= WS_STATE, "ws map");
static_assert(WS_PART + (size_t)MTOT * 16 * 4 <= WS_XCTX && WS_BIAS_F1 + 5 * 5632 * 4 <= WS_PART && WS_MOD + 2 * 5 * 6144 * 4 <= WS_LB, "ws map small");

namespace pg8 {
#define PG8_LAS __attribute__((address_space(3)))
typedef short bf16x8 __attribute__((ext_vector_type(8)));
typedef unsigned u32x4 __attribute__((ext_vector_type(4)));
constexpr int BM = 256, BK = 64, HALF = 128, HTB = HALF * BK * 2  , STAGE_BYTES = 8 * HTB, NXCD = 8, WGM = 8;

__host__ __device__ __forceinline__ int lds_byte(int r, int c) { const int st = (r >> 4) * 2 + (c >> 5), rr = r & 15, cc = c & 31, ob = rr * 64 + cc * 2; return st * 1024 + (ob ^ (((ob >> 9) & 1) << 5)); }
__host__ __device__ __forceinline__ void stage_rc(int b, int& R, int& C) { const int st = b / 1024, sb = b % 1024, swz = sb ^ (((sb >> 9) & 1) << 5); R = (st >> 1) * 16 + swz / 64; C = (st & 1) * 32 + (swz % 64) / 2; }
__host__ __device__ __forceinline__ int perm32(int rho) { const int n = rho >> 4, i = rho & 15; return 8 * (i >> 2) + 4 * n + (i & 3); }

struct Unit { int pm, pn; };
struct Gemm { const bf16_t* A; const bf16_t* Bt; int M, N, K, lda; };

struct StaticOrder {
    int nM, nN, nwg, G, c;
    __host__ __device__ void init(int M, int N, int G_, int c_) { nM = M / BM; nN = N / BM; nwg = nM * nN; G = G_; c = c_; }
    __host__ __device__ bool next(int i, Unit& u) const {
        const long L = (long)i * G + c; if (L >= nwg) return false;
        int wgid = (int)L; { const int q = nwg / NXCD, r = nwg % NXCD, xcd = wgid % NXCD, off = wgid / NXCD; wgid = (xcd < r ? xcd * (q + 1) : r * (q + 1) + (xcd - r) * q) + off; }
        const int nig = WGM * nN, gid = wgid / nig, fm = gid * WGM, gsz = (nM - fm) < WGM ? (nM - fm) : WGM;
        u.pm = fm + ((wgid % nig) % gsz); u.pn = (wgid % nig) / gsz; return true;
    }
    __device__ __forceinline__ void a_ready(const Unit&) const {}
    __device__ __forceinline__ void done(const Unit&) const {}
};
__device__ __forceinline__ unsigned cvt_pk_bf16(float lo, float hi) { unsigned r; asm volatile("v_cvt_pk_bf16_f32 %0, %1, %2" : "=v"(r) : "v"(lo), "v"(hi)); return r; }

__device__ __forceinline__ float quad_sum(float s) { s += __shfl_xor(s, 16); s += __shfl_xor(s, 32); return s; }
__device__ __forceinline__ float sq4(f32x4 v) { return (v[0] * v[0] + v[1] * v[1]) + (v[2] * v[2] + v[3] * v[3]); }
__device__ __forceinline__ u32x4 pack8(f32x4 a, f32x4 b) { u32x4 w; w.x = cvt_pk_bf16(a[0], a[1]); w.y = cvt_pk_bf16(a[2], a[3]); w.z = cvt_pk_bf16(b[0], b[1]); w.w = cvt_pk_bf16(b[2], b[3]); return w; }
__device__ __forceinline__ float row_rinv(const float* part, int row) {
    const f32x4* p = (const f32x4*)(part + (size_t)row * 16); const f32x4 a = p[0], b = p[1], c = p[2], d = p[3];
    const float s = ((a[0] + a[1]) + (a[2] + a[3])) + ((b[0] + b[1]) + (b[2] + b[3])) + ((c[0] + c[1]) + (c[2] + c[3])) + ((d[0] + d[1]) + (d[2] + d[3]));
    return rsqrtf(s * (1.f / D) + EPS);
}

struct EpiQKV {
    static constexpr bool PERM = true, AFTER_DRAIN = false;
    bf16_t* QKV; const float* qg; const float* kg; float qscale;
    __device__ __forceinline__ void operator()(const f32x4 (&acc)[2][2][4][2], const Unit& u, int wr, int wc, int fr, int fq) const {
        const int type = u.pn >> 2, head = (u.pn & 3) * 4 + wc;
        const int row0 = u.pm * BM + wr * 64 + fr;
        bf16_t* base = QKV + (size_t)type * D + head * 64 + 8 * fq;
        f32x4 gv[2][2];
        if (type < 2) { const float* gp = (type == 0 ? qg : kg) + 8 * fq;
#pragma unroll
            for (int bj = 0; bj < 2; ++bj)
#pragma unroll
                for (int n = 0; n < 2; ++n) gv[bj][n] = *(const f32x4*)(gp + 32 * bj + 4 * n); }
        const float sc = type == 0 ? qscale : 1.f;
#pragma unroll
        for (int ai = 0; ai < 2; ++ai)
#pragma unroll
            for (int m = 0; m < 4; ++m) {
                bf16_t* rowp = base + (size_t)(row0 + ai * HALF + m * 16) * 3072;
                f32x4 v00 = acc[ai][0][m][0], v01 = acc[ai][0][m][1], v10 = acc[ai][1][m][0], v11 = acc[ai][1][m][1];
                if (type < 2) {
                    const float ss = quad_sum((sq4(v00) + sq4(v01)) + (sq4(v10) + sq4(v11)));
                    const float r = rsqrtf(ss * (1.f / 64.f) + EPS) * sc;
                    v00 = v00 * r * gv[0][0]; v01 = v01 * r * gv[0][1]; v10 = v10 * r * gv[1][0]; v11 = v11 * r * gv[1][1];
                }
                *(u32x4*)(rowp) = pack8(v00, v01); *(u32x4*)(rowp + 32) = pack8(v10, v11);
            }
    }
};
struct EpiRes {
    static constexpr bool PERM = true, AFTER_DRAIN = false;
    const float* res_lat; const float* res_ctx; float* out_lat; float* out_ctx; const float* gate; const float* Gn; bf16_t* Aout; float* part;
    __device__ __forceinline__ void operator()(const f32x4 (&acc)[2][2][4][2], const Unit& u, int wr, int wc, int fr, int fq) const {
        const bool lat = u.pm < MLAT / BM; const int slot = lat ? (u.pm >> 5) : 4;
        const size_t trow = lat ? (size_t)u.pm * BM : (size_t)u.pm * BM - MLAT;
        const float* res = (lat ? res_lat : res_ctx) + trow * D; float* out = (lat ? out_lat : out_ctx) + trow * D;
        const int col0 = u.pn * BM + wc * 32 + 8 * fq;
        f32x4 gt[2][2], gn[2][2];
#pragma unroll
        for (int bj = 0; bj < 2; ++bj)
#pragma unroll
            for (int n = 0; n < 2; ++n) { gt[bj][n] = *(const f32x4*)(gate + (size_t)slot * 6 * D + col0 + bj * HALF + 4 * n);
                gn[bj][n] = Gn ? *(const f32x4*)(Gn + (size_t)slot * D + col0 + bj * HALF + 4 * n) : (f32x4){0.f, 0.f, 0.f, 0.f}; }
#pragma unroll
        for (int ai = 0; ai < 2; ++ai)
#pragma unroll
            for (int m = 0; m < 4; ++m) {
                const int r = wr * 64 + ai * HALF + m * 16 + fr; const size_t off = (size_t)r * D + col0;
                f32x4 x[2][2]; float ss = 0.f;
#pragma unroll
                for (int bj = 0; bj < 2; ++bj)
#pragma unroll
                    for (int n = 0; n < 2; ++n) { const f32x4 rv = *(const f32x4*)(res + off + bj * HALF + 4 * n); x[bj][n] = rv + gt[bj][n] * acc[ai][bj][m][n];
                        *(f32x4*)(out + off + bj * HALF + 4 * n) = x[bj][n]; ss += sq4(x[bj][n]); }
                if (Gn) {
                    ss = quad_sum(ss);
                    const size_t grow = (size_t)u.pm * BM + r;
                    if (fq == 0) part[grow * 16 + u.pn * 4 + wc] = ss;
                    bf16_t* ap = Aout + grow * D + col0;
                    *(u32x4*)(ap) = pack8(x[0][0] * gn[0][0], x[0][1] * gn[0][1]); *(u32x4*)(ap + HALF) = pack8(x[1][0] * gn[1][0], x[1][1] * gn[1][1]);
                }
            }
    }
};
struct EpiSwiglu {
    static constexpr bool PERM = true, AFTER_DRAIN = false;
    const float* part; const float* bias; bf16_t* HID;
    __device__ __forceinline__ void operator()(const f32x4 (&acc)[2][2][4][2], const Unit& u, int wr, int wc, int fr, int fq) const {
        const bool lat = u.pm < MLAT / BM; const int slot = lat ? (u.pm >> 5) : 4;
        const int c0 = wc * 32 + 8 * fq;
        const float* bp = bias + (size_t)slot * 2 * DFF + u.pn * BM + c0;
        f32x4 ba[2], bu[2];
#pragma unroll
        for (int n = 0; n < 2; ++n) { ba[n] = *(const f32x4*)(bp + 4 * n); bu[n] = *(const f32x4*)(bp + HALF + 4 * n); }
#pragma unroll
        for (int ai = 0; ai < 2; ++ai)
#pragma unroll
            for (int m = 0; m < 4; ++m) {
                const int row = u.pm * BM + wr * 64 + ai * HALF + m * 16 + fr;
                const float rinv = row_rinv(part, row);
                f32x4 h[2];
#pragma unroll
                for (int n = 0; n < 2; ++n) { const f32x4 a = acc[ai][0][m][n] * rinv + ba[n], uu = acc[ai][1][m][n] * rinv + bu[n];
#pragma unroll
                    for (int j = 0; j < 4; ++j) h[n][j] = fast_silu(a[j]) * uu[j]; }
                *(u32x4*)(HID + (size_t)row * DFF + u.pn * HALF + c0) = pack8(h[0], h[1]);
            }
    }
};
struct EpiHg {
    static constexpr bool PERM = true, AFTER_DRAIN = false;
    const float* part; const float* bias; unsigned short* HGO; const float* lb;
    __device__ __forceinline__ void operator()(const f32x4 (&acc)[2][2][4][2], const Unit& u, int wr, int wc, int fr, int fq) const {
        const bool lat = u.pm < MLAT / BM; const int slot = lat ? (u.pm >> 5) : 4;
        const int type = u.pn >> 2, col0 = u.pn * BM + wc * 32 + 8 * fq;
        f32x4 bv[2][2], lbv[2][2];
#pragma unroll
        for (int bj = 0; bj < 2; ++bj)
#pragma unroll
            for (int n = 0; n < 2; ++n) { bv[bj][n] = *(const f32x4*)(bias + (size_t)slot * 5 * D + col0 + bj * HALF + 4 * n);
                lbv[bj][n] = type >= 3 ? *(const f32x4*)(lb + (col0 - 3 * D) + bj * HALF + 4 * n) : (f32x4){0.f, 0.f, 0.f, 0.f}; }
#pragma unroll
        for (int ai = 0; ai < 2; ++ai)
#pragma unroll
            for (int m = 0; m < 4; ++m) {
                const int row = u.pm * BM + wr * 64 + ai * HALF + m * 16 + fr;
                const float rinv = row_rinv(part, row);
#pragma unroll
                for (int bj = 0; bj < 2; ++bj) {
                    f32x4 v0 = acc[ai][bj][m][0] * rinv + bv[bj][0], v1 = acc[ai][bj][m][1] * rinv + bv[bj][1]; u32x4 w;
                    if (type == 1) w = pack8(v0, v1);
                    else if (type < 3) {
#pragma unroll
                        for (int j = 0; j < 4; ++j) { v0[j] = fast_silu(v0[j]); v1[j] = fast_silu(v1[j]); }
                        w = pack8(v0, v1);
                    } else {
#pragma unroll
                        for (int j = 0; j < 4; ++j) { v0[j] = (1.f - lbv[bj][0][j]) * fast_sigmoid(-v0[j]); v1[j] = (1.f - lbv[bj][1][j]) * fast_sigmoid(-v1[j]); }
                        w.x = pk_h2(v0[0], v0[1]); w.y = pk_h2(v0[2], v0[3]); w.z = pk_h2(v1[0], v1[1]); w.w = pk_h2(v1[2], v1[3]);
                    }
                    *(u32x4*)(HGO + (size_t)row * 5 * D + col0 + bj * HALF) = w;
                }
            }
    }
};

template <class Epi, class Sched, bool ALIGN_EPI = false, bool SP2 = false>
__device__ __forceinline__ void gemm_phase(PG8_LAS unsigned char* lds, const Gemm g, const Sched& S, const Epi& E) {
    const int tid = threadIdx.x, wid = __builtin_amdgcn_readfirstlane(tid >> 6), lane = tid & 63, wr = wid >> 2, wc = wid & 3, fr = lane & 15, fq = lane >> 4;
    const int K = g.K, nt = K / BK;
    unsigned voffA[2], voffB[2];
#pragma unroll
    for (int i = 0; i < 2; ++i) { int R, C; stage_rc(tid * 16 + i * 8192, R, C); const int Rb = Epi::PERM ? ((R & ~31) + perm32(R & 31)) : R;
        voffA[i] = (unsigned)(R * g.lda + C) * 2u; voffB[i] = (unsigned)(Rb * K + C) * 2u; }
    const size_t kstep = (size_t)(BK * 2);
    const size_t hsA = (size_t)HALF * g.lda * 2, hsB = (size_t)HALF * K * 2;
    const size_t tsA = 2 * hsA, tsB = 2 * hsB;
    const unsigned ldsw = (unsigned)wid * 1024u;
    const int aoff = lds_byte(wr * 64 + fr, fq * 8), boff = lds_byte(wc * 32 + fr, fq * 8);
#define PG8_SA(b, h) (((b) * 2 + (h)) * HTB)
#define PG8_SB(b, h) ((4 + (b) * 2 + (h)) * HTB)
#define PG8_STAGE(bufoff, gbase, voff) do { _Pragma("unroll") for (int _i = 0; _i < 2; ++_i) \
        __builtin_amdgcn_global_load_lds((const unsigned*)((const char*)(gbase) + (voff)[_i]), (PG8_LAS unsigned*)(lds + (bufoff) + ldsw + _i * 8192), 16, 0, 0); } while (0)
#define PG8_LDA(dst, b, h) do { _Pragma("unroll") for (int m = 0; m < 4; ++m) _Pragma("unroll") for (int k = 0; k < 2; ++k) dst[m][k] = *(const PG8_LAS bf16x8*)(lds + PG8_SA(b, h) + aoff + m * 2048 + k * 1024); } while (0)
#define PG8_LDB(dst, b, h) do { _Pragma("unroll") for (int n = 0; n < 2; ++n) _Pragma("unroll") for (int k = 0; k < 2; ++k) dst[n][k] = *(const PG8_LAS bf16x8*)(lds + PG8_SB(b, h) + boff + n * 2048 + k * 1024); } while (0)
#define PG8_MMA(ai, bj, At, Bt) do { __builtin_amdgcn_s_setprio(1); _Pragma("unroll") for (int m = 0; m < 4; ++m) _Pragma("unroll") for (int n = 0; n < 2; ++n) _Pragma("unroll") for (int k = 0; k < 2; ++k) \
        acc[ai][bj][m][n] = __builtin_amdgcn_mfma_f32_16x16x32_bf16(Bt[n][k], At[m][k], acc[ai][bj][m][n], 0, 0, 0); __builtin_amdgcn_s_setprio(0); } while (0)
#define PG8_WAIT_V(n) asm volatile("s_waitcnt vmcnt(" #n ")" ::: "memory")
#define PG8_WAIT_L(n) asm volatile("s_waitcnt lgkmcnt(" #n ")" ::: "memory")
#define PG8_BAR __builtin_amdgcn_s_barrier()
#define PG8_SCHED __builtin_amdgcn_sched_barrier(0)
    Unit cur, nxt; int ui = 0;
    if (!S.next(0, cur)) return;
    f32x4 acc[2][2][4][2];
#pragma unroll
    for (int a = 0; a < 2; ++a)
#pragma unroll
        for (int b = 0; b < 2; ++b)
#pragma unroll
            for (int m = 0; m < 4; ++m)
#pragma unroll
                for (int n = 0; n < 2; ++n) acc[a][b][m][n] = (f32x4){0.f, 0.f, 0.f, 0.f};
    bf16x8 At[4][2], B0[2][2], B1[2][2];
    const char* cA = (const char*)g.A + (size_t)cur.pm * tsA; const char* cB = (const char*)g.Bt + (size_t)cur.pn * tsB;
    S.a_ready(cur);
    if constexpr (SP2) {
        PG8_STAGE(PG8_SB(0, 0), cB, voffB); PG8_STAGE(PG8_SB(0, 1), cB + hsB, voffB); PG8_STAGE(PG8_SA(0, 0), cA, voffA); PG8_STAGE(PG8_SA(0, 1), cA + hsA, voffA);
        if (wr == 1) PG8_BAR;
        PG8_WAIT_V(2); PG8_BAR;
        PG8_STAGE(PG8_SB(1, 0), cB + kstep, voffB); PG8_STAGE(PG8_SA(1, 0), cA + kstep, voffA); PG8_STAGE(PG8_SB(1, 1), cB + hsB + kstep, voffB);
        PG8_WAIT_V(6); PG8_BAR;
    } else {
        PG8_STAGE(PG8_SB(0, 0), cB, voffB); PG8_STAGE(PG8_SA(0, 0), cA, voffA); PG8_STAGE(PG8_SB(0, 1), cB + hsB, voffB); PG8_STAGE(PG8_SA(0, 1), cA + hsA, voffA);
        if (wr == 1) PG8_BAR;
        PG8_WAIT_V(4); PG8_BAR;
        PG8_STAGE(PG8_SB(1, 0), cB + kstep, voffB); PG8_STAGE(PG8_SA(1, 0), cA + kstep, voffA); PG8_STAGE(PG8_SB(1, 1), cB + hsB + kstep, voffB);
        PG8_WAIT_V(6); PG8_BAR;
    }
    for (;;) {
        const bool has_next = S.next(ui + 1, nxt);
        const char* nA = has_next ? (const char*)g.A + (size_t)nxt.pm * tsA : cA; const char* nB = has_next ? (const char*)g.Bt + (size_t)nxt.pn * tsB : cB;
        for (int t = 0; t < nt; t += 2) {
            const bool last = (t == nt - 2);
            const char* a1 = cA + (size_t)(t + 1) * kstep;
            const char* a2 = last ? nA : cA + (size_t)(t + 2) * kstep; const char* b2 = last ? nB : cB + (size_t)(t + 2) * kstep;
            const char* a3 = a2 + kstep; const char* b3 = b2 + kstep;
            if (last && has_next) S.a_ready(nxt);
            if constexpr (SP2) {
            PG8_LDB(B0, 0, 0); PG8_LDB(B1, 0, 1); PG8_SCHED; PG8_LDA(At, 0, 0); PG8_STAGE(PG8_SA(1, 1), a1 + hsA, voffA);
            PG8_WAIT_V(8); PG8_WAIT_L(0); PG8_BAR; PG8_MMA(0, 0, At, B0); PG8_MMA(0, 1, At, B1); PG8_BAR; PG8_SCHED;
            PG8_LDA(At, 0, 1); PG8_STAGE(PG8_SB(0, 0), b2, voffB); PG8_STAGE(PG8_SB(0, 1), b2 + hsB, voffB); PG8_STAGE(PG8_SA(0, 0), a2, voffA);
            PG8_WAIT_V(8); PG8_WAIT_L(0); PG8_BAR; PG8_MMA(1, 0, At, B0); PG8_MMA(1, 1, At, B1); PG8_BAR; PG8_SCHED;
            PG8_LDB(B0, 1, 0); PG8_LDB(B1, 1, 1); PG8_SCHED; PG8_LDA(At, 1, 0); PG8_STAGE(PG8_SA(0, 1), a2 + hsA, voffA);
            PG8_WAIT_V(8); PG8_WAIT_L(0); PG8_BAR; PG8_MMA(0, 0, At, B0); PG8_MMA(0, 1, At, B1); PG8_BAR; PG8_SCHED;
            PG8_LDA(At, 1, 1); PG8_STAGE(PG8_SB(1, 0), b3, voffB); PG8_STAGE(PG8_SB(1, 1), b3 + hsB, voffB); PG8_STAGE(PG8_SA(1, 0), a3, voffA);
            PG8_WAIT_V(8); PG8_WAIT_L(0); PG8_BAR; PG8_MMA(1, 0, At, B0); PG8_MMA(1, 1, At, B1); PG8_BAR; PG8_SCHED;
            } else {
            PG8_LDB(B0, 0, 0); PG8_SCHED; PG8_LDA(At, 0, 0); PG8_STAGE(PG8_SA(1, 1), a1 + hsA, voffA);
            PG8_WAIT_L(8); PG8_BAR; PG8_WAIT_L(0); PG8_MMA(0, 0, At, B0); PG8_BAR; PG8_SCHED;
            PG8_LDB(B1, 0, 1); PG8_STAGE(PG8_SB(0, 0), b2, voffB);
            PG8_BAR; PG8_WAIT_L(0); PG8_MMA(0, 1, At, B1); PG8_BAR;
            PG8_LDA(At, 0, 1); PG8_STAGE(PG8_SA(0, 0), a2, voffA);
            PG8_BAR; PG8_WAIT_L(0); PG8_MMA(1, 0, At, B0); PG8_BAR; PG8_SCHED;
            PG8_STAGE(PG8_SB(0, 1), b2 + hsB, voffB);
            PG8_WAIT_V(6); PG8_BAR; PG8_MMA(1, 1, At, B1); PG8_BAR;
            PG8_LDB(B0, 1, 0); PG8_SCHED; PG8_LDA(At, 1, 0); PG8_STAGE(PG8_SA(0, 1), a2 + hsA, voffA);
            PG8_WAIT_L(8); PG8_BAR; PG8_WAIT_L(0); PG8_MMA(0, 0, At, B0); PG8_BAR; PG8_SCHED;
            PG8_LDB(B1, 1, 1); PG8_STAGE(PG8_SB(1, 0), b3, voffB);
            PG8_BAR; PG8_WAIT_L(0); PG8_MMA(0, 1, At, B1); PG8_BAR;
            PG8_LDA(At, 1, 1); PG8_STAGE(PG8_SA(1, 0), a3, voffA);
            PG8_BAR; PG8_WAIT_L(0); PG8_MMA(1, 0, At, B0); PG8_BAR; PG8_SCHED;
            PG8_STAGE(PG8_SB(1, 1), b3 + hsB, voffB);
            PG8_WAIT_V(6); PG8_BAR; PG8_MMA(1, 1, At, B1); PG8_BAR;
            }
        }
        if constexpr (ALIGN_EPI) { if (wr == 0) PG8_BAR; }
        if constexpr (!Epi::AFTER_DRAIN) { E(acc, cur, wr, wc, fr, fq); S.done(cur); }
        if (!has_next) break;
#pragma unroll
        for (int a = 0; a < 2; ++a)
#pragma unroll
            for (int b = 0; b < 2; ++b)
#pragma unroll
                for (int m = 0; m < 4; ++m)
#pragma unroll
                    for (int n = 0; n < 2; ++n) acc[a][b][m][n] = (f32x4){0.f, 0.f, 0.f, 0.f};
        cur = nxt; cA = nA; cB = nB; ++ui;
        if constexpr (ALIGN_EPI) { if (wr == 1) PG8_BAR; }
    }
    PG8_WAIT_V(0);
    if constexpr (!ALIGN_EPI) { if (wr == 0) PG8_BAR; }
    PG8_BAR;
    if constexpr (Epi::AFTER_DRAIN) { E.fused(acc, cur, wr, wc, fr, fq, lds, wid, lane); S.done(cur); }
#undef PG8_SA
#undef PG8_SB
#undef PG8_STAGE
#undef PG8_LDA
#undef PG8_LDB
#undef PG8_MMA
#undef PG8_WAIT_V
#undef PG8_WAIT_L
#undef PG8_BAR
#undef PG8_SCHED
}

}


#define XB_TMO      128
#define XB_XCNT(j)  (256  + 64 * (j))
#define XB_XSUB(j)  (1280 + 64 * (j))
#define XB_XGEN(j)  (2304 + 64 * (j))
#define XB_TOP      3328
#define XB_TOPGEN   3392
#define XCD_BAR_WORDS 3456
#define XB_SPIN_CAP (1u << 20)

__device__ __forceinline__ unsigned xb_ld(unsigned* p)              { return __hip_atomic_load(p, __ATOMIC_RELAXED, __HIP_MEMORY_SCOPE_AGENT); }
__device__ __forceinline__ unsigned xb_add(unsigned* p, unsigned v) { return __hip_atomic_fetch_add(p, v, __ATOMIC_RELAXED, __HIP_MEMORY_SCOPE_AGENT); }
__device__ __forceinline__ unsigned xb_xcc_id() { return (unsigned)__builtin_amdgcn_s_getreg((3 << 11) | 20) & 0xFu; }
#define XB_SPIN(cond, bar) do { unsigned _sp = 0; while (cond) { __builtin_amdgcn_s_sleep(1); \
    if ((++_sp & 255u) == 0u) { if (xb_ld(&(bar)[XB_TMO])) break; if (_sp > XB_SPIN_CAP) { atomicAdd(&(bar)[XB_TMO], 1u); break; } } } } while (0)

struct XcdBarrier {
    unsigned* bar; unsigned x;
    volatile LAS unsigned* st;
};

__device__ __forceinline__ XcdBarrier xcd_barrier_post(unsigned* bar, volatile LAS unsigned* st) {
    XcdBarrier b; b.bar = bar; b.x = xb_xcc_id(); b.st = st;
    if (threadIdx.x == 0) (void)xb_add(&bar[XB_XCNT(b.x)], 1u);
    return b;
}
__device__ __forceinline__ void xcd_barrier_complete(unsigned* bar, unsigned x, unsigned& nloc, unsigned& nx) {
    const unsigned G = gridDim.x * gridDim.y * gridDim.z;
    unsigned sum, cnt, mine, sp = 0u;
    for (;;) {
        sum = 0u; cnt = 0u; mine = 0u;
#pragma unroll
        for (unsigned j = 0; j < 16; ++j) { const unsigned c = xb_ld(&bar[XB_XCNT(j)]); sum += c; cnt += (c > 0u) ? 1u : 0u; mine = (j == x) ? c : mine; }
        if (sum == G) break;
        __builtin_amdgcn_s_sleep(1);
        if ((++sp & 255u) == 0u) { if (xb_ld(&bar[XB_TMO])) break; if (sp > XB_SPIN_CAP) { atomicAdd(&bar[XB_TMO], 1u); break; } }
    }
    nloc = mine > 0u ? mine : 1u; nx = cnt > 0u ? cnt : 1u;
}

__device__ __forceinline__ void xcd_barrier(const XcdBarrier& b) {
    asm volatile("s_waitcnt vmcnt(0)" ::: "memory");
    __syncthreads();
    if (threadIdx.x == 0) {
        unsigned* bar = b.bar;
        __builtin_amdgcn_s_waitcnt(0);
        unsigned nloc = b.st[0], nx = b.st[1];
        if (nloc == 0u) { xcd_barrier_complete(bar, b.x, nloc, nx); b.st[0] = nloc; b.st[1] = nx; }
        const unsigned old = xb_add(&bar[XB_XSUB(b.x)], 1u);
        const unsigned gen = old / nloc;
        if (old + 1u == (gen + 1u) * nloc) {
            __builtin_amdgcn_fence(__ATOMIC_RELEASE, "agent");
            asm volatile("s_waitcnt vmcnt(0)" ::: "memory");
            const unsigned og = xb_add(&bar[XB_TOP], 1u);
            const unsigned tg = og / nx;
            if (og + 1u == (tg + 1u) * nx) xb_add(&bar[XB_TOPGEN], 1u);
            else XB_SPIN(xb_ld(&bar[XB_TOPGEN]) == tg, bar);
            __builtin_amdgcn_fence(__ATOMIC_ACQUIRE, "agent");
            xb_add(&bar[XB_XGEN(b.x)], 1u);
            asm volatile("s_waitcnt vmcnt(0)" ::: "memory");
        } else {
            XB_SPIN(xb_ld(&bar[XB_XGEN(b.x)]) == gen, bar);
            __builtin_amdgcn_fence(__ATOMIC_ACQUIRE, "agent");
            asm volatile("s_waitcnt vmcnt(0)" ::: "memory");
        }
    }
    __syncthreads();
}

namespace na {
typedef short bf16x8 __attribute__((ext_vector_type(8)));
typedef short s16x4 __attribute__((ext_vector_type(4)));
typedef float f32x16 __attribute__((ext_vector_type(16)));
constexpr float LOG2E = 1.4426950408889634f;
constexpr int KOFF = 0, VOFF = 16384, BOFF = 32768;
constexpr int N_LAT_UNITS = BATCH * NAH * (ROWS / 4), N_UNITS = N_LAT_UNITS + BATCH * NAH;
__device__ __forceinline__ s16x4 vtr(const LAS unsigned char* p) { return __builtin_bit_cast(s16x4, __builtin_amdgcn_ds_read_tr16_b64_v4i16((LAS s16x4*)p)); }
__device__ __forceinline__ int clampi(int v, int lo, int hi) { return v < lo ? lo : (v > hi ? hi : v); }

__device__ __forceinline__ void attn_phase(LAS unsigned char* lds, const bf16_t* QKV, const float* rpb, bf16_t* O, int G, int vcu) {
    const int tid = threadIdx.x, lane = tid & 63, wave = __builtin_amdgcn_readfirstlane(tid >> 6), r32 = lane & 31, hi = lane >> 5;
    LAS float* biasL = (LAS float*)(lds + BOFF);
    const int lkey = tid >> 3, lc16 = tid & 7;
    const int kwoff = lkey * 128 + ((lc16 ^ ((lkey >> 1) & 7)) * 16);
    const int vwoff = lkey * 128 + (((lc16 >> 1) ^ (2 * ((lkey >> 1) & 1))) * 32) + (lc16 & 1) * 16;
    const int kroff = r32 * 128, kswz = (r32 >> 1) & 7;
    const int i16 = lane & 15, g16 = (lane >> 4) & 1;
    for (int it = 0;; ++it) {
        const int u = it * G + vcu; if (u >= N_UNITS) break;
        const bool is_ctx = u >= N_LAT_UNITS;
        int b, h, R;
        if (!is_ctx) { b = u >> 9; h = (u >> 5) & 15; R = u & 31; } else { const int v = u - N_LAT_UNITS; b = v >> 4; h = v & 15; R = 0; }
        const int r = 4 * R + (wave >> 1), c0 = 32 * (wave & 1);
        const int qrow0 = is_ctx ? MLAT + b * CTX + wave * 32 : b * SEQ + r * GW + c0;
        const int rs = clampi(r - 4, 0, ROWS - 8);
        const int kr_lo = is_ctx ? 0 : clampi(4 * R - 4, 0, ROWS - 8), kr_hi = is_ctx ? 0 : clampi(4 * R - 1, 0, ROWS - 8) + 8;
        const int ntl = kr_hi - kr_lo, NT = ntl + 4;
        if (it > 0) __syncthreads();
        if (tid < 15 * 31) biasL[tid] = rpb[h * 15 * 31 + tid];
        bf16x8 qr[4];
#pragma unroll
        for (int ks = 0; ks < 4; ++ks) qr[ks] = *(const bf16x8*)(QKV + (size_t)(qrow0 + r32) * 3072 + h * 64 + ks * 16 + hi * 8);
        float m = -INFINITY, lsum = 0.f; f32x16 o0 = {}, o1 = {};
        v4u kreg, vreg;
        { const int row0 = ntl > 0 ? b * SEQ + kr_lo * GW : MLAT + b * CTX;
          const bf16_t* kp = QKV + (size_t)(row0 + lkey) * 3072 + D + h * 64 + lc16 * 8; kreg = *(const v4u*)kp; vreg = *(const v4u*)(kp + D); }
        for (int t = 0; t < NT; ++t) {
            const int buf = t & 1;
            *(LAS v4u*)(lds + KOFF + buf * 8192 + kwoff) = kreg;
            *(LAS v4u*)(lds + VOFF + buf * 8192 + vwoff) = vreg;
            if (t + 1 < NT) { const int t1 = t + 1; const int row0 = t1 < ntl ? b * SEQ + (kr_lo + t1) * GW : MLAT + b * CTX + (t1 - ntl) * 64;
                const bf16_t* kp = QKV + (size_t)(row0 + lkey) * 3072 + D + h * 64 + lc16 * 8; kreg = *(const v4u*)kp; vreg = *(const v4u*)(kp + D); }
            __syncthreads();
            const bool local = t < ntl; const int kr = kr_lo + t;
            const bool need = !local || (kr >= rs && kr < rs + 8);
            if (need) {
                const LAS unsigned char* Kb = lds + KOFF + buf * 8192; const LAS unsigned char* Vb = lds + VOFF + buf * 8192;
                f32x16 p0 = {}, p1 = {};
#pragma unroll
                for (int ks = 0; ks < 4; ++ks) {
                    const int co = ((2 * ks + hi) ^ kswz) * 16;
                    const bf16x8 a0 = *(const LAS bf16x8*)(Kb + kroff + co), a1 = *(const LAS bf16x8*)(Kb + 4096 + kroff + co);
                    p0 = __builtin_amdgcn_mfma_f32_32x32x16_bf16(a0, qr[ks], p0, 0, 0, 0);
                    p1 = __builtin_amdgcn_mfma_f32_32x32x16_bf16(a1, qr[ks], p1, 0, 0, 0);
                }
                if (local) {
                    const int qc = c0 + r32, cs = clampi(qc - 8, 0, GW - 16);
                    const LAS float* brow = biasL + (kr - r + 7) * 31 + (15 - qc);
#pragma unroll
                    for (int reg = 0; reg < 16; ++reg) { const int kc0 = (reg & 3) + 8 * (reg >> 2) + 4 * hi, kc1 = kc0 + 32;
                        p0[reg] = (kc0 >= cs && kc0 < cs + 16) ? p0[reg] + brow[kc0] : -INFINITY;
                        p1[reg] = (kc1 >= cs && kc1 < cs + 16) ? p1[reg] + brow[kc1] : -INFINITY; }
                }
                float mx = fmaxf(p0[0], p1[0]);
#pragma unroll
                for (int reg = 1; reg < 16; ++reg) mx = fmaxf(mx, fmaxf(p0[reg], p1[reg]));
                mx = fmaxf(mx, __shfl_xor(mx, 32));
                const float mn = fmaxf(m, mx);
                const float alpha = __builtin_amdgcn_exp2f((m - mn) * LOG2E);
                m = mn; lsum *= alpha; o0 = o0 * alpha; o1 = o1 * alpha;
                const float nm = -mn * LOG2E; float ps = 0.f;
#pragma unroll
                for (int reg = 0; reg < 16; ++reg) { p0[reg] = __builtin_amdgcn_exp2f(__builtin_fmaf(p0[reg], LOG2E, nm)); p1[reg] = __builtin_amdgcn_exp2f(__builtin_fmaf(p1[reg], LOG2E, nm)); ps += p0[reg] + p1[reg]; }
                lsum += ps;
#pragma unroll
                for (int kb = 0; kb < 2; ++kb)
#pragma unroll
                    for (int s2 = 0; s2 < 2; ++s2) {
                        const f32x16& pp = kb == 0 ? p0 : p1;
                        v4u pw; pw.x = pg8::cvt_pk_bf16(pp[8 * s2 + 0], pp[8 * s2 + 1]); pw.y = pg8::cvt_pk_bf16(pp[8 * s2 + 2], pp[8 * s2 + 3]);
                        pw.z = pg8::cvt_pk_bf16(pp[8 * s2 + 4], pp[8 * s2 + 5]); pw.w = pg8::cvt_pk_bf16(pp[8 * s2 + 6], pp[8 * s2 + 7]);
                        const bf16x8 pf = __builtin_bit_cast(bf16x8, pw);
                        const int rowA = 32 * kb + 16 * s2 + 4 * hi + (i16 >> 2);
                        const int vswz = 2 * ((i16 >> 3) & 1);
#pragma unroll
                        for (int db = 0; db < 2; ++db) {
                            const int c32 = (2 * db + g16) ^ vswz;
                            const LAS unsigned char* pa = Vb + rowA * 128 + c32 * 32 + 8 * (i16 & 3);
                            const s16x4 lo = vtr(pa), hi4 = vtr(pa + 8 * 128);
                            const bf16x8 vf = {lo[0], lo[1], lo[2], lo[3], hi4[0], hi4[1], hi4[2], hi4[3]};
                            if (db == 0) o0 = __builtin_amdgcn_mfma_f32_32x32x16_bf16(vf, pf, o0, 0, 0, 0);
                            else o1 = __builtin_amdgcn_mfma_f32_32x32x16_bf16(vf, pf, o1, 0, 0, 0);
                        }
                    }
            }
        }
        lsum += __shfl_xor(lsum, 32);
        const float rl = 1.f / lsum;
        bf16_t* op = O + (size_t)(qrow0 + r32) * D + h * 64 + 4 * hi;
#pragma unroll
        for (int g = 0; g < 4; ++g) {
            v2u w0, w1;
            w0.x = pg8::cvt_pk_bf16(o0[4 * g] * rl, o0[4 * g + 1] * rl); w0.y = pg8::cvt_pk_bf16(o0[4 * g + 2] * rl, o0[4 * g + 3] * rl);
            w1.x = pg8::cvt_pk_bf16(o1[4 * g] * rl, o1[4 * g + 1] * rl); w1.y = pg8::cvt_pk_bf16(o1[4 * g + 2] * rl, o1[4 * g + 3] * rl);
            *(v2u*)(op + 8 * g) = w0; *(v2u*)(op + 32 + 8 * g) = w1;
        }
    }
}
}


namespace hg {
typedef short bf16x8 __attribute__((ext_vector_type(8)));
typedef short s16x4 __attribute__((ext_vector_type(4)));
constexpr int RAWQ = 0, RAWK = 16384, RAWV = 32768, QI = 49152, QS = 65536, KI = 81920, KST = 98304, AM = 114688, TOT = 122880, DL = 126976, RED = 127488;
constexpr int NSLOT = 9;
constexpr size_t STATE_SLOT_F = 128 * 128;
constexpr size_t WS_DEC_OFF = (size_t)64 * NSLOT * STATE_SLOT_F * 4;
__device__ __forceinline__ s16x4 vtr(const LAS unsigned char* p) { return __builtin_bit_cast(s16x4, __builtin_amdgcn_ds_read_tr16_b64_v4i16((LAS s16x4*)p)); }
__device__ __forceinline__ int fv(int row) { return (row & 3) + 4 * ((row >> 3) & 1); }
#define HG_BAR() do { asm volatile("s_waitcnt vmcnt(0) lgkmcnt(0)" ::: "memory"); __builtin_amdgcn_s_barrier(); asm volatile("" ::: "memory"); } while (0)
#define HG_LBAR() do { asm volatile("s_waitcnt lgkmcnt(0)" ::: "memory"); __builtin_amdgcn_s_barrier(); asm volatile("" ::: "memory"); } while (0)

struct Stage { v4u q[2], k[2], v[2]; };
template <bool WITH_Q> __device__ __forceinline__ void stage_load(Stage& st, const unsigned short* HGO, int row0, int h, int dir, int tid) {
#pragma unroll
    for (int i = 0; i < 2; ++i) { const int p = tid + 512 * i, row = p >> 4, c16 = p & 15;
        const unsigned short* src = HGO + (size_t)(row0 + row) * 5120 + h * 128 + c16 * 8;
        if (WITH_Q) st.q[i] = *(const v4u*)src;
        st.v[i] = *(const v4u*)(src + D); st.k[i] = *(const v4u*)(src + (3 + dir) * D); }
}
template <bool WITH_Q> __device__ __forceinline__ void stage_store(const Stage& st, LAS unsigned char* lds, int tid) {
#pragma unroll
    for (int i = 0; i < 2; ++i) { const int p = tid + 512 * i, row = p >> 4, c16 = p & 15;
        const int o16 = row * 256 + ((c16 ^ (row & 15)) * 16);
        if (WITH_Q) *(LAS v4u*)(lds + RAWQ + o16) = st.q[i];
        *(LAS v4u*)(lds + RAWK + o16) = st.k[i];
        *(LAS v4u*)(lds + RAWV + row * 256 + (((c16 >> 1) ^ fv(row)) * 32) + (c16 & 1) * 16) = st.v[i]; }
}
template <bool FULL> __device__ __forceinline__ void prep(LAS unsigned char* lds, int dir, int tid) {
    const int kp = tid & 63, seg = tid >> 6;
    float kg[8][2], c[8][2];
#pragma unroll
    for (int i = 0; i < 8; ++i) { const int t = 8 * seg + i;
        const unsigned kk = *(const LAS unsigned*)(lds + RAWK + t * 256 + (((kp >> 2) ^ (t & 15)) * 16) + (kp & 3) * 4);
        kg[i][0] = h2f((f16_t)(kk & 0xffffu)); kg[i][1] = h2f((f16_t)(kk >> 16));
        c[i][0] = __logf(1.f - kg[i][0]); c[i][1] = __logf(1.f - kg[i][1]); }
    if (dir == 0) {
#pragma unroll
        for (int i = 1; i < 8; ++i) { c[i][0] += c[i - 1][0]; c[i][1] += c[i - 1][1]; }
    } else {
#pragma unroll
        for (int i = 6; i >= 0; --i) { c[i][0] += c[i + 1][0]; c[i][1] += c[i + 1][1]; }
    }
    { f32x2 t2; t2.x = dir == 0 ? c[7][0] : c[0][0]; t2.y = dir == 0 ? c[7][1] : c[0][1]; *(LAS f32x2*)(lds + TOT + (seg * 128 + 2 * kp) * 4) = t2; }
    HG_LBAR();
    float off[2] = {0.f, 0.f}, bend[2] = {0.f, 0.f}, bref[2] = {0.f, 0.f};
#pragma unroll
    for (int s2 = 0; s2 < 8; ++s2) { const f32x2 t2 = *(const LAS f32x2*)(lds + TOT + (s2 * 128 + 2 * kp) * 4);
        bend[0] += t2.x; bend[1] += t2.y;
        const bool before = dir == 0 ? (s2 < seg) : (s2 > seg); if (before) { off[0] += t2.x; off[1] += t2.y; }
        const bool inref = dir == 0 ? (s2 < 4) : (s2 >= 4); if (inref) { bref[0] += t2.x; bref[1] += t2.y; } }
    unsigned kst[2][4];
#pragma unroll
    for (int i = 0; i < 8; ++i) { const int t = 8 * seg + i;
        const float b0 = off[0] + c[i][0], b1 = off[1] + c[i][1];
        const float ks0 = kg[i][0] * __expf(bend[0] - b0), ks1 = kg[i][1] * __expf(bend[1] - b1);
        if (i & 1) { kst[0][i >> 1] |= (unsigned)f2bf(ks0) << 16; kst[1][i >> 1] |= (unsigned)f2bf(ks1) << 16; } else { kst[0][i >> 1] = f2bf(ks0); kst[1][i >> 1] = f2bf(ks1); }
        if (FULL) {
            const int o4 = t * 256 + (((kp >> 2) ^ (t & 15)) * 16) + (kp & 3) * 4;
            const unsigned qq = *(const LAS unsigned*)(lds + RAWQ + o4);
            const float q0 = bf2f((bf16_t)(qq & 0xffffu)), q1 = bf2f((bf16_t)(qq >> 16));
            const float e10 = __expf(fminf(b0 - bref[0], 80.f)), e11 = __expf(fminf(b1 - bref[1], 80.f));
            const float e20 = __expf(fminf(bref[0] - b0, 80.f)), e21 = __expf(fminf(bref[1] - b1, 80.f));
            *(LAS unsigned*)(lds + QI + o4) = pk2(q0 * e10, q1 * e11);
            *(LAS unsigned*)(lds + KI + o4) = pk2(kg[i][0] * e20, kg[i][1] * e21);
            *(LAS unsigned*)(lds + QS + o4) = pk2(q0 * __expf(b0), q1 * __expf(b1));
        }
    }
#pragma unroll
    for (int ch = 0; ch < 2; ++ch) { const int k = 2 * kp + ch; v4u w; w.x = kst[ch][0]; w.y = kst[ch][1]; w.z = kst[ch][2]; w.w = kst[ch][3];
        *(LAS v4u*)(lds + KST + k * 128 + ((seg ^ (kp & 7)) * 16)) = w; }
    if (seg == 0) { f32x2 d2; d2.x = __expf(bend[0]); d2.y = __expf(bend[1]); *(LAS f32x2*)(lds + DL + 2 * kp * 4) = d2; }
    HG_LBAR();
}
__device__ __forceinline__ void load_vB(bf16x8 (&vB)[2], const LAS unsigned char* lds, int wave, int lane) {
    const int i16 = lane & 15, g = lane >> 4;
#pragma unroll
    for (int ks = 0; ks < 2; ++ks) { const int rA = 32 * ks + 8 * g + (i16 >> 2);
        const LAS unsigned char* pa = lds + RAWV + rA * 256 + ((wave ^ fv(rA)) * 32) + 8 * (i16 & 3);
        const s16x4 lo = vtr(pa), hi4 = vtr(pa + 4 * 256);
        vB[ks] = (bf16x8){lo[0], lo[1], lo[2], lo[3], hi4[0], hi4[1], hi4[2], hi4[3]}; }
}
__device__ __forceinline__ void state_update(f32x4 (&S)[8], const bf16x8 (&vB)[2], const LAS unsigned char* lds, int lane) {
    const int i16 = lane & 15, g = lane >> 4;
#pragma unroll
    for (int kb = 0; kb < 8; ++kb) { const int k = 16 * kb + i16;
        const f32x4 d4 = *(const LAS f32x4*)(lds + DL + (16 * kb + 4 * g) * 4);
        f32x4 acc = S[kb] * d4;
#pragma unroll
        for (int ks = 0; ks < 2; ++ks) { const bf16x8 a = *(const LAS bf16x8*)(lds + KST + k * 128 + (((4 * ks + g) ^ ((k >> 1) & 7)) * 16));
            acc = __builtin_amdgcn_mfma_f32_16x16x32_bf16(a, vB[ks], acc, 0, 0, 0); }
        S[kb] = acc; }
}
__device__ __forceinline__ f32x4* state_ptr(float* base, int chain, int slot) { return (f32x4*)(base + ((size_t)chain * NSLOT + slot) * STATE_SLOT_F); }

__device__ __forceinline__ void phase1(LAS unsigned char* lds, const unsigned short* HGO, float* STATE, int G, int vcu) {
    const int tid = threadIdx.x, lane = tid & 63, wave = __builtin_amdgcn_readfirstlane(tid >> 6);
    float* DEC = STATE + WS_DEC_OFF / 4;
    for (int it = 0;; ++it) {
        const int u = it * G + vcu; if (u >= 512) break;
        int chain, pi; if (u < 448) { chain = u / 7; pi = 1 + u % 7; } else { chain = u - 448; pi = 0; }
        const int b = chain >> 4, h = (chain >> 1) & 7, dir = chain & 1;
        const int nch = pi == 0 ? 4 : 16;
        const int base = pi == 0 ? MLAT + b * CTX : b * SEQ + (dir == 0 ? pi - 1 : 8 - pi) * 1024;
        f32x4 S[8];
#pragma unroll
        for (int kb = 0; kb < 8; ++kb) S[kb] = (f32x4){0.f, 0.f, 0.f, 0.f};
        float dtot[2] = {1.f, 1.f};
        Stage st; stage_load<false>(st, HGO, base + (dir == 0 ? 0 : nch - 1) * 64, h, dir, tid);
        for (int ci = 0; ci < nch; ++ci) {
            HG_BAR();
            stage_store<false>(st, lds, tid);
            if (ci + 1 < nch) { const int cn = dir == 0 ? ci + 1 : nch - 2 - ci; stage_load<false>(st, HGO, base + cn * 64, h, dir, tid); }
            HG_LBAR();
            prep<false>(lds, dir, tid);
            { const f32x2 d2 = *(const LAS f32x2*)(lds + DL + 2 * (tid & 63) * 4); dtot[0] *= d2.x; dtot[1] *= d2.y; }
            bf16x8 vB[2]; load_vB(vB, lds, wave, lane);
            state_update(S, vB, lds, lane);
        }
        f32x4* sp = state_ptr(STATE, chain, pi) + (size_t)wave * 8 * 64 + lane;
#pragma unroll
        for (int kb = 0; kb < 8; ++kb) sp[kb * 64] = S[kb];
        if (tid < 64) { f32x2 d2; d2.x = dtot[0]; d2.y = dtot[1]; *(f32x2*)(DEC + ((size_t)chain * NSLOT + pi) * 128 + 2 * tid) = d2; }
    }
}
__device__ __forceinline__ void phase2(float* STATE, int G, int bx) {
    const float* DEC = STATE + WS_DEC_OFF / 4;
    for (int e = bx * 512 + (int)threadIdx.x; e < 64 * 4096; e += G * 512) {
        const int chain = e >> 12, r = e & 4095, kb = (r >> 6) & 7, lane = r & 63;
        f32x4* sp = state_ptr(STATE, chain, 0) + r;
        f32x4 run = sp[0];
#pragma unroll
        for (int i = 1; i < NSLOT; ++i) {
            f32x4 tmp = {0.f, 0.f, 0.f, 0.f}, d4 = {0.f, 0.f, 0.f, 0.f};
            if (i < NSLOT - 1) { tmp = sp[(size_t)i * 4096]; d4 = *(const f32x4*)(DEC + ((size_t)chain * NSLOT + i) * 128 + 16 * kb + 4 * (lane >> 4)); }
            sp[(size_t)i * 4096] = run;
            run = d4 * run + tmp;
        }
    }
}
__device__ __forceinline__ void phase3(LAS unsigned char* lds, unsigned short* HGO, float* STATE, const float* norm_g, int G, int vcu) {
    const int tid = threadIdx.x, lane = tid & 63, wave = __builtin_amdgcn_readfirstlane(tid >> 6), i16 = lane & 15, g = lane >> 4;
    for (int it = 0;; ++it) {
        const int u = it * G + vcu; if (u >= 256) break;
        const int b = u >> 6, h = (u >> 3) & 7, j = u & 7;
        const int base = b * SEQ + j * 1024;
        const float ng = norm_g[16 * wave + i16];
        for (int dir = 0; dir < 2; ++dir) {
            const int chain = (b * 8 + h) * 2 + dir, pi = dir == 0 ? j + 1 : 8 - j;
            f32x4 S[8];
            { const f32x4* sp = state_ptr(STATE, chain, pi) + (size_t)wave * 8 * 64 + lane;
#pragma unroll
              for (int kb = 0; kb < 8; ++kb) S[kb] = sp[kb * 64]; }
            Stage st; stage_load<true>(st, HGO, base + (dir == 0 ? 0 : 15) * 64, h, dir, tid);
            for (int ci = 0; ci < 16; ++ci) {
                const int cc = dir == 0 ? ci : 15 - ci, row0 = base + cc * 64;
                HG_BAR();
                stage_store<true>(st, lds, tid);
                if (ci + 1 < 16) { const int cn = dir == 0 ? ci + 1 : 14 - ci; stage_load<true>(st, HGO, base + cn * 64, h, dir, tid); }
                HG_LBAR();
                prep<true>(lds, dir, tid);
#pragma unroll
                for (int pp = 0; pp < 2; ++pp) { const int p = 2 * wave + pp, sb = p >> 2, tb = p & 3;
                    f32x4 acc = {0.f, 0.f, 0.f, 0.f};
                    const int sr = 16 * sb + i16, tr = 16 * tb + i16;
#pragma unroll
                    for (int ks = 0; ks < 4; ++ks) {
                        const bf16x8 a = *(const LAS bf16x8*)(lds + KI + sr * 256 + (((4 * ks + g) ^ (sr & 15)) * 16));
                        const bf16x8 bq = *(const LAS bf16x8*)(lds + QI + tr * 256 + (((4 * ks + g) ^ (tr & 15)) * 16));
                        acc = __builtin_amdgcn_mfma_f32_16x16x32_bf16(a, bq, acc, 0, 0, 0); }
#pragma unroll
                    for (int reg = 0; reg < 4; ++reg) { const int s = 16 * sb + 4 * g + reg; const bool ok = dir == 0 ? (s <= tr) : (s >= tr); if (!ok) acc[reg] = 0.f; }
                    v2u w; w.x = pg8::cvt_pk_bf16(acc[0], acc[1]); w.y = pg8::cvt_pk_bf16(acc[2], acc[3]);
                    *(LAS v2u*)(lds + AM + tr * 128 + (((2 * sb + (g >> 1)) ^ ((tr >> 1) & 7)) * 16) + (g & 1) * 8) = w; }
                HG_LBAR();
                bf16x8 vB[2]; load_vB(vB, lds, wave, lane);
                bf16x8 sB[4];
#pragma unroll
                for (int kk = 0; kk < 4; ++kk) { v4u w; w.x = pg8::cvt_pk_bf16(S[2 * kk][0], S[2 * kk][1]); w.y = pg8::cvt_pk_bf16(S[2 * kk][2], S[2 * kk][3]);
                    w.z = pg8::cvt_pk_bf16(S[2 * kk + 1][0], S[2 * kk + 1][1]); w.w = pg8::cvt_pk_bf16(S[2 * kk + 1][2], S[2 * kk + 1][3]); sB[kk] = __builtin_bit_cast(bf16x8, w); }
                f32x4 ob[4];
#pragma unroll
                for (int tb = 0; tb < 4; ++tb) { const int tr = 16 * tb + i16; f32x4 acc = {0.f, 0.f, 0.f, 0.f};
#pragma unroll
                    for (int ks = 0; ks < 2; ++ks) { const bf16x8 a = *(const LAS bf16x8*)(lds + AM + tr * 128 + (((4 * ks + g) ^ ((tr >> 1) & 7)) * 16));
                        acc = __builtin_amdgcn_mfma_f32_16x16x32_bf16(a, vB[ks], acc, 0, 0, 0); }
#pragma unroll
                    for (int kk = 0; kk < 4; ++kk) {
                        const v2u lo = *(const LAS v2u*)(lds + QS + tr * 256 + (((4 * kk + (g >> 1)) ^ (tr & 15)) * 16) + (g & 1) * 8);
                        const v2u hi2 = *(const LAS v2u*)(lds + QS + tr * 256 + (((4 * kk + 2 + (g >> 1)) ^ (tr & 15)) * 16) + (g & 1) * 8);
                        v4u w; w.x = lo.x; w.y = lo.y; w.z = hi2.x; w.w = hi2.y;
                        acc = __builtin_amdgcn_mfma_f32_16x16x32_bf16(__builtin_bit_cast(bf16x8, w), sB[kk], acc, 0, 0, 0); }
                    ob[tb] = acc; }
                state_update(S, vB, lds, lane);
                unsigned short* orow = HGO + (size_t)row0 * 5120 + h * 128 + 16 * wave + i16;
                if (dir == 0) {
#pragma unroll
                    for (int tb = 0; tb < 4; ++tb)
#pragma unroll
                        for (int reg = 0; reg < 4; ++reg) orow[(size_t)(16 * tb + 4 * g + reg) * 5120 + 3 * D] = f2bf(ob[tb][reg]);
                } else {
#pragma unroll
                    for (int tb = 0; tb < 4; ++tb)
#pragma unroll
                        for (int reg = 0; reg < 4; ++reg) { const int t = 16 * tb + 4 * g + reg;
                            const float o = ob[tb][reg] + bf2f(orow[(size_t)t * 5120 + 3 * D]); ob[tb][reg] = o;
                            float ss = o * o; ss += __shfl_xor(ss, 1); ss += __shfl_xor(ss, 2); ss += __shfl_xor(ss, 4); ss += __shfl_xor(ss, 8);
                            if (i16 == 0) *(LAS float*)(lds + RED + (t * 8 + wave) * 4) = ss; }
                    HG_LBAR();
#pragma unroll
                    for (int tb = 0; tb < 4; ++tb)
#pragma unroll
                        for (int reg = 0; reg < 4; ++reg) { const int t = 16 * tb + 4 * g + reg;
                            const f32x4 r0 = *(const LAS f32x4*)(lds + RED + t * 32), r1 = *(const LAS f32x4*)(lds + RED + t * 32 + 16);
                            const float tot = ((r0[0] + r0[1]) + (r0[2] + r0[3])) + ((r1[0] + r1[1]) + (r1[2] + r1[3]));
                            const float rinv = rsqrtf(tot * (1.f / 128.f) + EPS);
                            const float gs = bf2f(orow[(size_t)t * 5120 + 2 * D]);
                            orow[(size_t)t * 5120] = f2bf(ob[tb][reg] * rinv * ng * gs); }
                }
            }
            HG_BAR();
        }
    }
}
}


constexpr int NWAVES = 8;
constexpr int RING_BYTES = 131072, MISC_OFF = RING_BYTES + 320, LDS_BYTES = 147456;
typedef GAS unsigned gu32;
#define LDS_WAIT() asm volatile("s_waitcnt lgkmcnt(0)" ::: "memory")
#define VM_WAIT() asm volatile("s_waitcnt vmcnt(0)" ::: "memory")
__device__ __forceinline__ float wave_sum(float v) {
#pragma unroll
    for (int o = 1; o < 64; o <<= 1) v += __shfl_xor(v, o);
    return v;
}
struct Args { const float* in[19]; float* out; unsigned char* ws; int ph_lo, ph_hi; };

__device__ __forceinline__ void p0_transpose_item(const float* W, int K, int N, bf16_t* WT, int k0, int n0, int dst_row0, LAS float* scr, int lane) {
#pragma unroll 8
    for (int i = 0; i < 32; ++i) { const int kk = 2 * i + (lane >> 5); scr[kk * 33 + (lane & 31)] = W[(size_t)(k0 + kk) * N + n0 + (lane & 31)]; }
    LDS_WAIT(); asm volatile("" ::: "memory");
    const int c = lane & 7;
#pragma unroll
    for (int j = 0; j < 4; ++j) { const int n = (lane >> 3) + 8 * j; const LAS float* s = scr + (8 * c) * 33 + n;
        v4u o; o.x = pk2(s[0 * 33], s[1 * 33]); o.y = pk2(s[2 * 33], s[3 * 33]); o.z = pk2(s[4 * 33], s[5 * 33]); o.w = pk2(s[6 * 33], s[7 * 33]);
        *(v4u*)(WT + (size_t)(dst_row0 + n) * K + k0 + 8 * c) = o; }
    LDS_WAIT(); asm volatile("" ::: "memory");
}
__device__ __forceinline__ int perm_qkv(int n0) { const int t = n0 & 255, wc = t >> 6, bj = (t >> 5) & 1; return (n0 & ~255) + 128 * bj + 32 * wc; }
__device__ __forceinline__ int perm_ffn(int n0) { const int bj = n0 >= DFF ? 1 : 0, c = n0 - bj * DFF; return (c >> 7) * 256 + bj * 128 + (c & 127); }

__device__ __forceinline__ void naive_attn_item(const bf16_t* QKV, const float* rpb, bf16_t* O, int idx) {
    const int h = idx & 15, row = idx >> 4;
    float q[64], o[64]; float m = -INFINITY, l = 0.f;
    { const bf16_t* qp = QKV + (size_t)row * 3072 + h * 64;
#pragma unroll
      for (int i = 0; i < 64; ++i) { q[i] = bf2f(qp[i]); o[i] = 0.f; } }
    const int b = row_batch(row);
    auto visit = [&](int krow, float bias) {
        const bf16_t* kp = QKV + (size_t)krow * 3072 + D + h * 64; const bf16_t* vp = kp + D;
        float s = 0.f;
#pragma unroll
        for (int i = 0; i < 64; ++i) s += q[i] * bf2f(kp[i]);
        s += bias;
        const float mn = fmaxf(m, s), f = __expf(m - mn), p = __expf(s - mn);
        l = l * f + p;
#pragma unroll
        for (int i = 0; i < 64; ++i) o[i] = o[i] * f + p * bf2f(vp[i]);
        m = mn;
    };
    if (row < MLAT) {
        const int t = row & (SEQ - 1), r = t >> 6, c = t & 63;
        int rs = r - 4; rs = rs < 0 ? 0 : (rs > ROWS - 8 ? ROWS - 8 : rs);
        int cs = c - 8; cs = cs < 0 ? 0 : (cs > GW - 16 ? GW - 16 : cs);
        for (int j = 0; j < 8; ++j)
            for (int w = 0; w < 16; ++w) {
                const int kr = rs + j, kc = cs + w;
                visit(b * SEQ + kr * GW + kc, rpb[(h * 15 + (kr - r + 7)) * 31 + (kc - c + 15)]);
            }
    }
    for (int kk = 0; kk < CTX; ++kk) visit(MLAT + b * CTX + kk, 0.f);
    const float rl = 1.f / l;
    bf16_t* op = O + (size_t)row * D + h * 64;
#pragma unroll
    for (int i = 0; i < 64; ++i) op[i] = f2bf(o[i] * rl);
}
__device__ __forceinline__ void naive_hgscan(unsigned short* HGO, const float* norm_g, int bh, LAS float* sm) {
    LAS float (*sq)[128] = (LAS float (*)[128])sm; LAS float (*sk)[128] = (LAS float (*)[128])(sm + 256); LAS float (*red)[2] = (LAS float (*)[2])(sm + 512);
    const int b = bh >> 3, h = bh & 7, v = threadIdx.x & 127; const bool act = threadIdx.x < 128;
    const int NS = CTX + SEQ;
    const float ng = norm_g[v];
    for (int dir = 0; dir < 2; ++dir) {
        float S[128];
#pragma unroll
        for (int k = 0; k < 128; ++k) S[k] = 0.f;
        auto rowof = [&](int step) { int row; if (step < CTX) { const int j = dir == 0 ? step : CTX - 1 - step; row = MLAT + b * CTX + j; } else { const int t = dir == 0 ? step - CTX : SEQ - 1 - (step - CTX); row = b * SEQ + t; } return row; };
        { const int row = rowof(0); const unsigned short* p = HGO + (size_t)row * 5120 + h * 128;
          if (act) { sq[0][v] = bf2f(p[v]); sk[0][v] = h2f(p[(3 + dir) * D + v]); } }
        __syncthreads();
        for (int step = 0; step < NS; ++step) {
            const int cur = step & 1, row = rowof(step);
            unsigned short* p = HGO + (size_t)row * 5120 + h * 128;
            const float vv = bf2f(p[D + v]);
            if (step + 1 < NS) { const int rn = rowof(step + 1); const unsigned short* pn = HGO + (size_t)rn * 5120 + h * 128;
                if (act) { sq[cur ^ 1][v] = bf2f(pn[v]); sk[cur ^ 1][v] = h2f(pn[(3 + dir) * D + v]); } }
            float o = 0.f;
#pragma unroll
            for (int k = 0; k < 128; ++k) { const float kk = sk[cur][k]; S[k] = (1.f - kk) * S[k] + kk * vv; o += sq[cur][k] * S[k]; }
            if (row < MLAT) {
                if (dir == 0) { if (act) p[3 * D + v] = f2bf(o); }
                else {
                    const float ot = o + bf2f(p[3 * D + v]);
                    float ss = ot * ot;
#pragma unroll
                    for (int off = 1; off < 64; off <<= 1) ss += __shfl_xor(ss, off);
                    if (act && (v & 63) == 0) red[cur][v >> 6] = ss;
                    __syncthreads();
                    const float tot = red[cur][0] + red[cur][1];
                    const float rinv = rsqrtf(tot * (1.f / 128.f) + EPS);
                    const float gv = bf2f(p[2 * D + v]);
                    if (act) p[v] = f2bf(ot * rinv * ng * gv);
                }
            }
            __syncthreads();
        }
    }
}

__global__ void __launch_bounds__(NWAVES * 64, 2) mega(Args a) {
    extern __shared__ __attribute__((aligned(16))) unsigned char lds_raw[];
    LAS unsigned char* lds = (LAS unsigned char*)lds_raw;
    volatile LAS unsigned* MISC = (volatile LAS unsigned*)(lds + MISC_OFF);
    const int tid = threadIdx.x, lane = tid & 63, wave = __builtin_amdgcn_readfirstlane(tid >> 6);
    const int G = gridDim.x, bx = blockIdx.x;
    const int vcu = (G % 8 == 0) ? (bx % 8) * (G / 8) + bx / 8 : bx;
    unsigned char* ws = a.ws;
    const float* x = a.in[0]; const float* cvec = a.in[1]; const float* ctx = a.in[2]; const float* c_ctx = a.in[3];
    const float* ada_w = a.in[4]; const float* ada_b = a.in[5]; const float* norm1_g = a.in[6]; const float* norm2_g = a.in[7];
    const float* w_qkv = a.in[8]; const float* w_o = a.in[9]; const float* q_gain = a.in[10]; const float* k_gain = a.in[11];
    const float* hg_w_in = a.in[13]; const float* hg_lower = a.in[14];
    const float* hg_w_o = a.in[16]; const float* ffn_w_in = a.in[17]; const float* ffn_w_out = a.in[18];
    float* out = a.out;
    float* mod = (float*)(ws + WS_MOD); float* lbp = (float*)(ws + WS_LB); float* Gv = (float*)(ws + WS_GV);
    float* bias_f0 = (float*)(ws + WS_BIAS_F0); float* bias_hg = (float*)(ws + WS_BIAS_HG); float* bias_f1 = (float*)(ws + WS_BIAS_F1);
    float* part = (float*)(ws + WS_PART); float* XCTX = (float*)(ws + WS_XCTX);
    bf16_t* Wqkv_t = (bf16_t*)(ws + WS_WQKV); bf16_t* Wo0_t = (bf16_t*)(ws + WS_WO0); bf16_t* Whgin_t = (bf16_t*)(ws + WS_WHGIN); bf16_t* Whgo_t = (bf16_t*)(ws + WS_WHGO);
    bf16_t* Wfin0_t = (bf16_t*)(ws + WS_WFIN0); bf16_t* Wfin1_t = (bf16_t*)(ws + WS_WFIN1); bf16_t* Wfout0_t = (bf16_t*)(ws + WS_WFOUT0); bf16_t* Wfout1_t = (bf16_t*)(ws + WS_WFOUT1);
    bf16_t* ABUF = (bf16_t*)(ws + WS_ABUF); bf16_t* R1 = (bf16_t*)(ws + WS_R1);

    for (int u = tid; u < (LDS_BYTES - RING_BYTES) / 4; u += NWAVES * 64) ((LAS unsigned*)(lds + RING_BYTES))[u] = 0u;
    __syncthreads();
    XcdBarrier bar = xcd_barrier_post((unsigned*)(ws + WS_CTL) + 1024, MISC + 8);
    const int lo = a.ph_lo, hi = a.ph_hi;
#define IN(k) (lo <= (k) && (k) < hi)
#define SEAM(k) do { if (IN(k) && IN((k) + 1)) xcd_barrier(bar); } while (0)

    if (IN(0)) {
        if (bx < 192) {
            LAS float* sv = (LAS float*)lds; LAS float* red = (LAS float*)(lds + 20480);
            const int l = bx / 96, cb = bx % 96;
            for (int i = tid; i < 5 * D; i += 512) { const int s = i >> 10, k = i & 1023; const float v = s < 4 ? cvec[s * D + k] : c_ctx[k]; sv[i] = silu_f(v); }
            __syncthreads();
            const int col = tid & 63, kg = tid >> 6;
            float acc[5] = {0.f, 0.f, 0.f, 0.f, 0.f};
            const float* w = ada_w + (size_t)l * D * 6 * D + cb * 64 + col;
            for (int k = kg * 128; k < kg * 128 + 128; ++k) { const float wv = w[(size_t)k * 6 * D];
#pragma unroll
                for (int s = 0; s < 5; ++s) acc[s] += sv[s * D + k] * wv; }
#pragma unroll
            for (int s = 0; s < 5; ++s) red[(kg * 5 + s) * 64 + col] = acc[s];
            __syncthreads();
            if (tid < 320) { const int s = tid >> 6, c2 = tid & 63; float t = 0.f;
#pragma unroll
                for (int k2 = 0; k2 < 8; ++k2) t += red[(k2 * 5 + s) * 64 + c2];
                mod[((size_t)l * 5 + s) * 6 * D + cb * 64 + c2] = t + ada_b[l * 6 * D + cb * 64 + c2]; }
            __syncthreads();
        } else if (bx < 196) { const int i = (bx - 192) * 512 + tid; lbp[i] = sigmoid_f(hg_lower[2 * D + i] - hg_lower[i]); }
        {
            LAS float* scr = (LAS float*)(lds + wave * 16384);
            const int gw = vcu * NWAVES + wave, NGW = G * NWAVES;
            constexpr int I_QKV = 16 * 96, I_O = 16 * 32, I_HGIN = 16 * 160, I_FIN = 16 * 176, I_FOUT = 44 * 32;
            constexpr int NITEMS = I_QKV + 2 * I_O + I_HGIN + 2 * I_FIN + 2 * I_FOUT;
            for (int it = gw; it < NITEMS; it += NGW) {
                int r = it;
                if (r < I_QKV) { const int kb = r / 96, nb = r % 96; p0_transpose_item(w_qkv, D, 3 * D, Wqkv_t, kb * 64, nb * 32, perm_qkv(nb * 32), scr, lane); continue; } r -= I_QKV;
                if (r < I_O) { const int kb = r / 32, nb = r % 32; p0_transpose_item(w_o, D, D, Wo0_t, kb * 64, nb * 32, nb * 32, scr, lane); continue; } r -= I_O;
                if (r < I_O) { const int kb = r / 32, nb = r % 32; p0_transpose_item(hg_w_o, D, D, Whgo_t, kb * 64, nb * 32, nb * 32, scr, lane); continue; } r -= I_O;
                if (r < I_HGIN) { const int kb = r / 160, nb = r % 160; p0_transpose_item(hg_w_in, D, 5 * D, Whgin_t, kb * 64, nb * 32, nb * 32, scr, lane); continue; } r -= I_HGIN;
                if (r < 2 * I_FIN) { const int l = r / I_FIN, q = r % I_FIN, kb = q / 176, nb = q % 176;
                    p0_transpose_item(ffn_w_in + (size_t)l * D * 2 * DFF, D, 2 * DFF, l ? Wfin1_t : Wfin0_t, kb * 64, nb * 32, perm_ffn(nb * 32), scr, lane); continue; } r -= 2 * I_FIN;
                { const int l = r / I_FOUT, q = r % I_FOUT, kb = q / 32, nb = q % 32;
                    p0_transpose_item(ffn_w_out + (size_t)l * DFF * D, DFF, D, l ? Wfout1_t : Wfout0_t, kb * 64, nb * 32, nb * 32, scr, lane); }
            }
        }
    }
    SEAM(0);
    if (IN(1)) {
        const int gw = vcu * NWAVES + wave, NGW = G * NWAVES;
        { const int i = bx * 512 + tid;
          if (i < 2 * 2 * 5 * D) { const int col = i & 1023, s = (i >> 10) % 5, w = (i / (5 * D)) & 1, l = i / (10 * D);
              Gv[i] = (w == 0 ? norm1_g : norm2_g)[l * D + col] * (1.f + mod[((size_t)l * 5 + s) * 6 * D + (w == 0 ? 1 : 4) * D + col]); } }
        for (int n = gw; n < 16384; n += NGW) {
            const bf16_t* Bt; const float* shb; float* dst; int ldb, nn;
            if (n < 5632) { Bt = Wfin0_t; shb = mod + 3 * D; dst = bias_f0; ldb = 5632; nn = n; }
            else if (n < 10752) { Bt = Whgin_t; shb = mod + 5 * 6 * D; dst = bias_hg; ldb = 5120; nn = n - 5632; }
            else { Bt = Wfin1_t; shb = mod + 5 * 6 * D + 3 * D; dst = bias_f1; ldb = 5632; nn = n - 10752; }
            const v4u* wp = (const v4u*)(Bt + (size_t)nn * D + lane * 16); const v4u w0 = wp[0], w1 = wp[1];
            float wf[16];
#pragma unroll
            for (int j = 0; j < 4; ++j) { wf[2 * j] = __builtin_bit_cast(float, w0[j] << 16); wf[2 * j + 1] = __builtin_bit_cast(float, w0[j] & 0xffff0000u);
                wf[8 + 2 * j] = __builtin_bit_cast(float, w1[j] << 16); wf[8 + 2 * j + 1] = __builtin_bit_cast(float, w1[j] & 0xffff0000u); }
#pragma unroll
            for (int s = 0; s < 5; ++s) { const f32x4* sp = (const f32x4*)(shb + (size_t)s * 6 * D + lane * 16); float t = 0.f;
#pragma unroll
                for (int q = 0; q < 4; ++q) { const f32x4 sv = sp[q]; t += (sv[0] * wf[4 * q] + sv[1] * wf[4 * q + 1]) + (sv[2] * wf[4 * q + 2] + sv[3] * wf[4 * q + 3]); }
                t = wave_sum(t); if (lane == 0) dst[(size_t)s * ldb + nn] = t; }
        }
        for (int row = gw; row < MTOT; row += NGW) {
            const float* xr = row < MLAT ? x + (size_t)row * D : ctx + (size_t)(row - MLAT) * D;
            const f32x4* xp = (const f32x4*)xr + lane; f32x4 v[4]; float ss = 0.f;
#pragma unroll
            for (int j = 0; j < 4; ++j) { v[j] = xp[64 * j]; ss += pg8::sq4(v[j]); }
            const float rinv = rsqrtf(wave_sum(ss) * (1.f / D) + EPS);
            const float* mp = mod + (size_t)row_slot(row) * 6 * D;
#pragma unroll
            for (int j = 0; j < 4; ++j) { const int col = 4 * lane + 256 * j;
                const f32x4 g = *(const f32x4*)(norm1_g + col), sc = *(const f32x4*)(mp + D + col), sh = *(const f32x4*)(mp + col);
                const f32x4 y = (v[j] * rinv * g) * (sc + 1.f) + sh;
                v2u o; o.x = pk2(y[0], y[1]); o.y = pk2(y[2], y[3]); *(v2u*)(ABUF + (size_t)row * D + col) = o; }
        }
    }
    SEAM(1);
    const float* mod0 = mod; const float* mod1 = mod + 5 * 6 * D;
    if (IN(2)) {
        pg8::Gemm g{ABUF, Wqkv_t, MTOT, 3 * D, D, D}; pg8::StaticOrder S; S.init(MTOT, 3 * D, G, bx);
        pg8::EpiQKV E{R1, q_gain, k_gain, 0.125f};
        pg8::gemm_phase<pg8::EpiQKV, pg8::StaticOrder, true, true>(lds, g, S, E);
    }
    SEAM(2);
    if (IN(3)) { na::attn_phase(lds, R1, a.in[12], ABUF, G, vcu); }
    SEAM(3);
    if (IN(4)) {
        pg8::Gemm g{ABUF, Wo0_t, MTOT, D, D, D}; pg8::StaticOrder S; S.init(MTOT, D, G, bx);
        pg8::EpiRes E{x, ctx, out, XCTX, mod0 + 2 * D, Gv + (0 * 2 + 1) * 5 * D, ABUF, part};
        E.Aout = R1;
        pg8::gemm_phase<pg8::EpiRes, pg8::StaticOrder, true, true>(lds, g, S, E);
    }
    SEAM(4);
    bf16_t* A2 = R1; bf16_t* HID = R1 + (size_t)MTOT * D;
    if (IN(5)) {
        pg8::Gemm g{A2, Wfin0_t, MTOT, 2 * DFF, D, D}; pg8::StaticOrder S; S.init(MTOT, 2 * DFF, G, bx);
        pg8::EpiSwiglu E{part, bias_f0, HID};
        pg8::gemm_phase<pg8::EpiSwiglu, pg8::StaticOrder, true, true>(lds, g, S, E);
    }
    SEAM(5);
    if (IN(6)) {
        pg8::Gemm g{HID, Wfout0_t, MTOT, D, DFF, DFF}; pg8::StaticOrder S; S.init(MTOT, D, G, bx);
        pg8::EpiRes E{out, XCTX, out, XCTX, mod0 + 5 * D, Gv + (1 * 2 + 0) * 5 * D, ABUF, part};
        pg8::gemm_phase<pg8::EpiRes, pg8::StaticOrder, true, true>(lds, g, S, E);
    }
    SEAM(6);
    if (IN(7)) {
        pg8::Gemm g{ABUF, Whgin_t, MTOT, 5 * D, D, D}; pg8::StaticOrder S; S.init(MTOT, 5 * D, G, bx);
        pg8::EpiHg E{part, bias_hg, R1, lbp};
        pg8::gemm_phase<pg8::EpiHg, pg8::StaticOrder, true, true>(lds, g, S, E);
    }
    SEAM(7);
    float* STATE = (float*)(ws + WS_STATE);
    if (IN(8)) { hg::phase1(lds, R1, STATE, G, vcu); }
    SEAM(8);
    if (IN(9)) { hg::phase2(STATE, G, bx); }
    SEAM(9);
    if (IN(10)) { hg::phase3(lds, R1, STATE, a.in[15], G, vcu); }
    SEAM(10);
    if (IN(11)) {
        pg8::Gemm g{R1, Whgo_t, MLAT, D, D, 5 * D}; pg8::StaticOrder S; S.init(MLAT, D, G, bx);
        pg8::EpiRes E{out, XCTX, out, XCTX, mod1 + 2 * D, Gv + (1 * 2 + 1) * 5 * D, ABUF, part};
        pg8::gemm_phase<pg8::EpiRes, pg8::StaticOrder, true, true>(lds, g, S, E);
    }
    SEAM(11);
    if (IN(12)) {
        pg8::Gemm g{ABUF, Wfin1_t, MLAT, 2 * DFF, D, D}; pg8::StaticOrder S; S.init(MLAT, 2 * DFF, G, bx);
        pg8::EpiSwiglu E{part, bias_f1, R1};
        pg8::gemm_phase<pg8::EpiSwiglu, pg8::StaticOrder, true, true>(lds, g, S, E);
    }
    SEAM(12);
    if (IN(13)) {
        pg8::Gemm g{R1, Wfout1_t, MLAT, D, DFF, DFF}; pg8::StaticOrder S; S.init(MLAT, D, G, bx);
        pg8::EpiRes E{out, XCTX, out, XCTX, mod1 + 5 * D, nullptr, nullptr, nullptr};
        pg8::gemm_phase<pg8::EpiRes, pg8::StaticOrder, true, true>(lds, g, S, E);
    }
#undef IN
#undef SEAM
}

extern "C" void kernel_launch(void* const* d_in, const int* in_sizes, int n_in, void* d_out, int out_size, void* d_ws, size_t ws_size, hipStream_t stream) {
    static int grid = 0;
    if (grid == 0) {
        if (n_in != 19 || out_size != MLAT * D || ws_size < WS_END) { fprintf(stderr, "kernel_launch: unexpected sizes n_in %d out %d ws %zu\n", n_in, out_size, ws_size); grid = -1; return; }
        int dev = 0, cus = 0, per_cu = 0;
        if (hipGetDevice(&dev) != hipSuccess || hipDeviceGetAttribute(&cus, hipDeviceAttributeMultiprocessorCount, dev) != hipSuccess) { grid = -1; return; }
        if (hipFuncSetAttribute((const void*)mega, hipFuncAttributeMaxDynamicSharedMemorySize, LDS_BYTES) != hipSuccess) { fprintf(stderr, "kernel_launch: hipFuncSetAttribute failed\n"); grid = -1; return; }
        if (hipOccupancyMaxActiveBlocksPerMultiprocessor(&per_cu, (const void*)mega, NWAVES * 64, LDS_BYTES) != hipSuccess || per_cu < 1) { fprintf(stderr, "kernel_launch: occupancy query says %d blocks per CU\n", per_cu); grid = -1; (void)hipGetLastError(); return; }
        (void)hipGetLastError();
        grid = cus;
    }
    if (grid < 0) return;
    (void)hipMemsetAsync((char*)d_ws + WS_CTL, 0, CTL_ZERO_BYTES, stream);
    Args a{};
    for (int i = 0; i < 19; ++i) a.in[i] = (const float*)d_in[i];
    a.out = (float*)d_out; a.ws = (unsigned char*)d_ws;
    auto run = [&](int lo, int hi) { a.ph_lo = lo; a.ph_hi = hi; hipLaunchKernelGGL(mega, dim3(grid), dim3(NWAVES * 64), LDS_BYTES, stream, a); };
    run(0, 14);
}
```

```cpp
#include <hip/hip_runtime.h>
#include <cstdint>
#include <cstdio>
#include <type_traits>

constexpr int D = 1024, BATCH = 4, SEQ = 8192, CTX = 256, MLAT = BATCH * SEQ, MCTX = BATCH * CTX, MTOT = MLAT + MCTX;
constexpr int DFF = 2816, NAH = 16, HGH = 8, GW = 64, ROWS = SEQ / GW;
constexpr float EPS = 1e-6f;
typedef unsigned short bf16_t;
typedef unsigned short f16_t;
#define GAS __attribute__((address_space(1)))
#define LAS __attribute__((address_space(3)))
typedef unsigned v4u __attribute__((ext_vector_type(4)));
typedef unsigned v2u __attribute__((ext_vector_type(2)));
typedef float f32x4 __attribute__((ext_vector_type(4)));
typedef float f32x2 __attribute__((ext_vector_type(2)));
typedef _Float16 h16x2 __attribute__((ext_vector_type(2)));

__device__ __forceinline__ bf16_t f2bf(float f) { unsigned u = __builtin_bit_cast(unsigned, f); return (bf16_t)((u + 0x7fffu + ((u >> 16) & 1u)) >> 16); }
__device__ __forceinline__ float bf2f(bf16_t h) { return __builtin_bit_cast(float, (unsigned)h << 16); }
__device__ __forceinline__ f16_t f2h(float f) { _Float16 h = (_Float16)f; return __builtin_bit_cast(unsigned short, h); }
__device__ __forceinline__ float h2f(f16_t u) { return (float)__builtin_bit_cast(_Float16, u); }
__device__ __forceinline__ unsigned pk2(float lo, float hi) { return (unsigned)f2bf(lo) | ((unsigned)f2bf(hi) << 16); }
__device__ __forceinline__ unsigned pk_h2(float lo, float hi) { f32x2 v = {lo, hi}; h16x2 h = __builtin_convertvector(v, h16x2); return __builtin_bit_cast(unsigned, h); }
__device__ __forceinline__ float silu_f(float x) { return x / (1.f + __expf(-x)); }
__device__ __forceinline__ float sigmoid_f(float x) { return 1.f / (1.f + __expf(-x)); }
__device__ __forceinline__ float fast_sigmoid(float x) { return __builtin_amdgcn_rcpf(1.f + __builtin_amdgcn_exp2f(-1.4426950408889634f * x)); }
__device__ __forceinline__ float fast_silu(float x) { return x * fast_sigmoid(x); }
__device__ __forceinline__ int row_slot(int row) { return row < MLAT ? (row >> 13) : 4; }
__device__ __forceinline__ int row_batch(int row) { return row < MLAT ? (row >> 13) : ((row - MLAT) >> 8); }

constexpr size_t MiB = 1u << 20, KiB = 1024;
constexpr size_t WS_CTL = 0, CTL_ZERO_BYTES = 64 * KiB;
constexpr size_t WS_MOD = 64 * KiB;
constexpr size_t WS_LB = 320 * KiB;
constexpr size_t WS_GV = 336 * KiB;
constexpr size_t WS_BIAS_F0 = 448 * KiB;
constexpr size_t WS_BIAS_HG = 576 * KiB;
constexpr size_t WS_BIAS_F1 = 704 * KiB;
constexpr size_t WS_PART = 1 * MiB;
constexpr size_t WS_XCTX = 4 * MiB;
constexpr size_t WS_WQKV = 8 * MiB, WS_WO0 = 14 * MiB, WS_WHGIN = 16 * MiB, WS_WHGO = 26 * MiB;
constexpr size_t WS_WFIN0 = 28 * MiB, WS_WFIN1 = 39 * MiB, WS_WFOUT0 = 50 * MiB, WS_WFOUT1 = 50 * MiB + 5632 * KiB;
constexpr size_t WS_ABUF = 62 * MiB;
constexpr size_t WS_R1 = 128 * MiB;
constexpr size_t WS_STATE = 458 * MiB;
constexpr size_t WS_BTAB = 496 * MiB;
constexpr size_t WS_END = 512 * MiB;
static_assert(WS_WFOUT1 + (size_t)D * DFF * 2 <= WS_ABUF && WS_ABUF + (size_t)MTOT * D * 2 <= WS_R1 && WS_R1 + (size_t)MTOT * 5120 * 2 <= WS_STATE, "ws map");
static_assert(WS_PART + (size_t)MTOT * 16 * 4 <= WS_XCTX && WS_BIAS_F1 + 5 * 5632 * 4 <= WS_PART && WS_MOD + 2 * 5 * 6144 * 4 <= WS_LB, "ws map small");

namespace pg8 {
#define PG8_LAS __attribute__((address_space(3)))
typedef short bf16x8 __attribute__((ext_vector_type(8)));
typedef unsigned u32x4 __attribute__((ext_vector_type(4)));
constexpr int BM = 256, BK = 64, HALF = 128, HTB = HALF * BK * 2  , STAGE_BYTES = 8 * HTB, NXCD = 8, WGM = 8;

__host__ __device__ __forceinline__ int lds_byte(int r, int c) { const int st = (r >> 4) * 2 + (c >> 5), rr = r & 15, cc = c & 31, ob = rr * 64 + cc * 2; return st * 1024 + (ob ^ (((ob >> 9) & 1) << 5)); }
__host__ __device__ __forceinline__ void stage_rc(int b, int& R, int& C) { const int st = b / 1024, sb = b % 1024, swz = sb ^ (((sb >> 9) & 1) << 5); R = (st >> 1) * 16 + swz / 64; C = (st & 1) * 32 + (swz % 64) / 2; }
__host__ __device__ __forceinline__ int perm32(int rho) { const int n = rho >> 4, i = rho & 15; return 8 * (i >> 2) + 4 * n + (i & 3); }

struct Unit { int pm, pn; };
struct Gemm { const bf16_t* A; const bf16_t* Bt; int M, N, K, lda, nt, koff; };

struct StaticOrder {
    int nM, nN, nwg, G, c;
    __host__ __device__ void init(int M, int N, int G_, int c_) { nM = M / BM; nN = N / BM; nwg = nM * nN; G = G_; c = c_; }
    __host__ __device__ bool next(int i, Unit& u) const {
        const long L = (long)i * G + c; if (L >= nwg) return false;
        int wgid = (int)L; { const int q = nwg / NXCD, r = nwg % NXCD, xcd = wgid % NXCD, off = wgid / NXCD; wgid = (xcd < r ? xcd * (q + 1) : r * (q + 1) + (xcd - r) * q) + off; }
        const int nig = WGM * nN, gid = wgid / nig, fm = gid * WGM, gsz = (nM - fm) < WGM ? (nM - fm) : WGM;
        u.pm = fm + ((wgid % nig) % gsz); u.pn = (wgid % nig) / gsz; return true;
    }
    __device__ __forceinline__ void a_ready(const Unit&) const {}
    __device__ __forceinline__ void done(const Unit&) const {}
};
__device__ __forceinline__ unsigned cvt_pk_bf16(float lo, float hi) { unsigned r; asm volatile("v_cvt_pk_bf16_f32 %0, %1, %2" : "=v"(r) : "v"(lo), "v"(hi)); return r; }

struct CtxTaskOrder {
    int S, ntasks, c;
    __device__ void init(int N, int S_, int c_) { S = S_; ntasks = 4 * (N / BM) * S_; c = c_; }
    __device__ bool next(int i, Unit& u) const { if (i != 0 || c >= ntasks) return false; const int unit = c / S; u.pm = MLAT / BM + (unit & 3); u.pn = unit >> 2; return true; }
    __device__ __forceinline__ void a_ready(const Unit&) const {}
    __device__ __forceinline__ void done(const Unit&) const {}
};
template <class Epi, int S> struct EpiSplit {
    static constexpr bool PERM = Epi::PERM, AFTER_DRAIN = false;
    Epi inner; float* slab; unsigned* cnt; PG8_LAS unsigned* flag; int task;
    __device__ __forceinline__ void operator()(const f32x4 (&acc_c)[2][2][4][2], const Unit& u, int wr, int wc, int fr, int fq) const {
        f32x4 (&acc)[2][2][4][2] = const_cast<f32x4 (&)[2][2][4][2]>(acc_c);
        const int tid = threadIdx.x;
        f32x4* sp = (f32x4*)slab + (size_t)task * 32 * 512 + tid;
#pragma unroll
        for (int i = 0; i < 32; ++i) { const f32x4 v = acc[i >> 4][(i >> 3) & 1][(i >> 1) & 3][i & 1]; f32x4* q = sp + i * 512;
            asm volatile("global_store_dwordx4 %0, %1, off sc1\n\ts_nop 1" :: "v"(q), "v"(v) : "memory"); }
        asm volatile("s_waitcnt vmcnt(0) lgkmcnt(0)" ::: "memory"); __builtin_amdgcn_s_barrier(); asm volatile("" ::: "memory");
        if (tid == 0) *flag = __hip_atomic_fetch_add(cnt + task / S, 1u, __ATOMIC_RELAXED, __HIP_MEMORY_SCOPE_AGENT);
        asm volatile("s_waitcnt vmcnt(0) lgkmcnt(0)" ::: "memory"); __builtin_amdgcn_s_barrier(); asm volatile("" ::: "memory");
        const unsigned ticket = *flag;
        if (ticket + 1u != (unsigned)S) return;
        if (tid == 0) { __builtin_amdgcn_fence(__ATOMIC_ACQUIRE, "agent"); asm volatile("s_waitcnt vmcnt(0)" ::: "memory"); }
        asm volatile("s_waitcnt vmcnt(0) lgkmcnt(0)" ::: "memory"); __builtin_amdgcn_s_barrier(); asm volatile("" ::: "memory");
        f32x4* rp = (f32x4*)slab + (size_t)(task - task % S) * 32 * 512 + tid;
#pragma unroll 1
        for (int c8 = 0; c8 < 4; ++c8) {
            f32x4 t[8];
#pragma unroll
            for (int i = 0; i < 8; ++i) t[i] = rp[(size_t)(c8 * 8 + i) * 512];
#pragma unroll
            for (int s = 1; s < S; ++s)
#pragma unroll
                for (int i = 0; i < 8; ++i) t[i] += rp[((size_t)s * 32 + c8 * 8 + i) * 512];
#pragma unroll
            for (int i = 0; i < 8; ++i) rp[(size_t)(c8 * 8 + i) * 512] = t[i];
        }
        asm volatile("s_waitcnt vmcnt(0)" ::: "memory");
#pragma unroll
        for (int i = 0; i < 32; ++i) acc[i >> 4][(i >> 3) & 1][(i >> 1) & 3][i & 1] = rp[(size_t)i * 512];
        inner(acc, u, wr, wc, fr, fq);
    }
};

__device__ __forceinline__ float quad_sum(float s) { s += __shfl_xor(s, 16); s += __shfl_xor(s, 32); return s; }
__device__ __forceinline__ float sq4(f32x4 v) { return (v[0] * v[0] + v[1] * v[1]) + (v[2] * v[2] + v[3] * v[3]); }
__device__ __forceinline__ u32x4 pack8(f32x4 a, f32x4 b) { u32x4 w; w.x = cvt_pk_bf16(a[0], a[1]); w.y = cvt_pk_bf16(a[2], a[3]); w.z = cvt_pk_bf16(b[0], b[1]); w.w = cvt_pk_bf16(b[2], b[3]); return w; }
__device__ __forceinline__ float row_rinv(const float* part, int row) {
    const f32x4* p = (const f32x4*)(part + (size_t)row * 16); const f32x4 a = p[0], b = p[1], c = p[2], d = p[3];
    const float s = ((a[0] + a[1]) + (a[2] + a[3])) + ((b[0] + b[1]) + (b[2] + b[3])) + ((c[0] + c[1]) + (c[2] + c[3])) + ((d[0] + d[1]) + (d[2] + d[3]));
    return rsqrtf(s * (1.f / D) + EPS);
}

struct EpiQKV {
    static constexpr bool PERM = true, AFTER_DRAIN = false;
    bf16_t* QKV; const float* qg; const float* kg; float qscale;
    __device__ __forceinline__ void operator()(const f32x4 (&acc)[2][2][4][2], const Unit& u, int wr, int wc, int fr, int fq) const {
        const int type = u.pn >> 2, head = (u.pn & 3) * 4 + wc;
        const int row0 = u.pm * BM + wr * 64 + fr;
        bf16_t* base = QKV + (size_t)type * D + head * 64 + 8 * fq;
        f32x4 gv[2][2];
        if (type < 2) { const float* gp = (type == 0 ? qg : kg) + 8 * fq;
#pragma unroll
            for (int bj = 0; bj < 2; ++bj)
#pragma unroll
                for (int n = 0; n < 2; ++n) gv[bj][n] = *(const f32x4*)(gp + 32 * bj + 4 * n); }
        const float sc = type == 0 ? qscale : 1.f;
#pragma unroll
        for (int ai = 0; ai < 2; ++ai)
#pragma unroll
            for (int m = 0; m < 4; ++m) {
                bf16_t* rowp = base + (size_t)(row0 + ai * HALF + m * 16) * 3072;
                f32x4 v00 = acc[ai][0][m][0], v01 = acc[ai][0][m][1], v10 = acc[ai][1][m][0], v11 = acc[ai][1][m][1];
                if (type < 2) {
                    const float ss = quad_sum((sq4(v00) + sq4(v01)) + (sq4(v10) + sq4(v11)));
                    const float r = rsqrtf(ss * (1.f / 64.f) + EPS) * sc;
                    v00 = v00 * r * gv[0][0]; v01 = v01 * r * gv[0][1]; v10 = v10 * r * gv[1][0]; v11 = v11 * r * gv[1][1];
                }
                *(u32x4*)(rowp) = pack8(v00, v01); *(u32x4*)(rowp + 32) = pack8(v10, v11);
            }
    }
};
template <class Sched> __device__ __forceinline__ void fill_res_tables(PG8_LAS unsigned char* tab, const Sched& S, const float* gate, const float* Gn) {
    const int tid = threadIdx.x; Unit u;
    for (int i = 0; i < 8 && S.next(i, u); ++i) {
        const bool lat = u.pm < MLAT / BM; const int slot = lat ? (u.pm >> 5) : 4;
        if (tid < 256) *(PG8_LAS float*)(tab + i * 1024 + tid * 4) = gate[(size_t)slot * 6 * D + u.pn * BM + tid];
        else *(PG8_LAS float*)(tab + 16384 + i * 1024 + (tid - 256) * 4) = Gn ? Gn[(size_t)slot * D + u.pn * BM + (tid - 256)] : 0.f;
    }
    asm volatile("s_waitcnt vmcnt(0) lgkmcnt(0)" ::: "memory"); __builtin_amdgcn_s_barrier(); asm volatile("" ::: "memory");
}
template <bool RES_BF16, bool OUT_BF16> struct EpiRes {
    static constexpr bool PERM = true, AFTER_DRAIN = false;
    const void* res_lat; const void* res_ctx; void* out_lat; void* out_ctx; PG8_LAS unsigned char* tab; bool has_gn; bf16_t* Aout; float* part; int ldr, ldo; mutable int seq;
    __device__ __forceinline__ void operator()(const f32x4 (&acc)[2][2][4][2], const Unit& u, int wr, int wc, int fr, int fq) const {
        const bool lat = u.pm < MLAT / BM;
        const size_t trow = lat ? (size_t)u.pm * BM : (size_t)u.pm * BM - MLAT; const size_t pr = lat ? ldr : D, po = lat ? ldo : D;
        const int cl = wc * 32 + 8 * fq, col0 = u.pn * BM + cl;
        const PG8_LAS unsigned char* tg = tab + seq * 1024 + cl * 4; const PG8_LAS unsigned char* tn = tab + 16384 + seq * 1024 + cl * 4; ++seq;
        f32x4 gt[2][2], gn[2][2];
#pragma unroll
        for (int bj = 0; bj < 2; ++bj)
#pragma unroll
            for (int n = 0; n < 2; ++n) { gt[bj][n] = *(const PG8_LAS f32x4*)(tg + bj * HALF * 4 + 16 * n); gn[bj][n] = *(const PG8_LAS f32x4*)(tn + bj * HALF * 4 + 16 * n); }
        const char* rl_ = (const char*)res_lat; const char* rc_ = (const char*)res_ctx; char* ol_ = (char*)out_lat; char* oc_ = (char*)out_ctx;
        asm volatile("" : "+s"(rl_), "+s"(rc_), "+s"(ol_), "+s"(oc_));
        const char* rbase = lat ? rl_ : rc_; char* obase = lat ? ol_ : oc_;
        constexpr int MB = RES_BF16 ? 4 : 2;
#pragma unroll
        for (int ai = 0; ai < 2; ++ai)
#pragma unroll
        for (int m0 = 0; m0 < 4; m0 += MB) {
            u32x4 rb[MB][2]; f32x4 rf[MB][2][2];
#pragma unroll
            for (int mm = 0; mm < MB; ++mm) { const size_t offr = (trow + wr * 64 + ai * HALF + (m0 + mm) * 16 + fr) * pr + col0;
#pragma unroll
                for (int bj = 0; bj < 2; ++bj) {
                    if (RES_BF16) rb[mm][bj] = *(const u32x4*)((const bf16_t*)rbase + offr + bj * HALF);
                    else { const float* rp = (const float*)rbase + offr + bj * HALF; rf[mm][bj][0] = *(const f32x4*)rp; rf[mm][bj][1] = *(const f32x4*)(rp + 4); } } }
#pragma unroll
            for (int mm = 0; mm < MB; ++mm) { const int m = m0 + mm;
                const int r = wr * 64 + ai * HALF + m * 16 + fr; const size_t offo = (trow + r) * po + col0;
                f32x4 x[2][2]; float ss = 0.f;
#pragma unroll
                for (int bj = 0; bj < 2; ++bj) {
                    f32x4 r0, r1;
                    if (RES_BF16) { const u32x4 w = rb[mm][bj];
                        r0 = (f32x4){__builtin_bit_cast(float, w.x << 16), __builtin_bit_cast(float, w.x & 0xffff0000u), __builtin_bit_cast(float, w.y << 16), __builtin_bit_cast(float, w.y & 0xffff0000u)};
                        r1 = (f32x4){__builtin_bit_cast(float, w.z << 16), __builtin_bit_cast(float, w.z & 0xffff0000u), __builtin_bit_cast(float, w.w << 16), __builtin_bit_cast(float, w.w & 0xffff0000u)}; }
                    else { r0 = rf[mm][bj][0]; r1 = rf[mm][bj][1]; }
                    x[bj][0] = r0 + gt[bj][0] * acc[ai][bj][m][0]; x[bj][1] = r1 + gt[bj][1] * acc[ai][bj][m][1];
                    if (OUT_BF16) *(u32x4*)((bf16_t*)obase + offo + bj * HALF) = pack8(x[bj][0], x[bj][1]);
                    else { float* op = (float*)obase + offo + bj * HALF; *(f32x4*)op = x[bj][0]; *(f32x4*)(op + 4) = x[bj][1]; }
                    ss += sq4(x[bj][0]) + sq4(x[bj][1]);
                }
                if (has_gn) {
                    ss = quad_sum(ss);
                    const size_t grow = (size_t)u.pm * BM + r;
                    if (fq == 0) part[grow * 16 + u.pn * 4 + wc] = ss;
                    bf16_t* ap = Aout + grow * D + col0;
                    *(u32x4*)(ap) = pack8(x[0][0] * gn[0][0], x[0][1] * gn[0][1]); *(u32x4*)(ap + HALF) = pack8(x[1][0] * gn[1][0], x[1][1] * gn[1][1]);
                }
            }
            asm volatile("" ::: "memory");
        }
    }
};
constexpr int EPI_TAB_UNITS = 14;
template <class Sched> __device__ __forceinline__ void fill_epi_tables(PG8_LAS unsigned char* tab, const Sched& S, const float* part, const float* bias, int bias_ld) {
    const int tid = threadIdx.x; Unit u;
    for (int i = 0; i < EPI_TAB_UNITS && S.next(i, u); ++i) {
        const bool lat = u.pm < MLAT / BM; const int slot = lat ? (u.pm >> 5) : 4;
        if (tid < 256) *(PG8_LAS float*)(tab + i * 1024 + tid * 4) = row_rinv(part, u.pm * BM + tid);
        else *(PG8_LAS float*)(tab + 16384 + i * 1024 + (tid - 256) * 4) = bias[(size_t)slot * bias_ld + u.pn * BM + (tid - 256)];
    }
    asm volatile("s_waitcnt vmcnt(0) lgkmcnt(0)" ::: "memory"); __builtin_amdgcn_s_barrier(); asm volatile("" ::: "memory");
}
struct EpiSwiglu {
    static constexpr bool PERM = true, AFTER_DRAIN = false;
    PG8_LAS unsigned char* tab; bf16_t* HID; int ldh; mutable int seq;
    __device__ __forceinline__ void operator()(const f32x4 (&acc)[2][2][4][2], const Unit& u, int wr, int wc, int fr, int fq) const {
        const int c0 = wc * 32 + 8 * fq;
        const PG8_LAS unsigned char* tr = tab + seq * 1024; const PG8_LAS unsigned char* tb = tab + 16384 + seq * 1024 + c0 * 4; ++seq;
        f32x4 ba[2], bu[2];
#pragma unroll
        for (int n = 0; n < 2; ++n) { ba[n] = *(const PG8_LAS f32x4*)(tb + 16 * n); bu[n] = *(const PG8_LAS f32x4*)(tb + HALF * 4 + 16 * n); }
#pragma unroll
        for (int ai = 0; ai < 2; ++ai)
#pragma unroll
            for (int m = 0; m < 4; ++m) {
                const int rl = wr * 64 + ai * HALF + m * 16 + fr, row = u.pm * BM + rl;
                const float rinv = *(const PG8_LAS float*)(tr + rl * 4);
                f32x4 h[2];
#pragma unroll
                for (int n = 0; n < 2; ++n) { const f32x4 a = acc[ai][0][m][n] * rinv + ba[n], uu = acc[ai][1][m][n] * rinv + bu[n];
#pragma unroll
                    for (int j = 0; j < 4; ++j) h[n][j] = fast_silu(a[j]) * uu[j]; }
                *(u32x4*)(HID + (size_t)row * ldh + u.pn * HALF + c0) = pack8(h[0], h[1]);
            }
    }
};
struct EpiHg {
    static constexpr bool PERM = true, AFTER_DRAIN = false;
    PG8_LAS unsigned char* tab; unsigned short* HGO; const float* lb; mutable int seq;
    __device__ __forceinline__ void operator()(const f32x4 (&acc)[2][2][4][2], const Unit& u, int wr, int wc, int fr, int fq) const {
        const int type = u.pn >> 2, col0 = u.pn * BM + wc * 32 + 8 * fq;
        const PG8_LAS unsigned char* tr = tab + seq * 1024; const PG8_LAS unsigned char* tb = tab + 16384 + seq * 1024 + (wc * 32 + 8 * fq) * 4; ++seq;
        f32x4 bv[2][2], lbv[2][2];
#pragma unroll
        for (int bj = 0; bj < 2; ++bj)
#pragma unroll
            for (int n = 0; n < 2; ++n) { bv[bj][n] = *(const PG8_LAS f32x4*)(tb + bj * HALF * 4 + 16 * n);
                lbv[bj][n] = type >= 3 ? *(const f32x4*)(lb + (col0 - 3 * D) + bj * HALF + 4 * n) : (f32x4){0.f, 0.f, 0.f, 0.f}; }
#pragma unroll
        for (int ai = 0; ai < 2; ++ai)
#pragma unroll
            for (int m = 0; m < 4; ++m) {
                const int rl = wr * 64 + ai * HALF + m * 16 + fr, row = u.pm * BM + rl;
                const float rinv = *(const PG8_LAS float*)(tr + rl * 4);
#pragma unroll
                for (int bj = 0; bj < 2; ++bj) {
                    f32x4 v0 = acc[ai][bj][m][0] * rinv + bv[bj][0], v1 = acc[ai][bj][m][1] * rinv + bv[bj][1]; u32x4 w;
                    if (type == 1) w = pack8(v0, v1);
                    else if (type < 3) {
#pragma unroll
                        for (int j = 0; j < 4; ++j) { v0[j] = fast_silu(v0[j]); v1[j] = fast_silu(v1[j]); }
                        w = pack8(v0, v1);
                    } else {
#pragma unroll
                        for (int j = 0; j < 4; ++j) { v0[j] = (1.f - lbv[bj][0][j]) * fast_sigmoid(-v0[j]); v1[j] = (1.f - lbv[bj][1][j]) * fast_sigmoid(-v1[j]); }
                        w.x = pk_h2(v0[0], v0[1]); w.y = pk_h2(v0[2], v0[3]); w.z = pk_h2(v1[0], v1[1]); w.w = pk_h2(v1[2], v1[3]);
                    }
                    *(u32x4*)(HGO + (size_t)row * 5 * D + col0 + bj * HALF) = w;
                }
            }
    }
};

template <class Epi, class Sched, bool ALIGN_EPI = false, bool SP2 = false>
__device__ __forceinline__ void gemm_phase(PG8_LAS unsigned char* lds, const Gemm g, const Sched& S, const Epi& E) {
    const int tid = threadIdx.x, wid = __builtin_amdgcn_readfirstlane(tid >> 6), lane = tid & 63, wr = wid >> 2, wc = wid & 3, fr = lane & 15, fq = lane >> 4;
    const int K = g.K, nt = g.nt ? g.nt : K / BK;
    unsigned voffA[2], voffB[2];
#pragma unroll
    for (int i = 0; i < 2; ++i) { int R, C; stage_rc(tid * 16 + i * 8192, R, C); const int Rb = Epi::PERM ? ((R & ~31) + perm32(R & 31)) : R;
        voffA[i] = (unsigned)(R * g.lda + C) * 2u; voffB[i] = (unsigned)(Rb * K + C) * 2u; }
    const size_t kstep = (size_t)(BK * 2);
    const size_t hsA = (size_t)HALF * g.lda * 2, hsB = (size_t)HALF * K * 2;
    const size_t tsA = 2 * hsA, tsB = 2 * hsB;
    const unsigned ldsw = (unsigned)wid * 1024u;
    const int aoff = lds_byte(wr * 64 + fr, fq * 8), boff = lds_byte(wc * 32 + fr, fq * 8);
#define PG8_SA(b, h) (((b) * 2 + (h)) * HTB)
#define PG8_SB(b, h) ((4 + (b) * 2 + (h)) * HTB)
#define PG8_STAGE(bufoff, gbase, voff) do { _Pragma("unroll") for (int _i = 0; _i < 2; ++_i) \
        __builtin_amdgcn_global_load_lds((const unsigned*)((const char*)(gbase) + (voff)[_i]), (PG8_LAS unsigned*)(lds + (bufoff) + ldsw + _i * 8192), 16, 0, 0); } while (0)
#define PG8_LDA(dst, b, h) do { _Pragma("unroll") for (int m = 0; m < 4; ++m) _Pragma("unroll") for (int k = 0; k < 2; ++k) dst[m][k] = *(const PG8_LAS bf16x8*)(lds + PG8_SA(b, h) + aoff + m * 2048 + k * 1024); } while (0)
#define PG8_LDB(dst, b, h) do { _Pragma("unroll") for (int n = 0; n < 2; ++n) _Pragma("unroll") for (int k = 0; k < 2; ++k) dst[n][k] = *(const PG8_LAS bf16x8*)(lds + PG8_SB(b, h) + boff + n * 2048 + k * 1024); } while (0)
#define PG8_MMA(ai, bj, At, Bt) do { __builtin_amdgcn_s_setprio(1); _Pragma("unroll") for (int m = 0; m < 4; ++m) _Pragma("unroll") for (int n = 0; n < 2; ++n) _Pragma("unroll") for (int k = 0; k < 2; ++k) \
        acc[ai][bj][m][n] = __builtin_amdgcn_mfma_f32_16x16x32_bf16(Bt[n][k], At[m][k], acc[ai][bj][m][n], 0, 0, 0); __builtin_amdgcn_s_setprio(0); } while (0)
#define PG8_WAIT_V(n) asm volatile("s_waitcnt vmcnt(" #n ")" ::: "memory")
#define PG8_WAIT_L(n) asm volatile("s_waitcnt lgkmcnt(" #n ")" ::: "memory")
#define PG8_BAR __builtin_amdgcn_s_barrier()
#define PG8_SCHED __builtin_amdgcn_sched_barrier(0)
    Unit cur, nxt; int ui = 0;
    if (!S.next(0, cur)) return;
    f32x4 acc[2][2][4][2];
#pragma unroll
    for (int a = 0; a < 2; ++a)
#pragma unroll
        for (int b = 0; b < 2; ++b)
#pragma unroll
            for (int m = 0; m < 4; ++m)
#pragma unroll
                for (int n = 0; n < 2; ++n) acc[a][b][m][n] = (f32x4){0.f, 0.f, 0.f, 0.f};
    bf16x8 At[4][2], B0[2][2], B1[2][2];
    const char* cA = (const char*)g.A + (size_t)cur.pm * tsA + (size_t)g.koff * 2; const char* cB = (const char*)g.Bt + (size_t)cur.pn * tsB + (size_t)g.koff * 2;
    S.a_ready(cur);
    if constexpr (SP2) {
        PG8_STAGE(PG8_SB(0, 0), cB, voffB); PG8_STAGE(PG8_SB(0, 1), cB + hsB, voffB); PG8_STAGE(PG8_SA(0, 0), cA, voffA); PG8_STAGE(PG8_SA(0, 1), cA + hsA, voffA);
        if (wr == 1) PG8_BAR;
        PG8_WAIT_V(2); PG8_BAR;
        PG8_STAGE(PG8_SB(1, 0), cB + kstep, voffB); PG8_STAGE(PG8_SA(1, 0), cA + kstep, voffA); PG8_STAGE(PG8_SB(1, 1), cB + hsB + kstep, voffB);
        PG8_WAIT_V(6); PG8_BAR;
    } else {
        PG8_STAGE(PG8_SB(0, 0), cB, voffB); PG8_STAGE(PG8_SA(0, 0), cA, voffA); PG8_STAGE(PG8_SB(0, 1), cB + hsB, voffB); PG8_STAGE(PG8_SA(0, 1), cA + hsA, voffA);
        if (wr == 1) PG8_BAR;
        PG8_WAIT_V(4); PG8_BAR;
        PG8_STAGE(PG8_SB(1, 0), cB + kstep, voffB); PG8_STAGE(PG8_SA(1, 0), cA + kstep, voffA); PG8_STAGE(PG8_SB(1, 1), cB + hsB + kstep, voffB);
        PG8_WAIT_V(6); PG8_BAR;
    }
    for (;;) {
        const bool has_next = S.next(ui + 1, nxt);
        const char* nA = has_next ? (const char*)g.A + (size_t)nxt.pm * tsA + (size_t)g.koff * 2 : cA; const char* nB = has_next ? (const char*)g.Bt + (size_t)nxt.pn * tsB + (size_t)g.koff * 2 : cB;
        for (int t = 0; t < nt; t += 2) {
            const bool last = (t == nt - 2);
            const char* a1 = cA + (size_t)(t + 1) * kstep;
            const char* a2 = last ? nA : cA + (size_t)(t + 2) * kstep; const char* b2 = last ? nB : cB + (size_t)(t + 2) * kstep;
            const char* a3 = a2 + kstep; const char* b3 = b2 + kstep;
            if (last && has_next) S.a_ready(nxt);
            if constexpr (SP2) {
            PG8_LDB(B0, 0, 0); PG8_LDB(B1, 0, 1); PG8_SCHED; PG8_LDA(At, 0, 0); PG8_STAGE(PG8_SA(1, 1), a1 + hsA, voffA);
            PG8_WAIT_V(8); PG8_WAIT_L(0); PG8_BAR; PG8_MMA(0, 0, At, B0); PG8_MMA(0, 1, At, B1); PG8_BAR; PG8_SCHED;
            PG8_LDA(At, 0, 1); PG8_STAGE(PG8_SB(0, 0), b2, voffB); PG8_STAGE(PG8_SB(0, 1), b2 + hsB, voffB); PG8_STAGE(PG8_SA(0, 0), a2, voffA);
            PG8_WAIT_V(8); PG8_WAIT_L(0); PG8_BAR; PG8_MMA(1, 0, At, B0); PG8_MMA(1, 1, At, B1); PG8_BAR; PG8_SCHED;
            PG8_LDB(B0, 1, 0); PG8_LDB(B1, 1, 1); PG8_SCHED; PG8_LDA(At, 1, 0); PG8_STAGE(PG8_SA(0, 1), a2 + hsA, voffA);
            PG8_WAIT_V(8); PG8_WAIT_L(0); PG8_BAR; PG8_MMA(0, 0, At, B0); PG8_MMA(0, 1, At, B1); PG8_BAR; PG8_SCHED;
            PG8_LDA(At, 1, 1); PG8_STAGE(PG8_SB(1, 0), b3, voffB); PG8_STAGE(PG8_SB(1, 1), b3 + hsB, voffB); PG8_STAGE(PG8_SA(1, 0), a3, voffA);
            PG8_WAIT_V(8); PG8_WAIT_L(0); PG8_BAR; PG8_MMA(1, 0, At, B0); PG8_MMA(1, 1, At, B1); PG8_BAR; PG8_SCHED;
            } else {
            PG8_LDB(B0, 0, 0); PG8_SCHED; PG8_LDA(At, 0, 0); PG8_STAGE(PG8_SA(1, 1), a1 + hsA, voffA);
            PG8_WAIT_L(8); PG8_BAR; PG8_WAIT_L(0); PG8_MMA(0, 0, At, B0); PG8_BAR; PG8_SCHED;
            PG8_LDB(B1, 0, 1); PG8_STAGE(PG8_SB(0, 0), b2, voffB);
            PG8_BAR; PG8_WAIT_L(0); PG8_MMA(0, 1, At, B1); PG8_BAR;
            PG8_LDA(At, 0, 1); PG8_STAGE(PG8_SA(0, 0), a2, voffA);
            PG8_BAR; PG8_WAIT_L(0); PG8_MMA(1, 0, At, B0); PG8_BAR; PG8_SCHED;
            PG8_STAGE(PG8_SB(0, 1), b2 + hsB, voffB);
            PG8_WAIT_V(6); PG8_BAR; PG8_MMA(1, 1, At, B1); PG8_BAR;
            PG8_LDB(B0, 1, 0); PG8_SCHED; PG8_LDA(At, 1, 0); PG8_STAGE(PG8_SA(0, 1), a2 + hsA, voffA);
            PG8_WAIT_L(8); PG8_BAR; PG8_WAIT_L(0); PG8_MMA(0, 0, At, B0); PG8_BAR; PG8_SCHED;
            PG8_LDB(B1, 1, 1); PG8_STAGE(PG8_SB(1, 0), b3, voffB);
            PG8_BAR; PG8_WAIT_L(0); PG8_MMA(0, 1, At, B1); PG8_BAR;
            PG8_LDA(At, 1, 1); PG8_STAGE(PG8_SA(1, 0), a3, voffA);
            PG8_BAR; PG8_WAIT_L(0); PG8_MMA(1, 0, At, B0); PG8_BAR; PG8_SCHED;
            PG8_STAGE(PG8_SB(1, 1), b3 + hsB, voffB);
            PG8_WAIT_V(6); PG8_BAR; PG8_MMA(1, 1, At, B1); PG8_BAR;
            }
        }
        if constexpr (ALIGN_EPI) { if (wr == 0) PG8_BAR; }
        if constexpr (!Epi::AFTER_DRAIN) { E(acc, cur, wr, wc, fr, fq); S.done(cur); }
        if (!has_next) break;
#pragma unroll
        for (int a = 0; a < 2; ++a)
#pragma unroll
            for (int b = 0; b < 2; ++b)
#pragma unroll
                for (int m = 0; m < 4; ++m)
#pragma unroll
                    for (int n = 0; n < 2; ++n) acc[a][b][m][n] = (f32x4){0.f, 0.f, 0.f, 0.f};
        cur = nxt; cA = nA; cB = nB; ++ui;
        if constexpr (ALIGN_EPI) { if (wr == 1) PG8_BAR; }
    }
    PG8_WAIT_V(0);
    if constexpr (!ALIGN_EPI) { if (wr == 0) PG8_BAR; }
    PG8_BAR;
    if constexpr (Epi::AFTER_DRAIN) { E.fused(acc, cur, wr, wc, fr, fq, lds, wid, lane); S.done(cur); }
#undef PG8_SA
#undef PG8_SB
#undef PG8_STAGE
#undef PG8_LDA
#undef PG8_LDB
#undef PG8_MMA
#undef PG8_WAIT_V
#undef PG8_WAIT_L
#undef PG8_BAR
#undef PG8_SCHED
}

}


#define XB_TMO      128
#define XB_XCNT(j)  (256  + 64 * (j))
#define XB_XSUB(j)  (1280 + 64 * (j))
#define XB_XGEN(j)  (2304 + 64 * (j))
#define XB_TOP      3328
#define XB_TOPGEN   3392
#define XCD_BAR_WORDS 3456
#define XB_SPIN_CAP (1u << 20)

__device__ __forceinline__ unsigned xb_ld(unsigned* p)              { return __hip_atomic_load(p, __ATOMIC_RELAXED, __HIP_MEMORY_SCOPE_AGENT); }
__device__ __forceinline__ unsigned xb_add(unsigned* p, unsigned v) { return __hip_atomic_fetch_add(p, v, __ATOMIC_RELAXED, __HIP_MEMORY_SCOPE_AGENT); }
__device__ __forceinline__ unsigned xb_xcc_id() { return (unsigned)__builtin_amdgcn_s_getreg((3 << 11) | 20) & 0xFu; }
#define XB_SPIN(cond, bar) do { unsigned _sp = 0; while (cond) { __builtin_amdgcn_s_sleep(1); \
    if ((++_sp & 255u) == 0u) { if (xb_ld(&(bar)[XB_TMO])) break; if (_sp > XB_SPIN_CAP) { atomicAdd(&(bar)[XB_TMO], 1u); break; } } } } while (0)

struct XcdBarrier {
    unsigned* bar; unsigned x;
    volatile LAS unsigned* st;
};

__device__ __forceinline__ XcdBarrier xcd_barrier_post(unsigned* bar, volatile LAS unsigned* st) {
    XcdBarrier b; b.bar = bar; b.x = xb_xcc_id(); b.st = st;
    if (threadIdx.x == 0) (void)xb_add(&bar[XB_XCNT(b.x)], 1u);
    return b;
}
__device__ __forceinline__ void xcd_barrier_complete(unsigned* bar, unsigned x, unsigned& nloc, unsigned& nx) {
    const unsigned G = gridDim.x * gridDim.y * gridDim.z;
    unsigned sum, cnt, mine, sp = 0u;
    for (;;) {
        sum = 0u; cnt = 0u; mine = 0u;
#pragma unroll
        for (unsigned j = 0; j < 16; ++j) { const unsigned c = xb_ld(&bar[XB_XCNT(j)]); sum += c; cnt += (c > 0u) ? 1u : 0u; mine = (j == x) ? c : mine; }
        if (sum == G) break;
        __builtin_amdgcn_s_sleep(1);
        if ((++sp & 255u) == 0u) { if (xb_ld(&bar[XB_TMO])) break; if (sp > XB_SPIN_CAP) { atomicAdd(&bar[XB_TMO], 1u); break; } }
    }
    nloc = mine > 0u ? mine : 1u; nx = cnt > 0u ? cnt : 1u;
}

__device__ __forceinline__ void xcd_barrier(const XcdBarrier& b) {
    asm volatile("s_waitcnt vmcnt(0)" ::: "memory");
    __syncthreads();
    if (threadIdx.x == 0) {
        unsigned* bar = b.bar;
        __builtin_amdgcn_s_waitcnt(0);
        unsigned nloc = b.st[0], nx = b.st[1];
        if (nloc == 0u) { xcd_barrier_complete(bar, b.x, nloc, nx); b.st[0] = nloc; b.st[1] = nx; }
        const unsigned old = xb_add(&bar[XB_XSUB(b.x)], 1u);
        const unsigned gen = old / nloc;
        if (old + 1u == (gen + 1u) * nloc) {
            __builtin_amdgcn_fence(__ATOMIC_RELEASE, "agent");
            asm volatile("s_waitcnt vmcnt(0)" ::: "memory");
            const unsigned og = xb_add(&bar[XB_TOP], 1u);
            const unsigned tg = og / nx;
            if (og + 1u == (tg + 1u) * nx) xb_add(&bar[XB_TOPGEN], 1u);
            else XB_SPIN(xb_ld(&bar[XB_TOPGEN]) == tg, bar);
            __builtin_amdgcn_fence(__ATOMIC_ACQUIRE, "agent");
            xb_add(&bar[XB_XGEN(b.x)], 1u);
            asm volatile("s_waitcnt vmcnt(0)" ::: "memory");
        } else {
            XB_SPIN(xb_ld(&bar[XB_XGEN(b.x)]) == gen, bar);
            __builtin_amdgcn_fence(__ATOMIC_ACQUIRE, "agent");
            asm volatile("s_waitcnt vmcnt(0)" ::: "memory");
        }
    }
    __syncthreads();
}

namespace na {
typedef short bf16x8 __attribute__((ext_vector_type(8)));
typedef short s16x4 __attribute__((ext_vector_type(4)));
typedef float f32x16 __attribute__((ext_vector_type(16)));
constexpr float LOG2E = 1.4426950408889634f;
constexpr int KOFF = 0, VOFF = 32768;
constexpr int N_LAT_UNITS = BATCH * NAH * (ROWS / 4), N_UNITS = N_LAT_UNITS + BATCH * NAH;
__device__ __forceinline__ s16x4 vtr(const LAS unsigned char* p) { return __builtin_bit_cast(s16x4, __builtin_amdgcn_ds_read_tr16_b64_v4i16((LAS s16x4*)p)); }
__device__ __forceinline__ int clampi(int v, int lo, int hi) { return v < lo ? lo : (v > hi ? hi : v); }

constexpr int BM_HEAD_BYTES = 15 * 4 * 2 * 64 * 8;
__device__ __forceinline__ void build_bias_table(bf16_t* BM, const float* rpb, int G, int bx) {
    for (int idx = bx * 512 + (int)threadIdx.x; idx < NAH * 15 * 4 * 2 * 64 * 4; idx += G * 512) {
        const int reg = idx & 3, lane = (idx >> 2) & 63, kb = (idx >> 8) & 1, jq = (idx >> 9) & 3, hd = idx >> 11;
        const int qc = 16 * jq + (lane & 15), kc = clampi(16 * jq - 8, 0, 32) + 16 * kb + 4 * (lane >> 4) + reg, cs = clampi(qc - 8, 0, GW - 16);
        BM[idx] = (kc >= cs && kc < cs + 16) ? f2bf(rpb[hd * 31 + kc - qc + 15]) : (bf16_t)0xFF80;
    }
}
constexpr int BMOFF = 65536;
template <int MODE> __device__ __forceinline__ void attn_phase(LAS unsigned char* lds, const bf16_t* QKV, const bf16_t* BM, const float* qg, const float* kg, bf16_t* O, int G, int vcu) {
    const int tid = threadIdx.x, lane = tid & 63, wave = __builtin_amdgcn_readfirstlane(tid >> 6), r32 = lane & 31, hi = lane >> 5;
    const int lkey = tid >> 3, lc16 = tid & 7;
    const int kwoff = lkey * 128 + ((lc16 ^ ((lkey >> 1) & 7)) * 16);
    const int vwoff = lkey * 128 + (((lc16 >> 1) ^ ((lkey >> 1) & 3)) * 32) + (lc16 & 1) * 16;
    const int i16 = lane & 15, g4 = lane >> 4;
    int lk = i16 * 128 + ((g4 ^ ((i16 >> 1) & 7)) * 16), lv = (4 * g4 + (i16 >> 2)) * 128 + (((2 * (g4 & 1) + (i16 >> 3)) & 3) << 5) + 8 * (i16 & 3);
    const int h = (vcu >> 4) & 15, wl = vcu & 15;
    float nshift;
    { const float gq = fabsf(qg[lane] * kg[lane]); float mxg = gq;
#pragma unroll
      for (int o = 1; o < 64; o <<= 1) mxg = fmaxf(mxg, __shfl_xor(mxg, o));
      nshift = -(8.f * mxg * 1.03f + 0.25f) * LOG2E; }
    { const v4u* src = (const v4u*)(BM + (size_t)h * (BM_HEAD_BYTES / 2));
      for (int i = tid; i < BM_HEAD_BYTES / 16; i += 512) *(LAS v4u*)(lds + BMOFF + i * 16) = src[i]; }
    __syncthreads();
    struct UnitP { int b, R, r, qrow0, rs, kr_lo, ntl, NT; bool is_ctx, valid; };
    auto unit_of = [&](int it) { UnitP q; q.is_ctx = it == 8; q.valid = it < 8 || (it == 8 && wl < 4);
        const int kk = it * 16 + wl; q.b = q.is_ctx ? wl : (kk >> 5); q.R = q.is_ctx ? 0 : (kk & 31);
        q.r = 4 * q.R + (wave >> 1); const int c0 = 32 * (wave & 1);
        q.qrow0 = q.is_ctx ? MLAT + q.b * CTX + wave * 32 : q.b * SEQ + q.r * GW + c0;
        q.rs = clampi(q.r - 4, 0, ROWS - 8);
        q.kr_lo = q.is_ctx ? 0 : clampi(4 * q.R - 4, 0, ROWS - 8); const int kr_hi = q.is_ctx ? 0 : clampi(4 * q.R - 1, 0, ROWS - 8) + 8;
        q.ntl = kr_hi - q.kr_lo; q.NT = q.ntl + 4; return q; };
    auto tile_ptr = [&](const UnitP& q, int t) -> const bf16_t* { const int row0 = t < q.ntl ? q.b * SEQ + (q.kr_lo + t) * GW : MLAT + q.b * CTX + (t - q.ntl) * 64;
        return QKV + (size_t)(row0 + lkey) * 3072 + D + h * 64 + lc16 * 8; };
    UnitP U = unit_of(0);
    bf16x8 qr[4]; v4u kreg[2], vreg[2];
#pragma unroll
    for (int f = 0; f < 4; ++f) qr[f] = *(const bf16x8*)(QKV + (size_t)(U.qrow0 + 16 * (f >> 1) + i16) * 3072 + h * 64 + (f & 1) * 32 + g4 * 8);
#pragma unroll
    for (int hh = 0; hh < 2; ++hh) { const bf16_t* kp = tile_ptr(U, hh); kreg[hh] = *(const v4u*)kp; vreg[hh] = *(const v4u*)(kp + D); }
    int bufpar = 0;
    for (int it = 0; it < 9 && U.valid; ++it) {
        const UnitP UN = unit_of(it + 1);
        const int b = U.b, r = U.r, qrow0 = U.qrow0, rs = U.rs, kr_lo = U.kr_lo, ntl = U.ntl, NT = U.NT;
        (void)b;
        float lsum[2] = {0.f, 0.f}; f32x4 o[8];
#pragma unroll
        for (int f = 0; f < 8; ++f) o[f] = (f32x4){0.f, 0.f, 0.f, 0.f};
        auto tile = [&](int t, const LAS unsigned char* Kb, const LAS unsigned char* Vb, const v2u (&cbw)[4]) {
            const bool local = t < ntl; const int kr = kr_lo + t;
            if (local) {
                const int sp0 = (wave & 1) ? 24 : 0, sp1 = (wave & 1) ? 32 : 8;
                (void)kr;
#pragma unroll
                for (int qb = 0; qb < 2; ++qb) { const int sp = qb ? sp1 : sp0;
                    bf16x8 kf[4];
#pragma unroll
                    for (int kb = 0; kb < 2; ++kb)
#pragma unroll
                        for (int ks = 0; ks < 2; ++ks) kf[2 * kb + ks] = *(const LAS bf16x8*)(Kb + (sp + 16 * kb) * 128 + (lk ^ ((ks ^ ((sp >> 3) & 1)) << 6)));
                    s16x4 va[8];
#pragma unroll
                    for (int db = 0; db < 4; ++db) { const LAS unsigned char* pa = Vb + sp * 128 + (lv ^ (db << 5)); va[db * 2] = vtr(pa); va[db * 2 + 1] = vtr(pa + 16 * 128); }
                    f32x4 sc[2];
#pragma unroll
                    for (int kb = 0; kb < 2; ++kb) { const v2u w = cbw[2 * qb + kb];
                        sc[kb] = (f32x4){__builtin_bit_cast(float, w.x << 16), __builtin_bit_cast(float, w.x & 0xffff0000u), __builtin_bit_cast(float, w.y << 16), __builtin_bit_cast(float, w.y & 0xffff0000u)};
#pragma unroll
                        for (int ks = 0; ks < 2; ++ks) sc[kb] = __builtin_amdgcn_mfma_f32_16x16x32_bf16(kf[2 * kb + ks], qr[2 * qb + ks], sc[kb], 0, 0, 0); }
                    if (MODE == 2 || MODE == 4) { o[qb * 4] = o[qb * 4] + sc[0] + sc[1]; continue; }
#pragma unroll
                    for (int kb = 0; kb < 2; ++kb)
#pragma unroll
                        for (int e2 = 0; e2 < 4; ++e2) { sc[kb][e2] = __builtin_amdgcn_exp2f(__builtin_fmaf(sc[kb][e2], LOG2E, nshift)); lsum[qb] += sc[kb][e2]; }
                    if (MODE == 3) { o[qb * 4] = o[qb * 4] + sc[0] + sc[1]; continue; }
                    v4u pw; pw.x = pg8::cvt_pk_bf16(sc[0][0], sc[0][1]); pw.y = pg8::cvt_pk_bf16(sc[0][2], sc[0][3]);
                    pw.z = pg8::cvt_pk_bf16(sc[1][0], sc[1][1]); pw.w = pg8::cvt_pk_bf16(sc[1][2], sc[1][3]);
                    const bf16x8 pf = __builtin_bit_cast(bf16x8, pw);
#pragma unroll
                    for (int db = 0; db < 4; ++db) { const s16x4 lo = va[db * 2], hi4 = va[db * 2 + 1];
                        const bf16x8 vf = {lo[0], lo[1], lo[2], lo[3], hi4[0], hi4[1], hi4[2], hi4[3]};
                        o[qb * 4 + db] = __builtin_amdgcn_mfma_f32_16x16x32_bf16(vf, pf, o[qb * 4 + db], 0, 0, 0); }
                }
            } else {
#pragma unroll
                for (int grp = 0; grp < 2; ++grp) {
                    bf16x8 kf[4];
#pragma unroll
                    for (int kb = 0; kb < 2; ++kb)
#pragma unroll
                        for (int ks = 0; ks < 2; ++ks) kf[2 * kb + ks] = *(const LAS bf16x8*)(Kb + (2 * grp + kb) * 2048 + (lk ^ (ks << 6)));
                    s16x4 va[8];
#pragma unroll
                    for (int db = 0; db < 4; ++db) { const LAS unsigned char* pa = Vb + grp * 4096 + (lv ^ (db << 5)); va[db * 2] = vtr(pa); va[db * 2 + 1] = vtr(pa + 16 * 128); }
#pragma unroll
                    for (int qb = 0; qb < 2; ++qb) {
                        f32x4 sc[2];
#pragma unroll
                        for (int kb = 0; kb < 2; ++kb) { sc[kb] = (f32x4){0.f, 0.f, 0.f, 0.f};
#pragma unroll
                            for (int ks = 0; ks < 2; ++ks) sc[kb] = __builtin_amdgcn_mfma_f32_16x16x32_bf16(kf[2 * kb + ks], qr[2 * qb + ks], sc[kb], 0, 0, 0); }
                        if (MODE == 2 || MODE == 4) { o[qb * 4] = o[qb * 4] + sc[0] + sc[1]; continue; }
#pragma unroll
                        for (int kb = 0; kb < 2; ++kb)
#pragma unroll
                            for (int e2 = 0; e2 < 4; ++e2) { sc[kb][e2] = __builtin_amdgcn_exp2f(__builtin_fmaf(sc[kb][e2], LOG2E, nshift)); lsum[qb] += sc[kb][e2]; }
                        if (MODE == 3) { o[qb * 4] = o[qb * 4] + sc[0] + sc[1]; continue; }
                        v4u pw; pw.x = pg8::cvt_pk_bf16(sc[0][0], sc[0][1]); pw.y = pg8::cvt_pk_bf16(sc[0][2], sc[0][3]);
                        pw.z = pg8::cvt_pk_bf16(sc[1][0], sc[1][1]); pw.w = pg8::cvt_pk_bf16(sc[1][2], sc[1][3]);
                        const bf16x8 pf = __builtin_bit_cast(bf16x8, pw);
#pragma unroll
                        for (int db = 0; db < 4; ++db) { const s16x4 lo = va[db * 2], hi4 = va[db * 2 + 1];
                            const bf16x8 vf = {lo[0], lo[1], lo[2], lo[3], hi4[0], hi4[1], hi4[2], hi4[3]};
                            o[qb * 4 + db] = __builtin_amdgcn_mfma_f32_16x16x32_bf16(vf, pf, o[qb * 4 + db], 0, 0, 0); }
                    }
                }
            }
        };
        const int NP = (NT + 1) >> 1;
        for (int sI = 0; sI < NP; ++sI) {
            asm volatile("" : "+v"(lk), "+v"(lv));
            const int t0 = 2 * sI, bo = bufpar * 16384; bufpar ^= 1;
#pragma unroll
            for (int hh = 0; hh < 2; ++hh) { *(LAS v4u*)(lds + KOFF + bo + hh * 8192 + kwoff) = kreg[hh]; *(LAS v4u*)(lds + VOFF + bo + hh * 8192 + vwoff) = vreg[hh]; }
            const bool lastp = sI + 1 >= NP;
#pragma unroll
            for (int hh = 0; hh < 2; ++hh) { const int tn = t0 + 2 + hh;
                const bf16_t* kp = !lastp ? tile_ptr(U, tn < NT ? tn : NT - 1) : tile_ptr(UN.valid ? UN : U, hh);
                kreg[hh] = *(const v4u*)kp; vreg[hh] = *(const v4u*)(kp + D); }
            bool need[2]; v2u cbw[2][4];
#pragma unroll
            for (int hh = 0; hh < 2; ++hh) { const int t = t0 + hh; const bool local = t < ntl; const int kr = kr_lo + t;
                need[hh] = MODE != 1 && t < NT && (!local || (kr >= rs && kr < rs + 8));
                if (need[hh] && local) { const LAS unsigned char* tp = lds + BMOFF + ((kr - r + 7) * 4 + 2 * (wave & 1)) * 1024 + lane * 8;
#pragma unroll
                    for (int f = 0; f < 4; ++f) cbw[hh][f] = *(const LAS v2u*)(tp + f * 512); } }
            __syncthreads();
#pragma unroll
            for (int hh = 0; hh < 2; ++hh)
                if (need[hh]) tile(t0 + hh, lds + KOFF + bo + hh * 8192, lds + VOFF + bo + hh * 8192, cbw[hh]);
        }
#pragma unroll
        for (int qb = 0; qb < 2; ++qb) {
            float l = lsum[qb]; l += __shfl_xor(l, 16); l += __shfl_xor(l, 32);
            const float rl = 1.f / l;
            bf16_t* op = O + (size_t)(qrow0 + 16 * qb + i16) * D + h * 64 + 4 * g4;
#pragma unroll
            for (int db = 0; db < 4; ++db) { v2u w; w.x = pg8::cvt_pk_bf16(o[qb * 4 + db][0] * rl, o[qb * 4 + db][1] * rl); w.y = pg8::cvt_pk_bf16(o[qb * 4 + db][2] * rl, o[qb * 4 + db][3] * rl);
                *(v2u*)(op + 16 * db) = w; }
        }
        U = UN;
        if (U.valid) {
#pragma unroll
            for (int f = 0; f < 4; ++f) qr[f] = *(const bf16x8*)(QKV + (size_t)(U.qrow0 + 16 * (f >> 1) + i16) * 3072 + h * 64 + (f & 1) * 32 + g4 * 8); }
    }
}
}


namespace hg {
typedef short bf16x8 __attribute__((ext_vector_type(8)));
typedef short s16x4 __attribute__((ext_vector_type(4)));
constexpr int QT = 0, KT = 16384, VT = 32768, AM = 49152, EB = 57344, EK = 57856, DL = 58368, OT = 59392;
constexpr int NSLOT = 9;
constexpr size_t STATE_SLOT_F = 128 * 128;
constexpr size_t WS_DEC_OFF = (size_t)64 * NSLOT * STATE_SLOT_F * 4;
__device__ __forceinline__ s16x4 vtr(const LAS unsigned char* p) { return __builtin_bit_cast(s16x4, __builtin_amdgcn_ds_read_tr16_b64_v4i16((LAS s16x4*)p)); }
__device__ __forceinline__ int fsw(int t) { return ((t & 3) ^ ((t >> 4) & 3)) | (((t >> 3) & 1) << 2); }
__device__ __forceinline__ int toff(int t, int c16) { return t * 256 + (((c16 >> 1) ^ fsw(t)) * 32) + (c16 & 1) * 16; }
#define HG_BAR() do { asm volatile("s_waitcnt vmcnt(0) lgkmcnt(0)" ::: "memory"); __builtin_amdgcn_s_barrier(); asm volatile("" ::: "memory"); } while (0)
#define HG_LBAR() do { asm volatile("s_waitcnt lgkmcnt(0)" ::: "memory"); __builtin_amdgcn_s_barrier(); asm volatile("" ::: "memory"); } while (0)

struct Stage { v4u q[2], k[2], v[2]; };
template <bool WITH_Q> __device__ __forceinline__ void stage_load(Stage& st, const unsigned short* HGO, int row0, int h, int dir, int tid) {
#pragma unroll
    for (int i = 0; i < 2; ++i) { const int p = tid + 512 * i, row = p >> 4, c16 = p & 15;
        const unsigned short* src = HGO + (size_t)(row0 + row) * 5120 + h * 128 + c16 * 8;
        if (WITH_Q) st.q[i] = *(const v4u*)src;
        st.v[i] = *(const v4u*)(src + D); st.k[i] = *(const v4u*)(src + (3 + dir) * D); }
}
template <bool WITH_Q> __device__ __forceinline__ void stage_store(const Stage& st, LAS unsigned char* lds, int tid) {
#pragma unroll
    for (int i = 0; i < 2; ++i) { const int p = tid + 512 * i, o16 = toff(p >> 4, p & 15);
        if (WITH_Q) *(LAS v4u*)(lds + QT + o16) = st.q[i];
        *(LAS v4u*)(lds + KT + o16) = st.k[i];
        *(LAS v4u*)(lds + VT + o16) = st.v[i]; }
}
struct Bases { int b0, bq, bt, ba, bw, bo, bp, bs; };
__device__ __forceinline__ Bases make_bases(int tid) {
    const int lane = tid & 63, wave = tid >> 6, i16 = lane & 15, g = lane >> 4, kp = tid >> 3, seg = tid & 7;
    const int F0 = (i16 & 3) | (((i16 >> 3) & 1) << 2);
    Bases B;
    B.b0 = (i16 * 256) | ((F0 ^ (g >> 1)) << 5) | ((g & 1) << 4);
    B.bq = (i16 * 256) | (F0 << 5) | ((g >> 1) << 4) | ((g & 1) << 3);
    B.bt = ((8 * g + (i16 >> 2)) * 256) | ((((i16 >> 2) ^ (g >> 1)) | ((g & 1) << 2)) << 5) | (8 * (i16 & 3));
    B.ba = (i16 * 128) | ((g ^ ((i16 >> 1) & 7)) << 4);
    B.bw = (i16 * 128) | (((g >> 1) ^ ((i16 >> 1) & 7)) << 4) | ((g & 1) << 3);
    B.bo = (g * 2048) | ((wave ^ g) << 6) | (i16 << 2);
    B.bp = (seg * 2048) | (((kp >> 3) ^ (seg >> 1) ^ ((seg & 1) << 2)) << 5) | (((kp >> 2) & 1) << 4) | ((kp & 3) << 2);
    B.bs = toff(tid >> 4, tid & 15);
    return B;
}
#define HG_LAUNDER(B) asm volatile("" : "+v"((B).b0), "+v"((B).bq), "+v"((B).bt), "+v"((B).ba), "+v"((B).bw), "+v"((B).bo), "+v"((B).bp), "+v"((B).bs))
template <bool WITH_Q> __device__ __forceinline__ void stage_store2(const Stage& st, LAS unsigned char* lds, int bs) {
#pragma unroll
    for (int i = 0; i < 2; ++i) { const int o16 = (bs ^ (i << 6)) + i * 8192;
        if (WITH_Q) *(LAS v4u*)(lds + QT + o16) = st.q[i];
        *(LAS v4u*)(lds + KT + o16) = st.k[i];
        *(LAS v4u*)(lds + VT + o16) = st.v[i]; }
}
template <bool FULL> __device__ __forceinline__ void prep(LAS unsigned char* lds, int dir, int tid, int bp) {
    const int kp = tid >> 3, seg = tid & 7;
    float kg[8][2], c[8][2];
#pragma unroll
    for (int i = 0; i < 8; ++i) {
        const unsigned kk = *(const LAS unsigned*)(lds + KT + (bp ^ ((i & 3) << 5)) + i * 256);
        kg[i][0] = h2f((f16_t)(kk & 0xffffu)); kg[i][1] = h2f((f16_t)(kk >> 16));
        c[i][0] = __builtin_amdgcn_logf(1.f - kg[i][0]); c[i][1] = __builtin_amdgcn_logf(1.f - kg[i][1]); }
    float tots[2] = {0.f, 0.f};
#pragma unroll
    for (int i = 0; i < 8; ++i) { tots[0] += c[i][0]; tots[1] += c[i][1]; }
    if (dir == 0) {
#pragma unroll
        for (int i = 1; i < 8; ++i) { c[i][0] += c[i - 1][0]; c[i][1] += c[i - 1][1]; }
    } else {
#pragma unroll
        for (int i = 6; i >= 0; --i) { c[i][0] += c[i + 1][0]; c[i][1] += c[i + 1][1]; }
    }
    float off[2], bend[2], bref[2];
#pragma unroll
    for (int ch = 0; ch < 2; ++ch) {
        const float tot = tots[ch]; float inc = tot;
#pragma unroll
        for (int d = 1; d < 8; d <<= 1) { const float up = __shfl_up(inc, d, 8), dn = __shfl_down(inc, d, 8);
            if (dir == 0) { if (seg >= d) inc += up; } else { if (seg + d < 8) inc += dn; } }
        off[ch] = inc - tot; bend[ch] = __shfl(inc, dir == 0 ? 7 : 0, 8); bref[ch] = __shfl(inc, dir == 0 ? 3 : 4, 8);
    }
#pragma unroll
    for (int i = 0; i < 8; ++i) { const int o4 = (bp ^ ((i & 3) << 5)) + i * 256;
        const float b0 = off[0] + c[i][0], b1 = off[1] + c[i][1];
        const float e20 = __builtin_amdgcn_exp2f(fminf(bref[0] - b0, 100.f)), e21 = __builtin_amdgcn_exp2f(fminf(bref[1] - b1, 100.f));
        *(LAS unsigned*)(lds + KT + o4) = pg8::cvt_pk_bf16(kg[i][0] * e20, kg[i][1] * e21);
        if (FULL) {
            const unsigned qq = *(const LAS unsigned*)(lds + QT + o4);
            const float q0 = __builtin_bit_cast(float, qq << 16), q1 = __builtin_bit_cast(float, qq & 0xffff0000u);
            const float e10 = __builtin_amdgcn_exp2f(fminf(b0 - bref[0], 100.f)), e11 = __builtin_amdgcn_exp2f(fminf(b1 - bref[1], 100.f));
            *(LAS unsigned*)(lds + QT + o4) = pg8::cvt_pk_bf16(q0 * e10, q1 * e11);
        }
    }
    if (seg == 0) {
        if (FULL) { f32x2 e; e.x = __builtin_amdgcn_exp2f(bref[0]); e.y = __builtin_amdgcn_exp2f(bref[1]); *(LAS f32x2*)(lds + EB + 2 * kp * 4) = e; }
        { f32x2 e; e.x = __builtin_amdgcn_exp2f(bend[0] - bref[0]); e.y = __builtin_amdgcn_exp2f(bend[1] - bref[1]); *(LAS f32x2*)(lds + EK + 2 * kp * 4) = e; }
        { f32x2 e; e.x = __builtin_amdgcn_exp2f(bend[0]); e.y = __builtin_amdgcn_exp2f(bend[1]); *(LAS f32x2*)(lds + DL + 2 * kp * 4) = e; }
    }
}
__device__ __forceinline__ void load_vB(bf16x8 (&vB)[2], const LAS unsigned char* lds, int wave, int bt) {
#pragma unroll
    for (int ks = 0; ks < 2; ++ks) {
        const LAS unsigned char* pa = lds + VT + (bt ^ ((wave ^ (2 * (ks & 1))) << 5)) + ks * 8192;
        const s16x4 lo = vtr(pa), hi4 = vtr(pa + 1024);
        vB[ks] = (bf16x8){lo[0], lo[1], lo[2], lo[3], hi4[0], hi4[1], hi4[2], hi4[3]}; }
}
__device__ __forceinline__ void state_update(f32x4 (&S)[8], const bf16x8 (&vB)[2], const LAS unsigned char* lds, int g, int bt) {
#pragma unroll
    for (int kb = 0; kb < 8; ++kb) {
        const f32x4 d4 = *(const LAS f32x4*)(lds + DL + (16 * kb + 4 * g) * 4), e4 = *(const LAS f32x4*)(lds + EK + (16 * kb + 4 * g) * 4);
        f32x4 acc = {0.f, 0.f, 0.f, 0.f};
#pragma unroll
        for (int ks = 0; ks < 2; ++ks) {
            const LAS unsigned char* pa = lds + KT + (bt ^ ((kb ^ (2 * (ks & 1))) << 5)) + ks * 8192;
            const s16x4 lo = vtr(pa), hi4 = vtr(pa + 1024);
            const bf16x8 a = {lo[0], lo[1], lo[2], lo[3], hi4[0], hi4[1], hi4[2], hi4[3]};
            acc = __builtin_amdgcn_mfma_f32_16x16x32_bf16(a, vB[ks], acc, 0, 0, 0); }
        S[kb] = S[kb] * d4 + acc * e4; }
}
__device__ __forceinline__ f32x4* state_ptr(float* base, int chain, int slot) { return (f32x4*)(base + ((size_t)chain * NSLOT + slot) * STATE_SLOT_F); }

template <int MODE> __device__ __forceinline__ void phase1(LAS unsigned char* lds, const unsigned short* HGO, float* STATE, int G, int vcu) {
    const int tid = threadIdx.x, lane = tid & 63, wave = __builtin_amdgcn_readfirstlane(tid >> 6);
    const int kp = tid >> 3, seg = tid & 7;
    float* DEC = STATE + WS_DEC_OFF / 4;
    Bases B = make_bases(tid);
    constexpr int BUFB = 32768;
    for (int it = 0;; ++it) {
        const int u = it * G + vcu; if (u >= 512) break;
        int chain, pi; if (u < 448) { chain = u / 7; pi = 1 + u % 7; } else { chain = u - 448; pi = 0; }
        const int b = chain >> 4, h = (chain >> 1) & 7, dir = chain & 1;
        const int nch = pi == 0 ? 4 : 16;
        const int base = pi == 0 ? MLAT + b * CTX : b * SEQ + (dir == 0 ? pi - 1 : 8 - pi) * 1024;
        f32x4 S[8];
#pragma unroll
        for (int kb = 0; kb < 8; ++kb) S[kb] = (f32x4){0.f, 0.f, 0.f, 0.f};
        float carry[2] = {0.f, 0.f};
        unsigned krA[8], krB[8]; v4u vrA[2], vrB[2];
        auto issue = [&](int j, unsigned (&kraw)[8], v4u (&vraw)[2]) { const int cm = dir == 0 ? nch - 1 - j : j; const int row0 = base + cm * 64;
            const unsigned short* kb_ = HGO + (size_t)(row0 + 8 * seg) * 5120 + (3 + dir) * D + h * 128 + 2 * kp;
#pragma unroll
            for (int i = 0; i < 8; ++i) kraw[i] = *(const unsigned*)(kb_ + (size_t)i * 5120);
#pragma unroll
            for (int i = 0; i < 2; ++i) { const int p = tid + 512 * i; vraw[i] = *(const v4u*)(HGO + (size_t)(row0 + (p >> 4)) * 5120 + D + h * 128 + (p & 15) * 8); } };
        auto prep_store = [&](int buf, const unsigned (&kraw)[8], const v4u (&vraw)[2]) {
            if (MODE == 2) {
#pragma unroll
                for (int i = 0; i < 8; ++i) *(LAS unsigned*)(lds + buf * BUFB + (B.bp ^ ((i & 3) << 5)) + i * 256) = kraw[i];
#pragma unroll
                for (int i = 0; i < 2; ++i) *(LAS v4u*)(lds + buf * BUFB + 16384 + (B.bs ^ (i << 6)) + i * 8192) = vraw[i];
                return; }
            float kg[8][2], c[8][2], tot[2] = {0.f, 0.f};
#pragma unroll
            for (int i = 0; i < 8; ++i) { kg[i][0] = h2f((f16_t)(kraw[i] & 0xffffu)); kg[i][1] = h2f((f16_t)(kraw[i] >> 16));
                c[i][0] = __builtin_amdgcn_logf(1.f - kg[i][0]); c[i][1] = __builtin_amdgcn_logf(1.f - kg[i][1]); tot[0] += c[i][0]; tot[1] += c[i][1]; }
            float ex[8][2];
            if (dir == 0) { float r0 = 0.f, r1 = 0.f;
#pragma unroll
                for (int i = 7; i >= 0; --i) { ex[i][0] = r0; ex[i][1] = r1; r0 += c[i][0]; r1 += c[i][1]; } }
            else { float r0 = 0.f, r1 = 0.f;
#pragma unroll
                for (int i = 0; i < 8; ++i) { ex[i][0] = r0; ex[i][1] = r1; r0 += c[i][0]; r1 += c[i][1]; } }
#pragma unroll
            for (int ch = 0; ch < 2; ++ch) { float inc = tot[ch];
#pragma unroll
                for (int d = 1; d < 8; d <<= 1) { const float up = __shfl_up(inc, d, 8), dn = __shfl_down(inc, d, 8);
                    if (dir == 0) { if (seg + d < 8) inc += dn; } else { if (seg >= d) inc += up; } }
                const float off = inc - tot[ch] + carry[ch];
                carry[ch] += __shfl(inc, dir == 0 ? 0 : 7, 8);
#pragma unroll
                for (int i = 0; i < 8; ++i) ex[i][ch] += off; }
#pragma unroll
            for (int i = 0; i < 8; ++i)
                *(LAS unsigned*)(lds + buf * BUFB + (B.bp ^ ((i & 3) << 5)) + i * 256) = pg8::cvt_pk_bf16(kg[i][0] * __builtin_amdgcn_exp2f(ex[i][0]), kg[i][1] * __builtin_amdgcn_exp2f(ex[i][1]));
#pragma unroll
            for (int i = 0; i < 2; ++i) *(LAS v4u*)(lds + buf * BUFB + 16384 + (B.bs ^ (i << 6)) + i * 8192) = vraw[i];
        };
        auto mma = [&](int buf) {
            const LAS unsigned char* kt = lds + buf * BUFB; const LAS unsigned char* vt = kt + 16384;
            bf16x8 vB[2];
#pragma unroll
            for (int ks = 0; ks < 2; ++ks) { const LAS unsigned char* pa = vt + (B.bt ^ ((wave ^ (2 * (ks & 1))) << 5)) + ks * 8192;
                const s16x4 lo = vtr(pa), hi4 = vtr(pa + 1024); vB[ks] = (bf16x8){lo[0], lo[1], lo[2], lo[3], hi4[0], hi4[1], hi4[2], hi4[3]}; }
#pragma unroll
            for (int kb = 0; kb < 8; ++kb)
#pragma unroll
                for (int ks = 0; ks < 2; ++ks) { const LAS unsigned char* pa = kt + (B.bt ^ ((kb ^ (2 * (ks & 1))) << 5)) + ks * 8192;
                    const s16x4 lo = vtr(pa), hi4 = vtr(pa + 1024);
                    const bf16x8 a = {lo[0], lo[1], lo[2], lo[3], hi4[0], hi4[1], hi4[2], hi4[3]};
                    S[kb] = __builtin_amdgcn_mfma_f32_16x16x32_bf16(a, vB[ks], S[kb], 0, 0, 0); }
        };
        HG_LAUNDER(B);
        issue(0, krA, vrA); issue(1, krB, vrB);
        HG_LBAR();
        prep_store(0, krA, vrA);
        issue(2, krA, vrA);
        HG_LBAR();
        for (int j = 0; j < nch; j += 2) {
            HG_LAUNDER(B);
            if (MODE != 1) mma(0);
            prep_store(1, krB, vrB); if (j + 3 < nch) issue(j + 3, krB, vrB);
            HG_LBAR();
            if (MODE != 1) mma(1);
            if (j + 2 < nch) { prep_store(0, krA, vrA); if (j + 4 < nch) issue(j + 4, krA, vrA); }
            HG_LBAR();
        }
        f32x4* sp = state_ptr(STATE, chain, pi) + (size_t)wave * 8 * 64 + lane;
#pragma unroll
        for (int kb = 0; kb < 8; ++kb) sp[kb * 64] = S[kb];
        if (seg == 0) { f32x2 d2; d2.x = __builtin_amdgcn_exp2f(carry[0]); d2.y = __builtin_amdgcn_exp2f(carry[1]); *(f32x2*)(DEC + ((size_t)chain * NSLOT + pi) * 128 + 2 * kp) = d2; }
    }
}
__device__ __forceinline__ void phase2(float* STATE, int G, int bx) {
    const float* DEC = STATE + WS_DEC_OFF / 4;
    for (int e = bx * 512 + (int)threadIdx.x; e < 64 * 4096; e += G * 512) {
        const int chain = e >> 12, r = e & 4095, kb = (r >> 6) & 7, lane = r & 63;
        f32x4* sp = state_ptr(STATE, chain, 0) + r;
        f32x4 run = sp[0];
#pragma unroll
        for (int i = 1; i < NSLOT; ++i) {
            f32x4 tmp = {0.f, 0.f, 0.f, 0.f}, d4 = {0.f, 0.f, 0.f, 0.f};
            if (i < NSLOT - 1) { tmp = sp[(size_t)i * 4096]; d4 = *(const f32x4*)(DEC + ((size_t)chain * NSLOT + i) * 128 + 16 * kb + 4 * (lane >> 4)); }
            sp[(size_t)i * 4096] = run;
            run = d4 * run + tmp;
        }
    }
}
constexpr int P3BUF = 58880, P3OT = 2 * P3BUF;
__device__ __forceinline__ void phase3(LAS unsigned char* lds, unsigned short* HGO, float* STATE, const float* norm_g, int G, int vcu, volatile LAS unsigned* tacc) {
    const int tid = threadIdx.x, lane = tid & 63, wave = __builtin_amdgcn_readfirstlane(tid >> 6), i16 = lane & 15, g = lane >> 4;
    Bases B = make_bases(tid);
    for (int it = 0;; ++it) {
        const int u = it * G + vcu; if (u >= 256) break;
        const int b = u >> 6, h = (u >> 3) & 7, j = u & 7;
        const int base = b * SEQ + j * 1024;
        for (int dir = 0; dir < 2; ++dir) {
            const int chain = (b * 8 + h) * 2 + dir, pi = dir == 0 ? j + 1 : 8 - j;
            f32x4 S[8];
            { const f32x4* sp = state_ptr(STATE, chain, pi) + (size_t)wave * 8 * 64 + lane;
#pragma unroll
              for (int kb = 0; kb < 8; ++kb) S[kb] = sp[kb * 64]; }
            auto chunk_of = [&](int ci) { return dir == 0 ? ci : 15 - ci; };
            auto intra = [&](LAS unsigned char* L) {
#pragma unroll
                for (int pp = 0; pp < 2; ++pp) { const int p = 2 * wave + pp, sb = p >> 2, tb = p & 3;
                    f32x4 acc = {0.f, 0.f, 0.f, 0.f};
                    const int tr = 16 * tb + i16;
#pragma unroll
                    for (int ks = 0; ks < 4; ++ks) {
                        const bf16x8 a = *(const LAS bf16x8*)(L + KT + (B.b0 ^ ((sb << 5) ^ (ks << 6))) + sb * 4096);
                        const bf16x8 bq = *(const LAS bf16x8*)(L + QT + (B.b0 ^ ((tb << 5) ^ (ks << 6))) + tb * 4096);
                        acc = __builtin_amdgcn_mfma_f32_16x16x32_bf16(a, bq, acc, 0, 0, 0); }
#pragma unroll
                    for (int reg = 0; reg < 4; ++reg) { const int s = 16 * sb + 4 * g + reg; const bool ok = dir == 0 ? (s <= tr) : (s >= tr); if (!ok) acc[reg] = 0.f; }
                    v2u w; w.x = pg8::cvt_pk_bf16(acc[0], acc[1]); w.y = pg8::cvt_pk_bf16(acc[2], acc[3]);
                    *(LAS v2u*)(L + AM + (B.bw ^ (sb << 5)) + tb * 2048) = w; }
            };
            auto main_state = [&](LAS unsigned char* L) {
                bf16x8 vB[2]; load_vB(vB, L, wave, B.bt);
                bf16x8 sB[4];
#pragma unroll
                for (int kk = 0; kk < 4; ++kk) {
                    const f32x4 ea = *(const LAS f32x4*)(L + EB + (32 * kk + 4 * g) * 4), eb = *(const LAS f32x4*)(L + EB + (32 * kk + 16 + 4 * g) * 4);
                    const f32x4 sa = S[2 * kk] * ea, sb2 = S[2 * kk + 1] * eb;
                    v4u w; w.x = pg8::cvt_pk_bf16(sa[0], sa[1]); w.y = pg8::cvt_pk_bf16(sa[2], sa[3]); w.z = pg8::cvt_pk_bf16(sb2[0], sb2[1]); w.w = pg8::cvt_pk_bf16(sb2[2], sb2[3]);
                    sB[kk] = __builtin_bit_cast(bf16x8, w); }
#pragma unroll
                for (int tb = 0; tb < 4; ++tb) { f32x4 acc = {0.f, 0.f, 0.f, 0.f};
#pragma unroll
                    for (int ks = 0; ks < 2; ++ks) { const bf16x8 a = *(const LAS bf16x8*)(L + AM + (B.ba ^ (ks << 6)) + tb * 2048);
                        acc = __builtin_amdgcn_mfma_f32_16x16x32_bf16(a, vB[ks], acc, 0, 0, 0); }
#pragma unroll
                    for (int kk = 0; kk < 4; ++kk) {
                        const v2u lo = *(const LAS v2u*)(L + QT + (B.bq ^ (((2 * kk) ^ tb) << 5)) + tb * 4096);
                        const v2u hi2 = *(const LAS v2u*)(L + QT + (B.bq ^ (((2 * kk + 1) ^ tb) << 5)) + tb * 4096);
                        v4u w; w.x = lo.x; w.y = lo.y; w.z = hi2.x; w.w = hi2.y;
                        acc = __builtin_amdgcn_mfma_f32_16x16x32_bf16(__builtin_bit_cast(bf16x8, w), sB[kk], acc, 0, 0, 0); }
#pragma unroll
                    for (int reg = 0; reg < 4; ++reg) *(LAS float*)(lds + P3OT + (B.bo ^ ((tb & 1) << 8)) + tb * 8192 + reg * 512) = acc[reg];
                }
                state_update(S, vB, L, g, B.bt);
            };
            v4u ofp[2], gp[2];
            auto output = [&](int row0) {
                const f32x4 ng0 = *(const f32x4*)(norm_g + 8 * (tid & 15)), ng1 = *(const f32x4*)(norm_g + 8 * (tid & 15) + 4);
                const int ob0 = (tid >> 4) * 512 + ((((tid & 15) >> 1) ^ wave) * 64) + (tid & 1) * 32;
#pragma unroll
                for (int i = 0; i < 2; ++i) { const int p = tid + 512 * i, row = p >> 4, c16 = p & 15;
                    const LAS unsigned char* op = lds + P3OT + ob0 + i * 16384;
                    f32x4 o0 = *(const LAS f32x4*)op, o1 = *(const LAS f32x4*)(op + 16);
                    unsigned short* dst = HGO + (size_t)(row0 + row) * 5120 + h * 128 + c16 * 8;
                    if (dir == 0) { *(v4u*)(dst + 3 * D) = pg8::pack8(o0, o1); }
                    else {
                        const v4u f = ofp[i], gg = gp[i];
#pragma unroll
                        for (int q2 = 0; q2 < 2; ++q2) { o0[2 * q2] += __builtin_bit_cast(float, f[q2] << 16); o0[2 * q2 + 1] += __builtin_bit_cast(float, f[q2] & 0xffff0000u);
                            o1[2 * q2] += __builtin_bit_cast(float, f[2 + q2] << 16); o1[2 * q2 + 1] += __builtin_bit_cast(float, f[2 + q2] & 0xffff0000u); }
                        float ss = pg8::sq4(o0) + pg8::sq4(o1);
                        ss += __shfl_xor(ss, 1); ss += __shfl_xor(ss, 2); ss += __shfl_xor(ss, 4); ss += __shfl_xor(ss, 8);
                        const float rinv = rsqrtf(ss * (1.f / 128.f) + EPS);
                        f32x4 g0, g1;
#pragma unroll
                        for (int q2 = 0; q2 < 2; ++q2) { g0[2 * q2] = __builtin_bit_cast(float, gg[q2] << 16); g0[2 * q2 + 1] = __builtin_bit_cast(float, gg[q2] & 0xffff0000u);
                            g1[2 * q2] = __builtin_bit_cast(float, gg[2 + q2] << 16); g1[2 * q2 + 1] = __builtin_bit_cast(float, gg[2 + q2] & 0xffff0000u); }
                        *(v4u*)dst = pg8::pack8(o0 * rinv * ng0 * g0, o1 * rinv * ng1 * g1);
                    }
                }
            };
            Stage st;
            HG_LAUNDER(B);
            stage_load<true>(st, HGO, base + chunk_of(0) * 64, h, dir, tid);
            stage_store2<true>(st, lds, B.bs);
            stage_load<true>(st, HGO, base + chunk_of(1) * 64, h, dir, tid);
            HG_LBAR();
            prep<true>(lds, dir, tid, B.bp);
            HG_LBAR();
            intra(lds);
            stage_store2<true>(st, lds + P3BUF, B.bs);
            stage_load<true>(st, HGO, base + chunk_of(2) * 64, h, dir, tid);
            HG_LBAR();
            for (int ci = 0; ci < 16; ++ci) {
                LAS unsigned char* Lm = lds + (ci & 1) * P3BUF; LAS unsigned char* Ln = lds + ((ci & 1) ^ 1) * P3BUF;
                const int row0 = base + chunk_of(ci) * 64;
                HG_LAUNDER(B);
                const unsigned tp0 = tacc ? (unsigned)__builtin_amdgcn_s_memrealtime() : 0u;
                if (dir == 1) {
#pragma unroll
                    for (int i = 0; i < 2; ++i) { const int p = tid + 512 * i; const unsigned short* src = HGO + (size_t)(row0 + (p >> 4)) * 5120 + h * 128 + (p & 15) * 8;
                        ofp[i] = *(const v4u*)(src + 3 * D); gp[i] = *(const v4u*)(src + 2 * D); }
                }
                if (ci + 1 < 16) prep<true>(Ln, dir, tid, B.bp);
                main_state(Lm);
                HG_LBAR();
                const unsigned tp1 = tacc ? (unsigned)__builtin_amdgcn_s_memrealtime() : 0u;
                if (ci + 1 < 16) intra(Ln);
                output(row0);
                if (ci + 2 < 16) { stage_store2<true>(st, Lm, B.bs); if (ci + 3 < 16) stage_load<true>(st, HGO, base + chunk_of(ci + 3) * 64, h, dir, tid); }
                HG_LBAR();
                if (tacc && tid == 0) { const unsigned tp2 = (unsigned)__builtin_amdgcn_s_memrealtime(); tacc[0] += tp1 - tp0; tacc[1] += tp2 - tp1; }
            }
            HG_BAR();
        }
    }
}
}


constexpr int NWAVES = 8;
constexpr int RING_BYTES = 131072, LDS_BYTES = 163840, MISC_OFF = LDS_BYTES - 512;
typedef GAS unsigned gu32;
#define LDS_WAIT() asm volatile("s_waitcnt lgkmcnt(0)" ::: "memory")
#define VM_WAIT() asm volatile("s_waitcnt vmcnt(0)" ::: "memory")
__device__ __forceinline__ float wave_sum(float v) {
#pragma unroll
    for (int o = 1; o < 64; o <<= 1) v += __shfl_xor(v, o);
    return v;
}
#ifndef PROBE_MASK
#define PROBE_MASK 0u
#endif
#define PROBE_MUL 2u
struct Args { const float* in[19]; float* out; unsigned char* ws; int ph_lo, ph_hi; };

template <class PermF> __device__ __forceinline__ void p0_transpose_item(const float* W, int K, int N, bf16_t* WT, int k0, int n0, PermF perm, LAS float* scr, int lane) {
#pragma unroll 16
    for (int kk = 0; kk < 64; ++kk) scr[kk * 65 + lane] = W[(size_t)(k0 + kk) * N + n0 + lane];
    LDS_WAIT(); asm volatile("" ::: "memory");
    const int c = lane & 7;
#pragma unroll
    for (int j = 0; j < 8; ++j) { const int n = (lane >> 3) + 8 * j; const LAS float* s = scr + (8 * c) * 65 + n;
        v4u o; o.x = pk2(s[0 * 65], s[1 * 65]); o.y = pk2(s[2 * 65], s[3 * 65]); o.z = pk2(s[4 * 65], s[5 * 65]); o.w = pk2(s[6 * 65], s[7 * 65]);
        const int drow = perm(n0 + (n & ~31)) + (n & 31);
        *(v4u*)(WT + (size_t)drow * K + k0 + 8 * c) = o; }
    LDS_WAIT(); asm volatile("" ::: "memory");
}
__device__ __forceinline__ int perm_qkv(int n0) { const int t = n0 & 255, wc = t >> 6, bj = (t >> 5) & 1; return (n0 & ~255) + 128 * bj + 32 * wc; }
__device__ __forceinline__ int perm_ffn(int n0) { const int bj = n0 >= DFF ? 1 : 0, c = n0 - bj * DFF; return (c >> 7) * 256 + bj * 128 + (c & 127); }

__device__ __forceinline__ void naive_attn_item(const bf16_t* QKV, const float* rpb, bf16_t* O, int idx) {
    const int h = idx & 15, row = idx >> 4;
    float q[64], o[64]; float m = -INFINITY, l = 0.f;
    { const bf16_t* qp = QKV + (size_t)row * 3072 + h * 64;
#pragma unroll
      for (int i = 0; i < 64; ++i) { q[i] = bf2f(qp[i]); o[i] = 0.f; } }
    const int b = row_batch(row);
    auto visit = [&](int krow, float bias) {
        const bf16_t* kp = QKV + (size_t)krow * 3072 + D + h * 64; const bf16_t* vp = kp + D;
        float s = 0.f;
#pragma unroll
        for (int i = 0; i < 64; ++i) s += q[i] * bf2f(kp[i]);
        s += bias;
        const float mn = fmaxf(m, s), f = __expf(m - mn), p = __expf(s - mn);
        l = l * f + p;
#pragma unroll
        for (int i = 0; i < 64; ++i) o[i] = o[i] * f + p * bf2f(vp[i]);
        m = mn;
    };
    if (row < MLAT) {
        const int t = row & (SEQ - 1), r = t >> 6, c = t & 63;
        int rs = r - 4; rs = rs < 0 ? 0 : (rs > ROWS - 8 ? ROWS - 8 : rs);
        int cs = c - 8; cs = cs < 0 ? 0 : (cs > GW - 16 ? GW - 16 : cs);
        for (int j = 0; j < 8; ++j)
            for (int w = 0; w < 16; ++w) {
                const int kr = rs + j, kc = cs + w;
                visit(b * SEQ + kr * GW + kc, rpb[(h * 15 + (kr - r + 7)) * 31 + (kc - c + 15)]);
            }
    }
    for (int kk = 0; kk < CTX; ++kk) visit(MLAT + b * CTX + kk, 0.f);
    const float rl = 1.f / l;
    bf16_t* op = O + (size_t)row * D + h * 64;
#pragma unroll
    for (int i = 0; i < 64; ++i) op[i] = f2bf(o[i] * rl);
}
__device__ __forceinline__ void naive_hgscan(unsigned short* HGO, const float* norm_g, int bh, LAS float* sm) {
    LAS float (*sq)[128] = (LAS float (*)[128])sm; LAS float (*sk)[128] = (LAS float (*)[128])(sm + 256); LAS float (*red)[2] = (LAS float (*)[2])(sm + 512);
    const int b = bh >> 3, h = bh & 7, v = threadIdx.x & 127; const bool act = threadIdx.x < 128;
    const int NS = CTX + SEQ;
    const float ng = norm_g[v];
    for (int dir = 0; dir < 2; ++dir) {
        float S[128];
#pragma unroll
        for (int k = 0; k < 128; ++k) S[k] = 0.f;
        auto rowof = [&](int step) { int row; if (step < CTX) { const int j = dir == 0 ? step : CTX - 1 - step; row = MLAT + b * CTX + j; } else { const int t = dir == 0 ? step - CTX : SEQ - 1 - (step - CTX); row = b * SEQ + t; } return row; };
        { const int row = rowof(0); const unsigned short* p = HGO + (size_t)row * 5120 + h * 128;
          if (act) { sq[0][v] = bf2f(p[v]); sk[0][v] = h2f(p[(3 + dir) * D + v]); } }
        __syncthreads();
        for (int step = 0; step < NS; ++step) {
            const int cur = step & 1, row = rowof(step);
            unsigned short* p = HGO + (size_t)row * 5120 + h * 128;
            const float vv = bf2f(p[D + v]);
            if (step + 1 < NS) { const int rn = rowof(step + 1); const unsigned short* pn = HGO + (size_t)rn * 5120 + h * 128;
                if (act) { sq[cur ^ 1][v] = bf2f(pn[v]); sk[cur ^ 1][v] = h2f(pn[(3 + dir) * D + v]); } }
            float o = 0.f;
#pragma unroll
            for (int k = 0; k < 128; ++k) { const float kk = sk[cur][k]; S[k] = (1.f - kk) * S[k] + kk * vv; o += sq[cur][k] * S[k]; }
            if (row < MLAT) {
                if (dir == 0) { if (act) p[3 * D + v] = f2bf(o); }
                else {
                    const float ot = o + bf2f(p[3 * D + v]);
                    float ss = ot * ot;
#pragma unroll
                    for (int off = 1; off < 64; off <<= 1) ss += __shfl_xor(ss, off);
                    if (act && (v & 63) == 0) red[cur][v >> 6] = ss;
                    __syncthreads();
                    const float tot = red[cur][0] + red[cur][1];
                    const float rinv = rsqrtf(tot * (1.f / 128.f) + EPS);
                    const float gv = bf2f(p[2 * D + v]);
                    if (act) p[v] = f2bf(ot * rinv * ng * gv);
                }
            }
            __syncthreads();
        }
    }
}


template <int SET> __device__ __forceinline__ void convert_weights(const Args& a, unsigned char* ws, LAS unsigned char* lds, int w, int nw, int lane) {
    const float* w_qkv = a.in[8]; const float* w_o = a.in[9]; const float* hg_w_in = a.in[13]; const float* hg_w_o = a.in[16]; const float* ffn_w_in = a.in[17]; const float* ffn_w_out = a.in[18];
    bf16_t* Wqkv_t = (bf16_t*)(ws + WS_WQKV); bf16_t* Wo0_t = (bf16_t*)(ws + WS_WO0); bf16_t* Whgin_t = (bf16_t*)(ws + WS_WHGIN); bf16_t* Whgo_t = (bf16_t*)(ws + WS_WHGO);
    bf16_t* Wfin0_t = (bf16_t*)(ws + WS_WFIN0); bf16_t* Wfin1_t = (bf16_t*)(ws + WS_WFIN1); bf16_t* Wfout0_t = (bf16_t*)(ws + WS_WFOUT0); bf16_t* Wfout1_t = (bf16_t*)(ws + WS_WFOUT1);
    LAS float* scr = (LAS float*)(lds + (threadIdx.x >> 6) * 16896);
    constexpr int I_QKV = 16 * 48, I_O = 16 * 16, I_HGIN = 16 * 80, I_FIN = 16 * 88, I_FOUT = 44 * 16;
    auto ident = [](int n) { return n; };
    auto pq = [](int n) { return perm_qkv(n); };
    auto pf = [](int n) { return perm_ffn(n); };
    if (SET == 0) {
        for (int r = w; r < I_QKV; r += nw) { const int kb = r / 48, nb = r % 48; p0_transpose_item(w_qkv, D, 3 * D, Wqkv_t, kb * 64, nb * 64, pq, scr, lane); }
    } else if (SET == 1) {
        for (int it = w; it < I_O + I_FIN + I_FOUT; it += nw) { int r = it;
            if (r < I_O) { const int kb = r / 16, nb = r % 16; p0_transpose_item(w_o, D, D, Wo0_t, kb * 64, nb * 64, ident, scr, lane); continue; } r -= I_O;
            if (r < I_FIN) { const int kb = r / 88, nb = r % 88; p0_transpose_item(ffn_w_in, D, 2 * DFF, Wfin0_t, kb * 64, nb * 64, pf, scr, lane); continue; } r -= I_FIN;
            { const int kb = r / 16, nb = r % 16; p0_transpose_item(ffn_w_out, DFF, D, Wfout0_t, kb * 64, nb * 64, ident, scr, lane); } }
    } else {
        for (int it = w; it < I_HGIN + I_O + I_FIN + I_FOUT; it += nw) { int r = it;
            if (r < I_HGIN) { const int kb = r / 80, nb = r % 80; p0_transpose_item(hg_w_in, D, 5 * D, Whgin_t, kb * 64, nb * 64, ident, scr, lane); continue; } r -= I_HGIN;
            if (r < I_O) { const int kb = r / 16, nb = r % 16; p0_transpose_item(hg_w_o, D, D, Whgo_t, kb * 64, nb * 64, ident, scr, lane); continue; } r -= I_O;
            if (r < I_FIN) { const int kb = r / 88, nb = r % 88; p0_transpose_item(ffn_w_in + (size_t)D * 2 * DFF, D, 2 * DFF, Wfin1_t, kb * 64, nb * 64, pf, scr, lane); continue; } r -= I_FIN;
            { const int kb = r / 16, nb = r % 16; p0_transpose_item(ffn_w_out + (size_t)DFF * D, DFF, D, Wfout1_t, kb * 64, nb * 64, ident, scr, lane); } }
    }
}
__device__ __forceinline__ void bias_gemv(const bf16_t* Bt, int N, const float* sh, float* dst, int w, int nw, int lane) {
    for (int n = w; n < N; n += nw) {
        const v4u* wp = (const v4u*)(Bt + (size_t)n * D + lane * 16); const v4u w0 = wp[0], w1 = wp[1];
        float wf[16];
#pragma unroll
        for (int j = 0; j < 4; ++j) { wf[2 * j] = __builtin_bit_cast(float, w0[j] << 16); wf[2 * j + 1] = __builtin_bit_cast(float, w0[j] & 0xffff0000u);
            wf[8 + 2 * j] = __builtin_bit_cast(float, w1[j] << 16); wf[8 + 2 * j + 1] = __builtin_bit_cast(float, w1[j] & 0xffff0000u); }
#pragma unroll
        for (int s = 0; s < 5; ++s) { const f32x4* sp = (const f32x4*)(sh + (size_t)s * 6 * D + lane * 16); float t = 0.f;
#pragma unroll
            for (int q = 0; q < 4; ++q) { const f32x4 sv = sp[q]; t += (sv[0] * wf[4 * q] + sv[1] * wf[4 * q + 1]) + (sv[2] * wf[4 * q + 2] + sv[3] * wf[4 * q + 3]); }
            t = wave_sum(t); if (lane == 0) dst[(size_t)s * N + n] = t; }
    }
}

__global__ void __launch_bounds__(NWAVES * 64, 2) mega(Args a) {
    extern __shared__ __attribute__((aligned(16))) unsigned char lds_raw[];
    LAS unsigned char* lds = (LAS unsigned char*)lds_raw;
    volatile LAS unsigned* MISC = (volatile LAS unsigned*)(lds + MISC_OFF);
    const int tid = threadIdx.x, lane = tid & 63, wave = __builtin_amdgcn_readfirstlane(tid >> 6);
    const int G = gridDim.x, bx = blockIdx.x;
    const int vcu = (G % 8 == 0) ? (bx % 8) * (G / 8) + bx / 8 : bx;
    unsigned char* ws = a.ws;
    const float* x = a.in[0]; const float* cvec = a.in[1]; const float* ctx = a.in[2]; const float* c_ctx = a.in[3];
    const float* ada_w = a.in[4]; const float* ada_b = a.in[5]; const float* norm1_g = a.in[6]; const float* norm2_g = a.in[7];
    const float* w_qkv = a.in[8]; const float* w_o = a.in[9]; const float* q_gain = a.in[10]; const float* k_gain = a.in[11];
    const float* hg_w_in = a.in[13]; const float* hg_lower = a.in[14];
    const float* hg_w_o = a.in[16]; const float* ffn_w_in = a.in[17]; const float* ffn_w_out = a.in[18];
    float* out = a.out;
    float* mod = (float*)(ws + WS_MOD); float* lbp = (float*)(ws + WS_LB); float* Gv = (float*)(ws + WS_GV);
    float* bias_f0 = (float*)(ws + WS_BIAS_F0); float* bias_hg = (float*)(ws + WS_BIAS_HG); float* bias_f1 = (float*)(ws + WS_BIAS_F1);
    float* part = (float*)(ws + WS_PART); bf16_t* XCTX = (bf16_t*)(ws + WS_XCTX);
    bf16_t* XRES = (bf16_t*)out;
    bf16_t* Wqkv_t = (bf16_t*)(ws + WS_WQKV); bf16_t* Wo0_t = (bf16_t*)(ws + WS_WO0); bf16_t* Whgin_t = (bf16_t*)(ws + WS_WHGIN); bf16_t* Whgo_t = (bf16_t*)(ws + WS_WHGO);
    bf16_t* Wfin0_t = (bf16_t*)(ws + WS_WFIN0); bf16_t* Wfin1_t = (bf16_t*)(ws + WS_WFIN1); bf16_t* Wfout0_t = (bf16_t*)(ws + WS_WFOUT0); bf16_t* Wfout1_t = (bf16_t*)(ws + WS_WFOUT1);
    bf16_t* ABUF = (bf16_t*)(ws + WS_ABUF); bf16_t* R1 = (bf16_t*)(ws + WS_R1);
    bf16_t* X3 = R1 + 3840;

    for (int u = tid; u < 512 / 4; u += NWAVES * 64) ((LAS unsigned*)(lds + MISC_OFF))[u] = 0u;
    __syncthreads();
    XcdBarrier bar = xcd_barrier_post((unsigned*)(ws + WS_CTL) + 1024, MISC + 8);
    const int lo = a.ph_lo, hi = a.ph_hi;
#define IN(k) (lo <= (k) && (k) < hi)
#ifndef BAR_REPEAT
#define BAR_REPEAT 1
#endif
#define SEAM(k) do { if (IN(k) && IN((k) + 1)) for (int br_ = 0; br_ < BAR_REPEAT; ++br_) xcd_barrier(bar); if (PROBE_MASK && bx == 0 && tid == 0) MISC[17 + (k)] = (unsigned)__builtin_amdgcn_s_memrealtime(); } while (0)
    if (PROBE_MASK && bx == 0 && tid == 0) MISC[16] = (unsigned)__builtin_amdgcn_s_memrealtime();

    if (IN(0)) {
        if (bx < 192) {
            LAS float* sv = (LAS float*)lds; LAS float* red = (LAS float*)(lds + 20480);
            const int l = bx / 96, cb = bx % 96;
            for (int i = tid; i < 5 * D; i += 512) { const int s = i >> 10, k = i & 1023; const float v = s < 4 ? cvec[s * D + k] : c_ctx[k]; sv[i] = silu_f(v); }
            __syncthreads();
            const int col = tid & 63, kg = tid >> 6;
            float acc[5] = {0.f, 0.f, 0.f, 0.f, 0.f};
            const float* w = ada_w + (size_t)l * D * 6 * D + cb * 64 + col;
            for (int k0 = kg * 128; k0 < kg * 128 + 128; k0 += 32) {
                float wv[32];
#pragma unroll
                for (int q = 0; q < 32; ++q) wv[q] = w[(size_t)(k0 + q) * 6 * D];
#pragma unroll
                for (int q = 0; q < 32; ++q)
#pragma unroll
                    for (int s = 0; s < 5; ++s) acc[s] += sv[s * D + k0 + q] * wv[q]; }
#pragma unroll
            for (int s = 0; s < 5; ++s) red[(kg * 5 + s) * 64 + col] = acc[s];
            __syncthreads();
            if (tid < 320) { const int s = tid >> 6, c2 = tid & 63; float t = 0.f;
#pragma unroll
                for (int k2 = 0; k2 < 8; ++k2) t += red[(k2 * 5 + s) * 64 + c2];
                mod[((size_t)l * 5 + s) * 6 * D + cb * 64 + c2] = t + ada_b[l * 6 * D + cb * 64 + c2]; }
            __syncthreads();
        } else if (bx < 196) { const int i = (bx - 192) * 512 + tid; lbp[i] = sigmoid_f(hg_lower[2 * D + i] - hg_lower[i]); }
        convert_weights<0>(a, ws, lds, vcu * NWAVES + wave, G * NWAVES, lane);
    }
    SEAM(0);
    if (IN(1)) {
        const int gw = vcu * NWAVES + wave, NGW = G * NWAVES;
        na::build_bias_table((bf16_t*)(ws + WS_BTAB), a.in[12], G, bx);
        { const int i = bx * 512 + tid;
          if (i < 2 * 2 * 5 * D) { const int col = i & 1023, s = (i >> 10) % 5, w = (i / (5 * D)) & 1, l = i / (10 * D);
              Gv[i] = (w == 0 ? norm1_g : norm2_g)[l * D + col] * (1.f + mod[((size_t)l * 5 + s) * 6 * D + (w == 0 ? 1 : 4) * D + col]); } }
        LAS float* tA = (LAS float*)lds; LAS float* tB = (LAS float*)(lds + 20480);
        for (int i = tid; i < 5 * D; i += 512) { const int s5 = i >> 10, col = i & 1023; const float* mp = mod + (size_t)s5 * 6 * D;
            tA[i] = norm1_g[col] * (1.f + mp[D + col]); tB[i] = mp[col]; }
        __syncthreads();
        for (int row0 = gw; row0 < MTOT; row0 += 2 * NGW) {
            const int row1 = row0 + NGW; const bool has1 = row1 < MTOT; const int r1 = has1 ? row1 : row0;
            const float* xr0 = row0 < MLAT ? x + (size_t)row0 * D : ctx + (size_t)(row0 - MLAT) * D;
            const float* xr1 = r1 < MLAT ? x + (size_t)r1 * D : ctx + (size_t)(r1 - MLAT) * D;
            f32x4 v0[4], v1[4]; float ss0 = 0.f, ss1 = 0.f;
#pragma unroll
            for (int j = 0; j < 4; ++j) { v0[j] = ((const f32x4*)xr0)[lane + 64 * j]; v1[j] = ((const f32x4*)xr1)[lane + 64 * j]; }
#pragma unroll
            for (int j = 0; j < 4; ++j) { ss0 += pg8::sq4(v0[j]); ss1 += pg8::sq4(v1[j]); }
            const float ri0 = rsqrtf(wave_sum(ss0) * (1.f / D) + EPS), ri1 = rsqrtf(wave_sum(ss1) * (1.f / D) + EPS);
            const int s0 = row_slot(row0), s1 = row_slot(r1);
#pragma unroll
            for (int j = 0; j < 4; ++j) { const int col = 4 * lane + 256 * j;
                { const f32x4 y = (v0[j] * ri0) * *(const LAS f32x4*)(tA + s0 * D + col) + *(const LAS f32x4*)(tB + s0 * D + col);
                  v2u o; o.x = pk2(y[0], y[1]); o.y = pk2(y[2], y[3]); *(v2u*)(ABUF + (size_t)row0 * D + col) = o; }
                if (has1) { const f32x4 y = (v1[j] * ri1) * *(const LAS f32x4*)(tA + s1 * D + col) + *(const LAS f32x4*)(tB + s1 * D + col);
                  v2u o; o.x = pk2(y[0], y[1]); o.y = pk2(y[2], y[3]); *(v2u*)(ABUF + (size_t)row1 * D + col) = o; }
            }
        }
    }
    SEAM(1);
    const float* mod0 = mod; const float* mod1 = mod + 5 * 6 * D;
#define COMMA ,
#define GEMM_ALL(EPI, Aptr, Btptr, N_, K_, lda_, ...) do { \
        pg8::Gemm g_{Aptr, Btptr, MTOT, N_, K_, lda_, 0, 0}; pg8::StaticOrder S1_; S1_.init(MTOT, N_, G, bx); EPI E1_{__VA_ARGS__}; \
        pg8::gemm_phase<EPI, pg8::StaticOrder, true, true>(lds, g_, S1_, E1_); } while (0)
#define GEMM_LAT_CTX(EPI, Aptr, Btptr, N_, K_, lda_, S_, phase, ...) do { \
        pg8::Gemm g_{Aptr, Btptr, MLAT, N_, K_, lda_, 0, 0}; pg8::StaticOrder S1_; S1_.init(MLAT, N_, G, bx); EPI E1_{__VA_ARGS__}; \
        pg8::gemm_phase<EPI, pg8::StaticOrder, true, true>(lds, g_, S1_, E1_); \
        pg8::CtxTaskOrder S2_; S2_.init(N_, S_, bx); \
        pg8::Gemm g2_{Aptr, Btptr, MTOT, N_, K_, lda_, (K_) / 64 / (S_), (bx % (S_)) * ((K_) / (S_))}; \
        pg8::EpiSplit<EPI, S_> E2_{{__VA_ARGS__}, slab, scnt + (phase) * 128, sflag, bx}; \
        pg8::gemm_phase<pg8::EpiSplit<EPI, S_>, pg8::CtxTaskOrder, true, true>(lds, g2_, S2_, E2_); } while (0)
    float* slab = (float*)(ws + WS_STATE); unsigned* scnt = (unsigned*)(ws + WS_CTL) + 8192; LAS unsigned* sflag = (LAS unsigned*)(lds + MISC_OFF + 256);
    if (IN(2)) {
        GEMM_ALL(pg8::EpiQKV, ABUF, Wqkv_t, 3 * D, D, D, R1, q_gain, k_gain, 0.125f);
        { constexpr int NL = (MTOT / 256) * 12 % 256; if (G == 256 && bx >= NL) convert_weights<1>(a, ws, lds, (bx - NL) * NWAVES + wave, (G - NL) * NWAVES, lane);
          else if (G != 256) convert_weights<1>(a, ws, lds, bx * NWAVES + wave, G * NWAVES, lane); }
    }
    SEAM(2);
#ifndef ATTN_PROBE
#define ATTN_PROBE -1
#endif
    if (IN(3)) {
        if (ATTN_PROBE >= 0) { na::attn_phase<(ATTN_PROBE < 0 ? 0 : ATTN_PROBE)>(lds, R1, (const bf16_t*)(ws + WS_BTAB), q_gain, k_gain, (bf16_t*)(ws + 330 * MiB), G, vcu); __syncthreads(); }
        na::attn_phase<0>(lds, R1, (const bf16_t*)(ws + WS_BTAB), q_gain, k_gain, ABUF, G, vcu);
    }
    SEAM(3);
    if (IN(4)) {
        pg8::Gemm g{ABUF, Wo0_t, MTOT, D, D, D, 0, 0}; pg8::StaticOrder S; S.init(MTOT, D, G, bx);
        pg8::fill_res_tables(lds + RING_BYTES, S, mod0 + 2 * D, Gv + (0 * 2 + 1) * 5 * D);
        pg8::EpiRes<false, true> E{x, ctx, XRES, XCTX, lds + RING_BYTES, true, R1, part, D, D, 0};
        pg8::gemm_phase<pg8::EpiRes<false, true>, pg8::StaticOrder, true, true>(lds, g, S, E);
        { constexpr int NL = (MTOT / 256) * 4 % 256; const int w_ = G == 256 ? (bx - NL) * NWAVES + wave : bx * NWAVES + wave, nw_ = G == 256 ? (G - NL) * NWAVES : G * NWAVES;
          if (G != 256 || bx >= NL) { convert_weights<2>(a, ws, lds, w_, nw_, lane); bias_gemv(Wfin0_t, 2 * DFF, mod0 + 3 * D, bias_f0, w_, nw_, lane); } }
    }
    SEAM(4);
    bf16_t* A2 = R1; bf16_t* HID = R1 + (size_t)MTOT * D;
    if (IN(5)) {
        pg8::Gemm g{A2, Wfin0_t, MTOT, 2 * DFF, D, D, 0, 0}; pg8::StaticOrder S; S.init(MTOT, 2 * DFF, G, bx);
        pg8::fill_epi_tables(lds + RING_BYTES, S, part, bias_f0, 2 * DFF);
        pg8::EpiSwiglu E{lds + RING_BYTES, HID, DFF, 0};
        pg8::gemm_phase<pg8::EpiSwiglu, pg8::StaticOrder, true, true>(lds, g, S, E);
    }
    SEAM(5);
    if (IN(6)) {
        pg8::Gemm g{HID, Wfout0_t, MTOT, D, DFF, DFF, 0, 0}; pg8::StaticOrder S; S.init(MTOT, D, G, bx);
        pg8::fill_res_tables(lds + RING_BYTES, S, mod0 + 5 * D, Gv + (1 * 2 + 0) * 5 * D);
        pg8::EpiRes<true, true> E{XRES, XCTX, XRES, XCTX, lds + RING_BYTES, true, ABUF, part, D, D, 0};
        pg8::gemm_phase<pg8::EpiRes<true, true>, pg8::StaticOrder, true, true>(lds, g, S, E);
        { constexpr int NL = (MTOT / 256) * 4 % 256; const int w_ = G == 256 ? (bx - NL) * NWAVES + wave : bx * NWAVES + wave, nw_ = G == 256 ? (G - NL) * NWAVES : G * NWAVES;
          if (G != 256 || bx >= NL) { bias_gemv(Whgin_t, 5 * D, mod1, bias_hg, w_, nw_, lane); bias_gemv(Wfin1_t, 2 * DFF, mod1 + 3 * D, bias_f1, w_, nw_, lane); } }
    }
    SEAM(6);
    if (IN(7)) {
        pg8::Gemm g{ABUF, Whgin_t, MTOT, 5 * D, D, D, 0, 0}; pg8::StaticOrder S; S.init(MTOT, 5 * D, G, bx);
        pg8::fill_epi_tables(lds + RING_BYTES, S, part, bias_hg, 5 * D);
        pg8::EpiHg E{lds + RING_BYTES, R1, lbp, 0};
        pg8::gemm_phase<pg8::EpiHg, pg8::StaticOrder, true, true>(lds, g, S, E);
    }
    SEAM(7);
    float* STATE = (float*)(ws + WS_STATE);
#ifndef HG1_PROBE
#define HG1_PROBE -1
#endif
    if (IN(8)) { if (HG1_PROBE >= 0) { hg::phase1<(HG1_PROBE < 0 ? 0 : HG1_PROBE)>(lds, R1, STATE, G, vcu); __syncthreads(); } hg::phase1<0>(lds, R1, STATE, G, vcu); }
    SEAM(8);
    if (IN(9)) { hg::phase2(STATE, G, bx); }
    SEAM(9);
    if (IN(10)) { hg::phase3(lds, R1, STATE, a.in[15], G, vcu, (PROBE_MASK >> 14) && bx == 0 ? MISC + 48 : (volatile LAS unsigned*)nullptr); }
    SEAM(10);
    if (IN(11)) {
        pg8::Gemm g{R1, Whgo_t, MLAT, D, D, 5 * D, 0, 0}; pg8::StaticOrder S; S.init(MLAT, D, G, bx);
        pg8::fill_res_tables(lds + RING_BYTES, S, mod1 + 2 * D, Gv + (1 * 2 + 1) * 5 * D);
        pg8::EpiRes<true, true> E{XRES, XCTX, X3, XCTX, lds + RING_BYTES, true, ABUF, part, D, 5 * D, 0};
        pg8::gemm_phase<pg8::EpiRes<true, true>, pg8::StaticOrder, true, true>(lds, g, S, E);
    }
    SEAM(11);
    if (IN(12)) {
        pg8::Gemm g{ABUF, Wfin1_t, MLAT, 2 * DFF, D, D, 0, 0}; pg8::StaticOrder S; S.init(MLAT, 2 * DFF, G, bx);
        pg8::fill_epi_tables(lds + RING_BYTES, S, part, bias_f1, 2 * DFF);
        pg8::EpiSwiglu E{lds + RING_BYTES, R1 + D, 5 * D, 0};
        pg8::gemm_phase<pg8::EpiSwiglu, pg8::StaticOrder, true, true>(lds, g, S, E);
    }
    SEAM(12);
    if (IN(13)) {
        pg8::Gemm g{R1 + D, Wfout1_t, MLAT, D, DFF, 5 * D, 0, 0}; pg8::StaticOrder S; S.init(MLAT, D, G, bx);
        pg8::fill_res_tables(lds + RING_BYTES, S, mod1 + 5 * D, (const float*)nullptr);
        pg8::EpiRes<true, false> E{X3, XCTX, out, XCTX, lds + RING_BYTES, false, nullptr, nullptr, 5 * D, D, 0};
        pg8::gemm_phase<pg8::EpiRes<true, false>, pg8::StaticOrder, true, true>(lds, g, S, E);
    }
    if (PROBE_MASK && bx == 0 && tid == 0) {
        MISC[17 + 13] = (unsigned)__builtin_amdgcn_s_memrealtime();
        unsigned extra = 0;
        for (int k = 0; k < 14; ++k) if ((PROBE_MASK >> k) & 1u) extra += MISC[17 + k] - MISC[16 + k];
        if ((PROBE_MASK >> 14) & 1u) extra += MISC[48];
        if ((PROBE_MASK >> 15) & 1u) extra += MISC[49];
        const unsigned t0 = (unsigned)__builtin_amdgcn_s_memrealtime();
        while ((unsigned)__builtin_amdgcn_s_memrealtime() - t0 < extra * PROBE_MUL) __builtin_amdgcn_s_sleep(8);
    }
#undef IN
#undef SEAM
}

extern "C" void kernel_launch(void* const* d_in, const int* in_sizes, int n_in, void* d_out, int out_size, void* d_ws, size_t ws_size, hipStream_t stream) {
    static int grid = 0;
    if (grid == 0) {
        if (n_in != 19 || out_size != MLAT * D || ws_size < WS_END) { fprintf(stderr, "kernel_launch: unexpected sizes n_in %d out %d ws %zu\n", n_in, out_size, ws_size); grid = -1; return; }
        int dev = 0, cus = 0, per_cu = 0;
        if (hipGetDevice(&dev) != hipSuccess || hipDeviceGetAttribute(&cus, hipDeviceAttributeMultiprocessorCount, dev) != hipSuccess) { grid = -1; return; }
        if (hipFuncSetAttribute((const void*)mega, hipFuncAttributeMaxDynamicSharedMemorySize, LDS_BYTES) != hipSuccess) { fprintf(stderr, "kernel_launch: hipFuncSetAttribute failed\n"); grid = -1; return; }
        if (hipOccupancyMaxActiveBlocksPerMultiprocessor(&per_cu, (const void*)mega, NWAVES * 64, LDS_BYTES) != hipSuccess || per_cu < 1) { fprintf(stderr, "kernel_launch: occupancy query says %d blocks per CU\n", per_cu); grid = -1; (void)hipGetLastError(); return; }
        (void)hipGetLastError();
        grid = cus;
    }
    if (grid < 0) return;
    (void)hipMemsetAsync((char*)d_ws + WS_CTL, 0, CTL_ZERO_BYTES, stream);
    Args a{};
    for (int i = 0; i < 19; ++i) a.in[i] = (const float*)d_in[i];
    a.out = (float*)d_out; a.ws = (unsigned char*)d_ws;
    auto run = [&](int lo, int hi) { a.ph_lo = lo; a.ph_hi = hi; hipLaunchKernelGGL(mega, dim3(grid), dim3(NWAVES * 64), LDS_BYTES, stream, a); };
    run(0, 14);
}
```

```cpp
#include <hip/hip_runtime.h>
#include <cstdint>
#include <cstdio>
#include <type_traits>

constexpr int D = 1024, BATCH = 4, SEQ = 8192, CTX = 256, MLAT = BATCH * SEQ, MCTX = BATCH * CTX, MTOT = MLAT + MCTX;
constexpr int DFF = 2816, NAH = 16, HGH = 8, GW = 64, ROWS = SEQ / GW;
constexpr float EPS = 1e-6f;
typedef unsigned short bf16_t;
typedef unsigned short f16_t;
#define GAS __attribute__((address_space(1)))
#define LAS __attribute__((address_space(3)))
typedef unsigned v4u __attribute__((ext_vector_type(4)));
typedef unsigned v2u __attribute__((ext_vector_type(2)));
typedef float f32x4 __attribute__((ext_vector_type(4)));
typedef float f32x2 __attribute__((ext_vector_type(2)));
typedef _Float16 h16x2 __attribute__((ext_vector_type(2)));

__device__ __forceinline__ bf16_t f2bf(float f) { unsigned u = __builtin_bit_cast(unsigned, f); return (bf16_t)((u + 0x7fffu + ((u >> 16) & 1u)) >> 16); }
__device__ __forceinline__ float bf2f(bf16_t h) { return __builtin_bit_cast(float, (unsigned)h << 16); }
__device__ __forceinline__ f16_t f2h(float f) { _Float16 h = (_Float16)f; return __builtin_bit_cast(unsigned short, h); }
__device__ __forceinline__ float h2f(f16_t u) { return (float)__builtin_bit_cast(_Float16, u); }
__device__ __forceinline__ unsigned pk2(float lo, float hi) { return (unsigned)f2bf(lo) | ((unsigned)f2bf(hi) << 16); }
__device__ __forceinline__ unsigned pk_h2(float lo, float hi) { f32x2 v = {lo, hi}; h16x2 h = __builtin_convertvector(v, h16x2); return __builtin_bit_cast(unsigned, h); }
__device__ __forceinline__ float silu_f(float x) { return x / (1.f + __expf(-x)); }
__device__ __forceinline__ float sigmoid_f(float x) { return 1.f / (1.f + __expf(-x)); }
__device__ __forceinline__ float fast_sigmoid(float x) { return __builtin_amdgcn_rcpf(1.f + __builtin_amdgcn_exp2f(-1.4426950408889634f * x)); }
__device__ __forceinline__ float fast_silu(float x) { return x * fast_sigmoid(x); }
__device__ __forceinline__ int row_slot(int row) { return row < MLAT ? (row >> 13) : 4; }
__device__ __forceinline__ int row_batch(int row) { return row < MLAT ? (row >> 13) : ((row - MLAT) >> 8); }

constexpr size_t MiB = 1u << 20, KiB = 1024;
constexpr size_t WS_CTL = 0, CTL_ZERO_BYTES = 64 * KiB;
constexpr size_t WS_MOD = 64 * KiB;
constexpr size_t WS_LB = 320 * KiB;
constexpr size_t WS_GV = 336 * KiB;
constexpr size_t WS_BIAS_F0 = 448 * KiB;
constexpr size_t WS_BIAS_HG = 576 * KiB;
constexpr size_t WS_BIAS_F1 = 704 * KiB;
constexpr size_t WS_PART = 1 * MiB;
constexpr size_t WS_XCTX = 4 * MiB;
constexpr size_t WS_WQKV = 8 * MiB, WS_WO0 = 14 * MiB, WS_WHGIN = 16 * MiB, WS_WHGO = 26 * MiB;
constexpr size_t WS_WFIN0 = 28 * MiB, WS_WFIN1 = 39 * MiB, WS_WFOUT0 = 50 * MiB, WS_WFOUT1 = 50 * MiB + 5632 * KiB;
constexpr size_t WS_ABUF = 62 * MiB;
constexpr size_t WS_R1 = 128 * MiB;
constexpr size_t WS_STATE = 458 * MiB;
constexpr size_t WS_BTAB = 496 * MiB;
constexpr size_t WS_END = 512 * MiB;
static_assert(WS_WFOUT1 + (size_t)D * DFF * 2 <= WS_ABUF && WS_ABUF + (size_t)MTOT * D * 2 <= WS_R1 && WS_R1 + (size_t)MTOT * 5120 * 2 <= WS_STATE, "ws map");
static_assert(WS_PART + (size_t)MTOT * 16 * 4 <= WS_XCTX && WS_BIAS_F1 + 5 * 5632 * 4 <= WS_PART && WS_MOD + 2 * 5 * 6144 * 4 <= WS_LB, "ws map small");

namespace pg8 {
#define PG8_LAS __attribute__((address_space(3)))
typedef short bf16x8 __attribute__((ext_vector_type(8)));
typedef unsigned u32x4 __attribute__((ext_vector_type(4)));
constexpr int BM = 256, BK = 64, HALF = 128, HTB = HALF * BK * 2  , STAGE_BYTES = 8 * HTB, NXCD = 8, WGM = 8;

__host__ __device__ __forceinline__ int lds_byte(int r, int c) { const int st = (r >> 4) * 2 + (c >> 5), rr = r & 15, cc = c & 31, ob = rr * 64 + cc * 2; return st * 1024 + (ob ^ (((ob >> 9) & 1) << 5)); }
__host__ __device__ __forceinline__ void stage_rc(int b, int& R, int& C) { const int st = b / 1024, sb = b % 1024, swz = sb ^ (((sb >> 9) & 1) << 5); R = (st >> 1) * 16 + swz / 64; C = (st & 1) * 32 + (swz % 64) / 2; }
__host__ __device__ __forceinline__ int perm32(int rho) { const int n = rho >> 4, i = rho & 15; return 8 * (i >> 2) + 4 * n + (i & 3); }

struct Unit { int pm, pn; };
struct Gemm { const bf16_t* A; const bf16_t* Bt; int M, N, K, lda, nt, koff; };

struct StaticOrder {
    int nM, nN, nwg, G, c;
    __host__ __device__ void init(int M, int N, int G_, int c_) { nM = M / BM; nN = N / BM; nwg = nM * nN; G = G_; c = c_; }
    __host__ __device__ bool next(int i, Unit& u) const {
        const long L = (long)i * G + c; if (L >= nwg) return false;
        int wgid = (int)L; { const int q = nwg / NXCD, r = nwg % NXCD, xcd = wgid % NXCD, off = wgid / NXCD; wgid = (xcd < r ? xcd * (q + 1) : r * (q + 1) + (xcd - r) * q) + off; }
        const int nig = WGM * nN, gid = wgid / nig, fm = gid * WGM, gsz = (nM - fm) < WGM ? (nM - fm) : WGM;
        u.pm = fm + ((wgid % nig) % gsz); u.pn = (wgid % nig) / gsz; return true;
    }
    __device__ __forceinline__ void a_ready(const Unit&) const {}
    __device__ __forceinline__ void done(const Unit&) const {}
};
__device__ __forceinline__ unsigned cvt_pk_bf16(float lo, float hi) { unsigned r; asm volatile("v_cvt_pk_bf16_f32 %0, %1, %2" : "=v"(r) : "v"(lo), "v"(hi)); return r; }

struct CtxTaskOrder {
    int S, ntasks, c;
    __device__ void init(int N, int S_, int c_) { S = S_; ntasks = 4 * (N / BM) * S_; c = c_; }
    __device__ bool next(int i, Unit& u) const { if (i != 0 || c >= ntasks) return false; const int unit = c / S; u.pm = MLAT / BM + (unit & 3); u.pn = unit >> 2; return true; }
    __device__ __forceinline__ void a_ready(const Unit&) const {}
    __device__ __forceinline__ void done(const Unit&) const {}
};
template <class Epi, int S> struct EpiSplit {
    static constexpr bool PERM = Epi::PERM, AFTER_DRAIN = false;
    Epi inner; float* slab; unsigned* cnt; PG8_LAS unsigned* flag; int task;
    __device__ __forceinline__ void operator()(const f32x4 (&acc_c)[2][2][4][2], const Unit& u, int wr, int wc, int fr, int fq) const {
        f32x4 (&acc)[2][2][4][2] = const_cast<f32x4 (&)[2][2][4][2]>(acc_c);
        const int tid = threadIdx.x;
        f32x4* sp = (f32x4*)slab + (size_t)task * 32 * 512 + tid;
#pragma unroll
        for (int i = 0; i < 32; ++i) { const f32x4 v = acc[i >> 4][(i >> 3) & 1][(i >> 1) & 3][i & 1]; f32x4* q = sp + i * 512;
            asm volatile("global_store_dwordx4 %0, %1, off sc1\n\ts_nop 1" :: "v"(q), "v"(v) : "memory"); }
        asm volatile("s_waitcnt vmcnt(0) lgkmcnt(0)" ::: "memory"); __builtin_amdgcn_s_barrier(); asm volatile("" ::: "memory");
        if (tid == 0) *flag = __hip_atomic_fetch_add(cnt + task / S, 1u, __ATOMIC_RELAXED, __HIP_MEMORY_SCOPE_AGENT);
        asm volatile("s_waitcnt vmcnt(0) lgkmcnt(0)" ::: "memory"); __builtin_amdgcn_s_barrier(); asm volatile("" ::: "memory");
        const unsigned ticket = *flag;
        if (ticket + 1u != (unsigned)S) return;
        if (tid == 0) { __builtin_amdgcn_fence(__ATOMIC_ACQUIRE, "agent"); asm volatile("s_waitcnt vmcnt(0)" ::: "memory"); }
        asm volatile("s_waitcnt vmcnt(0) lgkmcnt(0)" ::: "memory"); __builtin_amdgcn_s_barrier(); asm volatile("" ::: "memory");
        f32x4* rp = (f32x4*)slab + (size_t)(task - task % S) * 32 * 512 + tid;
#pragma unroll 1
        for (int c8 = 0; c8 < 4; ++c8) {
            f32x4 t[8];
#pragma unroll
            for (int i = 0; i < 8; ++i) t[i] = rp[(size_t)(c8 * 8 + i) * 512];
#pragma unroll
            for (int s = 1; s < S; ++s)
#pragma unroll
                for (int i = 0; i < 8; ++i) t[i] += rp[((size_t)s * 32 + c8 * 8 + i) * 512];
#pragma unroll
            for (int i = 0; i < 8; ++i) rp[(size_t)(c8 * 8 + i) * 512] = t[i];
        }
        asm volatile("s_waitcnt vmcnt(0)" ::: "memory");
#pragma unroll
        for (int i = 0; i < 32; ++i) acc[i >> 4][(i >> 3) & 1][(i >> 1) & 3][i & 1] = rp[(size_t)i * 512];
        inner(acc, u, wr, wc, fr, fq);
    }
};

__device__ __forceinline__ float quad_sum(float s) { s += __shfl_xor(s, 16); s += __shfl_xor(s, 32); return s; }
__device__ __forceinline__ float sq4(f32x4 v) { return (v[0] * v[0] + v[1] * v[1]) + (v[2] * v[2] + v[3] * v[3]); }
__device__ __forceinline__ u32x4 pack8(f32x4 a, f32x4 b) { u32x4 w; w.x = cvt_pk_bf16(a[0], a[1]); w.y = cvt_pk_bf16(a[2], a[3]); w.z = cvt_pk_bf16(b[0], b[1]); w.w = cvt_pk_bf16(b[2], b[3]); return w; }
__device__ __forceinline__ float row_rinv(const float* part, int row) {
    const f32x4* p = (const f32x4*)(part + (size_t)row * 16); const f32x4 a = p[0], b = p[1], c = p[2], d = p[3];
    const float s = ((a[0] + a[1]) + (a[2] + a[3])) + ((b[0] + b[1]) + (b[2] + b[3])) + ((c[0] + c[1]) + (c[2] + c[3])) + ((d[0] + d[1]) + (d[2] + d[3]));
    return rsqrtf(s * (1.f / D) + EPS);
}

struct EpiQKV {
    static constexpr bool PERM = true, AFTER_DRAIN = false;
    bf16_t* QKV; const float* qg; const float* kg; float qscale;
    __device__ __forceinline__ void operator()(const f32x4 (&acc)[2][2][4][2], const Unit& u, int wr, int wc, int fr, int fq) const {
        const int type = u.pn >> 2, head = (u.pn & 3) * 4 + wc;
        const int row0 = u.pm * BM + wr * 64 + fr;
        bf16_t* base = QKV + (size_t)type * D + head * 64 + 8 * fq;
        f32x4 gv[2][2];
        if (type < 2) { const float* gp = (type == 0 ? qg : kg) + 8 * fq;
#pragma unroll
            for (int bj = 0; bj < 2; ++bj)
#pragma unroll
                for (int n = 0; n < 2; ++n) gv[bj][n] = *(const f32x4*)(gp + 32 * bj + 4 * n); }
        const float sc = type == 0 ? qscale : 1.f;
#pragma unroll
        for (int ai = 0; ai < 2; ++ai)
#pragma unroll
            for (int m = 0; m < 4; ++m) {
                bf16_t* rowp = base + (size_t)(row0 + ai * HALF + m * 16) * 3072;
                f32x4 v00 = acc[ai][0][m][0], v01 = acc[ai][0][m][1], v10 = acc[ai][1][m][0], v11 = acc[ai][1][m][1];
                if (type < 2) {
                    const float ss = quad_sum((sq4(v00) + sq4(v01)) + (sq4(v10) + sq4(v11)));
                    const float r = rsqrtf(ss * (1.f / 64.f) + EPS) * sc;
                    v00 = v00 * r * gv[0][0]; v01 = v01 * r * gv[0][1]; v10 = v10 * r * gv[1][0]; v11 = v11 * r * gv[1][1];
                }
                *(u32x4*)(rowp) = pack8(v00, v01); *(u32x4*)(rowp + 32) = pack8(v10, v11);
            }
    }
};
template <class Sched> __device__ __forceinline__ void fill_res_tables(PG8_LAS unsigned char* tab, const Sched& S, const float* gate, const float* Gn) {
    const int tid = threadIdx.x; Unit u;
    for (int i = 0; i < 8 && S.next(i, u); ++i) {
        const bool lat = u.pm < MLAT / BM; const int slot = lat ? (u.pm >> 5) : 4;
        if (tid < 256) *(PG8_LAS float*)(tab + i * 1024 + tid * 4) = gate[(size_t)slot * 6 * D + u.pn * BM + tid];
        else *(PG8_LAS float*)(tab + 16384 + i * 1024 + (tid - 256) * 4) = Gn ? Gn[(size_t)slot * D + u.pn * BM + (tid - 256)] : 0.f;
    }
    asm volatile("s_waitcnt vmcnt(0) lgkmcnt(0)" ::: "memory"); __builtin_amdgcn_s_barrier(); asm volatile("" ::: "memory");
}
template <bool RES_BF16, bool OUT_BF16> struct EpiRes {
    static constexpr bool PERM = true, AFTER_DRAIN = false;
    const void* res_lat; const void* res_ctx; void* out_lat; void* out_ctx; PG8_LAS unsigned char* tab; bool has_gn; bf16_t* Aout; float* part; int ldr, ldo; mutable int seq;
    __device__ __forceinline__ void operator()(const f32x4 (&acc)[2][2][4][2], const Unit& u, int wr, int wc, int fr, int fq) const {
        const bool lat = u.pm < MLAT / BM;
        const size_t trow = lat ? (size_t)u.pm * BM : (size_t)u.pm * BM - MLAT; const size_t pr = lat ? ldr : D, po = lat ? ldo : D;
        const int cl = wc * 32 + 8 * fq, col0 = u.pn * BM + cl;
        const PG8_LAS unsigned char* tg = tab + seq * 1024 + cl * 4; const PG8_LAS unsigned char* tn = tab + 16384 + seq * 1024 + cl * 4; ++seq;
        f32x4 gt[2][2], gn[2][2];
#pragma unroll
        for (int bj = 0; bj < 2; ++bj)
#pragma unroll
            for (int n = 0; n < 2; ++n) { gt[bj][n] = *(const PG8_LAS f32x4*)(tg + bj * HALF * 4 + 16 * n); gn[bj][n] = *(const PG8_LAS f32x4*)(tn + bj * HALF * 4 + 16 * n); }
        const char* rl_ = (const char*)res_lat; const char* rc_ = (const char*)res_ctx; char* ol_ = (char*)out_lat; char* oc_ = (char*)out_ctx;
        asm volatile("" : "+s"(rl_), "+s"(rc_), "+s"(ol_), "+s"(oc_));
        const char* rbase = lat ? rl_ : rc_; char* obase = lat ? ol_ : oc_;
        constexpr int MB = RES_BF16 ? 4 : 2;
#pragma unroll
        for (int ai = 0; ai < 2; ++ai)
#pragma unroll
        for (int m0 = 0; m0 < 4; m0 += MB) {
            u32x4 rb[MB][2]; f32x4 rf[MB][2][2];
#pragma unroll
            for (int mm = 0; mm < MB; ++mm) { const size_t offr = (trow + wr * 64 + ai * HALF + (m0 + mm) * 16 + fr) * pr + col0;
#pragma unroll
                for (int bj = 0; bj < 2; ++bj) {
                    if (RES_BF16) rb[mm][bj] = *(const u32x4*)((const bf16_t*)rbase + offr + bj * HALF);
                    else { const float* rp = (const float*)rbase + offr + bj * HALF; rf[mm][bj][0] = *(const f32x4*)rp; rf[mm][bj][1] = *(const f32x4*)(rp + 4); } } }
#pragma unroll
            for (int mm = 0; mm < MB; ++mm) { const int m = m0 + mm;
                const int r = wr * 64 + ai * HALF + m * 16 + fr; const size_t offo = (trow + r) * po + col0;
                f32x4 x[2][2]; float ss = 0.f;
#pragma unroll
                for (int bj = 0; bj < 2; ++bj) {
                    f32x4 r0, r1;
                    if (RES_BF16) { const u32x4 w = rb[mm][bj];
                        r0 = (f32x4){__builtin_bit_cast(float, w.x << 16), __builtin_bit_cast(float, w.x & 0xffff0000u), __builtin_bit_cast(float, w.y << 16), __builtin_bit_cast(float, w.y & 0xffff0000u)};
                        r1 = (f32x4){__builtin_bit_cast(float, w.z << 16), __builtin_bit_cast(float, w.z & 0xffff0000u), __builtin_bit_cast(float, w.w << 16), __builtin_bit_cast(float, w.w & 0xffff0000u)}; }
                    else { r0 = rf[mm][bj][0]; r1 = rf[mm][bj][1]; }
                    x[bj][0] = r0 + gt[bj][0] * acc[ai][bj][m][0]; x[bj][1] = r1 + gt[bj][1] * acc[ai][bj][m][1];
                    if (OUT_BF16) *(u32x4*)((bf16_t*)obase + offo + bj * HALF) = pack8(x[bj][0], x[bj][1]);
                    else { float* op = (float*)obase + offo + bj * HALF; *(f32x4*)op = x[bj][0]; *(f32x4*)(op + 4) = x[bj][1]; }
                    ss += sq4(x[bj][0]) + sq4(x[bj][1]);
                }
                if (has_gn) {
                    ss = quad_sum(ss);
                    const size_t grow = (size_t)u.pm * BM + r;
                    if (fq == 0) part[grow * 16 + u.pn * 4 + wc] = ss;
                    bf16_t* ap = Aout + grow * D + col0;
                    *(u32x4*)(ap) = pack8(x[0][0] * gn[0][0], x[0][1] * gn[0][1]); *(u32x4*)(ap + HALF) = pack8(x[1][0] * gn[1][0], x[1][1] * gn[1][1]);
                }
            }
            asm volatile("" ::: "memory");
        }
    }
};
constexpr int EPI_TAB_UNITS = 14;
template <class Sched> __device__ __forceinline__ void fill_epi_tables(PG8_LAS unsigned char* tab, const Sched& S, const float* part, const float* bias, int bias_ld) {
    const int tid = threadIdx.x; Unit u;
    for (int i = 0; i < EPI_TAB_UNITS && S.next(i, u); ++i) {
        const bool lat = u.pm < MLAT / BM; const int slot = lat ? (u.pm >> 5) : 4;
        if (tid < 256) *(PG8_LAS float*)(tab + i * 1024 + tid * 4) = row_rinv(part, u.pm * BM + tid);
        else *(PG8_LAS float*)(tab + 16384 + i * 1024 + (tid - 256) * 4) = bias[(size_t)slot * bias_ld + u.pn * BM + (tid - 256)];
    }
    asm volatile("s_waitcnt vmcnt(0) lgkmcnt(0)" ::: "memory"); __builtin_amdgcn_s_barrier(); asm volatile("" ::: "memory");
}
struct EpiSwiglu {
    static constexpr bool PERM = true, AFTER_DRAIN = false;
    PG8_LAS unsigned char* tab; bf16_t* HID; int ldh; mutable int seq;
    __device__ __forceinline__ void operator()(const f32x4 (&acc)[2][2][4][2], const Unit& u, int wr, int wc, int fr, int fq) const {
        const int c0 = wc * 32 + 8 * fq;
        const PG8_LAS unsigned char* tr = tab + seq * 1024; const PG8_LAS unsigned char* tb = tab + 16384 + seq * 1024 + c0 * 4; ++seq;
        f32x4 ba[2], bu[2];
#pragma unroll
        for (int n = 0; n < 2; ++n) { ba[n] = *(const PG8_LAS f32x4*)(tb + 16 * n); bu[n] = *(const PG8_LAS f32x4*)(tb + HALF * 4 + 16 * n); }
#pragma unroll
        for (int ai = 0; ai < 2; ++ai)
#pragma unroll
            for (int m = 0; m < 4; ++m) {
                const int rl = wr * 64 + ai * HALF + m * 16 + fr, row = u.pm * BM + rl;
                const float rinv = *(const PG8_LAS float*)(tr + rl * 4);
                f32x4 h[2];
#pragma unroll
                for (int n = 0; n < 2; ++n) { const f32x4 a = acc[ai][0][m][n] * rinv + ba[n], uu = acc[ai][1][m][n] * rinv + bu[n];
#pragma unroll
                    for (int j = 0; j < 4; ++j) h[n][j] = fast_silu(a[j]) * uu[j]; }
                *(u32x4*)(HID + (size_t)row * ldh + u.pn * HALF + c0) = pack8(h[0], h[1]);
            }
    }
};
struct EpiHg {
    static constexpr bool PERM = true, AFTER_DRAIN = false;
    PG8_LAS unsigned char* tab; unsigned short* HGO; const float* lb; mutable int seq;
    __device__ __forceinline__ void operator()(const f32x4 (&acc)[2][2][4][2], const Unit& u, int wr, int wc, int fr, int fq) const {
        const int type = u.pn >> 2, col0 = u.pn * BM + wc * 32 + 8 * fq;
        const PG8_LAS unsigned char* tr = tab + seq * 1024; const PG8_LAS unsigned char* tb = tab + 16384 + seq * 1024 + (wc * 32 + 8 * fq) * 4; ++seq;
        f32x4 bv[2][2], lbv[2][2];
#pragma unroll
        for (int bj = 0; bj < 2; ++bj)
#pragma unroll
            for (int n = 0; n < 2; ++n) { bv[bj][n] = *(const PG8_LAS f32x4*)(tb + bj * HALF * 4 + 16 * n);
                lbv[bj][n] = type >= 3 ? *(const f32x4*)(lb + (col0 - 3 * D) + bj * HALF + 4 * n) : (f32x4){0.f, 0.f, 0.f, 0.f}; }
#pragma unroll
        for (int ai = 0; ai < 2; ++ai)
#pragma unroll
            for (int m = 0; m < 4; ++m) {
                const int rl = wr * 64 + ai * HALF + m * 16 + fr, row = u.pm * BM + rl;
                const float rinv = *(const PG8_LAS float*)(tr + rl * 4);
#pragma unroll
                for (int bj = 0; bj < 2; ++bj) {
                    f32x4 v0 = acc[ai][bj][m][0] * rinv + bv[bj][0], v1 = acc[ai][bj][m][1] * rinv + bv[bj][1]; u32x4 w;
                    if (type == 1) w = pack8(v0, v1);
                    else if (type < 3) {
#pragma unroll
                        for (int j = 0; j < 4; ++j) { v0[j] = fast_silu(v0[j]); v1[j] = fast_silu(v1[j]); }
                        w = pack8(v0, v1);
                    } else {
#pragma unroll
                        for (int j = 0; j < 4; ++j) { v0[j] = (1.f - lbv[bj][0][j]) * fast_sigmoid(-v0[j]); v1[j] = (1.f - lbv[bj][1][j]) * fast_sigmoid(-v1[j]); }
                        w.x = pk_h2(v0[0], v0[1]); w.y = pk_h2(v0[2], v0[3]); w.z = pk_h2(v1[0], v1[1]); w.w = pk_h2(v1[2], v1[3]);
                    }
                    *(u32x4*)(HGO + (size_t)row * 5 * D + col0 + bj * HALF) = w;
                }
            }
    }
};

template <class Epi, class Sched, bool ALIGN_EPI = false, bool SP2 = false>
__device__ __forceinline__ void gemm_phase(PG8_LAS unsigned char* lds, const Gemm g, const Sched& S, const Epi& E) {
    const int tid = threadIdx.x, wid = __builtin_amdgcn_readfirstlane(tid >> 6), lane = tid & 63, wr = wid >> 2, wc = wid & 3, fr = lane & 15, fq = lane >> 4;
    const int K = g.K, nt = g.nt ? g.nt : K / BK;
    unsigned voffA[2], voffB[2];
#pragma unroll
    for (int i = 0; i < 2; ++i) { int R, C; stage_rc(tid * 16 + i * 8192, R, C); const int Rb = Epi::PERM ? ((R & ~31) + perm32(R & 31)) : R;
        voffA[i] = (unsigned)(R * g.lda + C) * 2u; voffB[i] = (unsigned)(Rb * K + C) * 2u; }
    const size_t kstep = (size_t)(BK * 2);
    const size_t hsA = (size_t)HALF * g.lda * 2, hsB = (size_t)HALF * K * 2;
    const size_t tsA = 2 * hsA, tsB = 2 * hsB;
    const unsigned ldsw = (unsigned)wid * 1024u;
    const int aoff = lds_byte(wr * 64 + fr, fq * 8), boff = lds_byte(wc * 32 + fr, fq * 8);
#define PG8_SA(b, h) (((b) * 2 + (h)) * HTB)
#define PG8_SB(b, h) ((4 + (b) * 2 + (h)) * HTB)
#define PG8_STAGE(bufoff, gbase, voff) do { _Pragma("unroll") for (int _i = 0; _i < 2; ++_i) \
        __builtin_amdgcn_global_load_lds((const unsigned*)((const char*)(gbase) + (voff)[_i]), (PG8_LAS unsigned*)(lds + (bufoff) + ldsw + _i * 8192), 16, 0, 0); } while (0)
#define PG8_LDA(dst, b, h) do { _Pragma("unroll") for (int m = 0; m < 4; ++m) _Pragma("unroll") for (int k = 0; k < 2; ++k) dst[m][k] = *(const PG8_LAS bf16x8*)(lds + PG8_SA(b, h) + aoff + m * 2048 + k * 1024); } while (0)
#define PG8_LDB(dst, b, h) do { _Pragma("unroll") for (int n = 0; n < 2; ++n) _Pragma("unroll") for (int k = 0; k < 2; ++k) dst[n][k] = *(const PG8_LAS bf16x8*)(lds + PG8_SB(b, h) + boff + n * 2048 + k * 1024); } while (0)
#define PG8_MMA(ai, bj, At, Bt) do { __builtin_amdgcn_s_setprio(1); _Pragma("unroll") for (int m = 0; m < 4; ++m) _Pragma("unroll") for (int n = 0; n < 2; ++n) _Pragma("unroll") for (int k = 0; k < 2; ++k) \
        acc[ai][bj][m][n] = __builtin_amdgcn_mfma_f32_16x16x32_bf16(Bt[n][k], At[m][k], acc[ai][bj][m][n], 0, 0, 0); __builtin_amdgcn_s_setprio(0); } while (0)
#define PG8_WAIT_V(n) asm volatile("s_waitcnt vmcnt(" #n ")" ::: "memory")
#define PG8_WAIT_L(n) asm volatile("s_waitcnt lgkmcnt(" #n ")" ::: "memory")
#define PG8_BAR __builtin_amdgcn_s_barrier()
#define PG8_SCHED __builtin_amdgcn_sched_barrier(0)
    Unit cur, nxt; int ui = 0;
    if (!S.next(0, cur)) return;
    f32x4 acc[2][2][4][2];
#pragma unroll
    for (int a = 0; a < 2; ++a)
#pragma unroll
        for (int b = 0; b < 2; ++b)
#pragma unroll
            for (int m = 0; m < 4; ++m)
#pragma unroll
                for (int n = 0; n < 2; ++n) acc[a][b][m][n] = (f32x4){0.f, 0.f, 0.f, 0.f};
    bf16x8 At[4][2], B0[2][2], B1[2][2];
    const char* cA = (const char*)g.A + (size_t)cur.pm * tsA + (size_t)g.koff * 2; const char* cB = (const char*)g.Bt + (size_t)cur.pn * tsB + (size_t)g.koff * 2;
    S.a_ready(cur);
    if constexpr (SP2) {
        PG8_STAGE(PG8_SB(0, 0), cB, voffB); PG8_STAGE(PG8_SB(0, 1), cB + hsB, voffB); PG8_STAGE(PG8_SA(0, 0), cA, voffA); PG8_STAGE(PG8_SA(0, 1), cA + hsA, voffA);
        if (wr == 1) PG8_BAR;
        PG8_WAIT_V(2); PG8_BAR;
        PG8_STAGE(PG8_SB(1, 0), cB + kstep, voffB); PG8_STAGE(PG8_SA(1, 0), cA + kstep, voffA); PG8_STAGE(PG8_SB(1, 1), cB + hsB + kstep, voffB);
        PG8_WAIT_V(6); PG8_BAR;
    } else {
        PG8_STAGE(PG8_SB(0, 0), cB, voffB); PG8_STAGE(PG8_SA(0, 0), cA, voffA); PG8_STAGE(PG8_SB(0, 1), cB + hsB, voffB); PG8_STAGE(PG8_SA(0, 1), cA + hsA, voffA);
        if (wr == 1) PG8_BAR;
        PG8_WAIT_V(4); PG8_BAR;
        PG8_STAGE(PG8_SB(1, 0), cB + kstep, voffB); PG8_STAGE(PG8_SA(1, 0), cA + kstep, voffA); PG8_STAGE(PG8_SB(1, 1), cB + hsB + kstep, voffB);
        PG8_WAIT_V(6); PG8_BAR;
    }
    for (;;) {
        const bool has_next = S.next(ui + 1, nxt);
        const char* nA = has_next ? (const char*)g.A + (size_t)nxt.pm * tsA + (size_t)g.koff * 2 : cA; const char* nB = has_next ? (const char*)g.Bt + (size_t)nxt.pn * tsB + (size_t)g.koff * 2 : cB;
        for (int t = 0; t < nt; t += 2) {
            const bool last = (t == nt - 2);
            const char* a1 = cA + (size_t)(t + 1) * kstep;
            const char* a2 = last ? nA : cA + (size_t)(t + 2) * kstep; const char* b2 = last ? nB : cB + (size_t)(t + 2) * kstep;
            const char* a3 = a2 + kstep; const char* b3 = b2 + kstep;
            if (last && has_next) S.a_ready(nxt);
            if constexpr (SP2) {
            PG8_LDB(B0, 0, 0); PG8_LDB(B1, 0, 1); PG8_SCHED; PG8_LDA(At, 0, 0); PG8_STAGE(PG8_SA(1, 1), a1 + hsA, voffA);
            PG8_WAIT_V(8); PG8_WAIT_L(0); PG8_BAR; PG8_MMA(0, 0, At, B0); PG8_MMA(0, 1, At, B1); PG8_BAR; PG8_SCHED;
            PG8_LDA(At, 0, 1); PG8_STAGE(PG8_SB(0, 0), b2, voffB); PG8_STAGE(PG8_SB(0, 1), b2 + hsB, voffB); PG8_STAGE(PG8_SA(0, 0), a2, voffA);
            PG8_WAIT_V(8); PG8_WAIT_L(0); PG8_BAR; PG8_MMA(1, 0, At, B0); PG8_MMA(1, 1, At, B1); PG8_BAR; PG8_SCHED;
            PG8_LDB(B0, 1, 0); PG8_LDB(B1, 1, 1); PG8_SCHED; PG8_LDA(At, 1, 0); PG8_STAGE(PG8_SA(0, 1), a2 + hsA, voffA);
            PG8_WAIT_V(8); PG8_WAIT_L(0); PG8_BAR; PG8_MMA(0, 0, At, B0); PG8_MMA(0, 1, At, B1); PG8_BAR; PG8_SCHED;
            PG8_LDA(At, 1, 1); PG8_STAGE(PG8_SB(1, 0), b3, voffB); PG8_STAGE(PG8_SB(1, 1), b3 + hsB, voffB); PG8_STAGE(PG8_SA(1, 0), a3, voffA);
            PG8_WAIT_V(8); PG8_WAIT_L(0); PG8_BAR; PG8_MMA(1, 0, At, B0); PG8_MMA(1, 1, At, B1); PG8_BAR; PG8_SCHED;
            } else {
            PG8_LDB(B0, 0, 0); PG8_SCHED; PG8_LDA(At, 0, 0); PG8_STAGE(PG8_SA(1, 1), a1 + hsA, voffA);
            PG8_WAIT_L(8); PG8_BAR; PG8_WAIT_L(0); PG8_MMA(0, 0, At, B0); PG8_BAR; PG8_SCHED;
            PG8_LDB(B1, 0, 1); PG8_STAGE(PG8_SB(0, 0), b2, voffB);
            PG8_BAR; PG8_WAIT_L(0); PG8_MMA(0, 1, At, B1); PG8_BAR;
            PG8_LDA(At, 0, 1); PG8_STAGE(PG8_SA(0, 0), a2, voffA);
            PG8_BAR; PG8_WAIT_L(0); PG8_MMA(1, 0, At, B0); PG8_BAR; PG8_SCHED;
            PG8_STAGE(PG8_SB(0, 1), b2 + hsB, voffB);
            PG8_WAIT_V(6); PG8_BAR; PG8_MMA(1, 1, At, B1); PG8_BAR;
            PG8_LDB(B0, 1, 0); PG8_SCHED; PG8_LDA(At, 1, 0); PG8_STAGE(PG8_SA(0, 1), a2 + hsA, voffA);
            PG8_WAIT_L(8); PG8_BAR; PG8_WAIT_L(0); PG8_MMA(0, 0, At, B0); PG8_BAR; PG8_SCHED;
            PG8_LDB(B1, 1, 1); PG8_STAGE(PG8_SB(1, 0), b3, voffB);
            PG8_BAR; PG8_WAIT_L(0); PG8_MMA(0, 1, At, B1); PG8_BAR;
            PG8_LDA(At, 1, 1); PG8_STAGE(PG8_SA(1, 0), a3, voffA);
            PG8_BAR; PG8_WAIT_L(0); PG8_MMA(1, 0, At, B0); PG8_BAR; PG8_SCHED;
            PG8_STAGE(PG8_SB(1, 1), b3 + hsB, voffB);
            PG8_WAIT_V(6); PG8_BAR; PG8_MMA(1, 1, At, B1); PG8_BAR;
            }
        }
        if constexpr (ALIGN_EPI) { if (wr == 0) PG8_BAR; }
        if constexpr (!Epi::AFTER_DRAIN) { E(acc, cur, wr, wc, fr, fq); S.done(cur); }
        if (!has_next) break;
#pragma unroll
        for (int a = 0; a < 2; ++a)
#pragma unroll
            for (int b = 0; b < 2; ++b)
#pragma unroll
                for (int m = 0; m < 4; ++m)
#pragma unroll
                    for (int n = 0; n < 2; ++n) acc[a][b][m][n] = (f32x4){0.f, 0.f, 0.f, 0.f};
        cur = nxt; cA = nA; cB = nB; ++ui;
        if constexpr (ALIGN_EPI) { if (wr == 1) PG8_BAR; }
    }
    PG8_WAIT_V(0);
    if constexpr (!ALIGN_EPI) { if (wr == 0) PG8_BAR; }
    PG8_BAR;
    if constexpr (Epi::AFTER_DRAIN) { E.fused(acc, cur, wr, wc, fr, fq, lds, wid, lane); S.done(cur); }
#undef PG8_SA
#undef PG8_SB
#undef PG8_STAGE
#undef PG8_LDA
#undef PG8_LDB
#undef PG8_MMA
#undef PG8_WAIT_V
#undef PG8_WAIT_L
#undef PG8_BAR
#undef PG8_SCHED
}

}


#define XB_TMO      128
#define XB_XCNT(j)  (256  + 64 * (j))
#define XB_XSUB(j)  (1280 + 64 * (j))
#define XB_XGEN(j)  (2304 + 64 * (j))
#define XB_TOP      3328
#define XB_TOPGEN   3392
#define XCD_BAR_WORDS 3456
#define XB_SPIN_CAP (1u << 20)

__device__ __forceinline__ unsigned xb_ld(unsigned* p)              { return __hip_atomic_load(p, __ATOMIC_RELAXED, __HIP_MEMORY_SCOPE_AGENT); }
__device__ __forceinline__ unsigned xb_add(unsigned* p, unsigned v) { return __hip_atomic_fetch_add(p, v, __ATOMIC_RELAXED, __HIP_MEMORY_SCOPE_AGENT); }
__device__ __forceinline__ unsigned xb_xcc_id() { return (unsigned)__builtin_amdgcn_s_getreg((3 << 11) | 20) & 0xFu; }
#define XB_SPIN(cond, bar) do { unsigned _sp = 0; while (cond) { __builtin_amdgcn_s_sleep(1); \
    if ((++_sp & 255u) == 0u) { if (xb_ld(&(bar)[XB_TMO])) break; if (_sp > XB_SPIN_CAP) { atomicAdd(&(bar)[XB_TMO], 1u); break; } } } } while (0)

struct XcdBarrier {
    unsigned* bar; unsigned x;
    volatile LAS unsigned* st;
};

__device__ __forceinline__ XcdBarrier xcd_barrier_post(unsigned* bar, volatile LAS unsigned* st) {
    XcdBarrier b; b.bar = bar; b.x = xb_xcc_id(); b.st = st;
    if (threadIdx.x == 0) (void)xb_add(&bar[XB_XCNT(b.x)], 1u);
    return b;
}
__device__ __forceinline__ void xcd_barrier_complete(unsigned* bar, unsigned x, unsigned& nloc, unsigned& nx) {
    const unsigned G = gridDim.x * gridDim.y * gridDim.z;
    unsigned sum, cnt, mine, sp = 0u;
    for (;;) {
        sum = 0u; cnt = 0u; mine = 0u;
#pragma unroll
        for (unsigned j = 0; j < 16; ++j) { const unsigned c = xb_ld(&bar[XB_XCNT(j)]); sum += c; cnt += (c > 0u) ? 1u : 0u; mine = (j == x) ? c : mine; }
        if (sum == G) break;
        __builtin_amdgcn_s_sleep(1);
        if ((++sp & 255u) == 0u) { if (xb_ld(&bar[XB_TMO])) break; if (sp > XB_SPIN_CAP) { atomicAdd(&bar[XB_TMO], 1u); break; } }
    }
    nloc = mine > 0u ? mine : 1u; nx = cnt > 0u ? cnt : 1u;
}

__device__ __forceinline__ void xcd_barrier(const XcdBarrier& b) {
    asm volatile("s_waitcnt vmcnt(0)" ::: "memory");
    __syncthreads();
    if (threadIdx.x == 0) {
        unsigned* bar = b.bar;
        __builtin_amdgcn_s_waitcnt(0);
        unsigned nloc = b.st[0], nx = b.st[1];
        if (nloc == 0u) { xcd_barrier_complete(bar, b.x, nloc, nx); b.st[0] = nloc; b.st[1] = nx; }
        const unsigned old = xb_add(&bar[XB_XSUB(b.x)], 1u);
        const unsigned gen = old / nloc;
        if (old + 1u == (gen + 1u) * nloc) {
            __builtin_amdgcn_fence(__ATOMIC_RELEASE, "agent");
            asm volatile("s_waitcnt vmcnt(0)" ::: "memory");
            const unsigned og = xb_add(&bar[XB_TOP], 1u);
            const unsigned tg = og / nx;
            if (og + 1u == (tg + 1u) * nx) xb_add(&bar[XB_TOPGEN], 1u);
            else XB_SPIN(xb_ld(&bar[XB_TOPGEN]) == tg, bar);
            __builtin_amdgcn_fence(__ATOMIC_ACQUIRE, "agent");
            xb_add(&bar[XB_XGEN(b.x)], 1u);
            asm volatile("s_waitcnt vmcnt(0)" ::: "memory");
        } else {
            XB_SPIN(xb_ld(&bar[XB_XGEN(b.x)]) == gen, bar);
            __builtin_amdgcn_fence(__ATOMIC_ACQUIRE, "agent");
            asm volatile("s_waitcnt vmcnt(0)" ::: "memory");
        }
    }
    __syncthreads();
}

namespace na {
typedef short bf16x8 __attribute__((ext_vector_type(8)));
typedef short s16x4 __attribute__((ext_vector_type(4)));
typedef float f32x16 __attribute__((ext_vector_type(16)));
constexpr float LOG2E = 1.4426950408889634f;
constexpr int KOFF = 0, VOFF = 16384;
constexpr int N_LAT_UNITS = BATCH * NAH * (ROWS / 4), N_UNITS = N_LAT_UNITS + BATCH * NAH;
__device__ __forceinline__ s16x4 vtr(const LAS unsigned char* p) { return __builtin_bit_cast(s16x4, __builtin_amdgcn_ds_read_tr16_b64_v4i16((LAS s16x4*)p)); }
__device__ __forceinline__ int clampi(int v, int lo, int hi) { return v < lo ? lo : (v > hi ? hi : v); }

constexpr int BM_HEAD_BYTES = 15 * 4 * 2 * 64 * 16;
__device__ __forceinline__ void build_bias_table(float* BM, const float* rpb, int G, int bx) {
    for (int idx = bx * 512 + (int)threadIdx.x; idx < NAH * 15 * 4 * 2 * 64 * 4; idx += G * 512) {
        const int reg = idx & 3, lane = (idx >> 2) & 63, kb = (idx >> 8) & 1, jq = (idx >> 9) & 3, hd = idx >> 11;
        const int qc = 16 * jq + (lane & 15), kc = clampi(16 * jq - 8, 0, 32) + 16 * kb + 4 * (lane >> 4) + reg, cs = clampi(qc - 8, 0, GW - 16);
        BM[idx] = (kc >= cs && kc < cs + 16) ? rpb[hd * 31 + kc - qc + 15] : -INFINITY;
    }
}
constexpr int BMOFF = 32768;
template <int MODE> __device__ __forceinline__ void attn_phase(LAS unsigned char* lds, const bf16_t* QKV, const float* BM, const float* qg, const float* kg, bf16_t* O, int G, int vcu) {
    const int tid = threadIdx.x, lane = tid & 63, wave = __builtin_amdgcn_readfirstlane(tid >> 6), r32 = lane & 31, hi = lane >> 5;
    const int lkey = tid >> 3, lc16 = tid & 7;
    const int kwoff = lkey * 128 + ((lc16 ^ ((lkey >> 1) & 7)) * 16);
    const int vwoff = lkey * 128 + (((lc16 >> 1) ^ ((lkey >> 1) & 3)) * 32) + (lc16 & 1) * 16;
    const int i16 = lane & 15, g4 = lane >> 4;
    int lk = i16 * 128 + ((g4 ^ ((i16 >> 1) & 7)) * 16), lv = (4 * g4 + (i16 >> 2)) * 128 + (((2 * (g4 & 1) + (i16 >> 3)) & 3) << 5) + 8 * (i16 & 3);
    const int h = (vcu >> 4) & 15, wl = vcu & 15;
    float nshift;
    { const float gq = fabsf(qg[lane] * kg[lane]); float mxg = gq;
#pragma unroll
      for (int o = 1; o < 64; o <<= 1) mxg = fmaxf(mxg, __shfl_xor(mxg, o));
      nshift = -(8.f * mxg * 1.03f + 0.25f) * LOG2E; }
    { const v4u* src = (const v4u*)(BM + (size_t)h * (BM_HEAD_BYTES / 4));
      for (int i = tid; i < BM_HEAD_BYTES / 16; i += 512) *(LAS v4u*)(lds + BMOFF + i * 16) = src[i]; }
    struct UnitP { int b, R, r, qrow0, rs, kr_lo, ntl, NT; bool is_ctx, valid; };
    auto unit_of = [&](int it) { UnitP q; q.is_ctx = it == 8; q.valid = it < 8 || (it == 8 && wl < 4);
        const int kk = it * 16 + wl; q.b = q.is_ctx ? wl : (kk >> 5); q.R = q.is_ctx ? 0 : (kk & 31);
        q.r = 4 * q.R + (wave >> 1); const int c0 = 32 * (wave & 1);
        q.qrow0 = q.is_ctx ? MLAT + q.b * CTX + wave * 32 : q.b * SEQ + q.r * GW + c0;
        q.rs = clampi(q.r - 4, 0, ROWS - 8);
        q.kr_lo = q.is_ctx ? 0 : clampi(4 * q.R - 4, 0, ROWS - 8); const int kr_hi = q.is_ctx ? 0 : clampi(4 * q.R - 1, 0, ROWS - 8) + 8;
        q.ntl = kr_hi - q.kr_lo; q.NT = q.ntl + 4; return q; };
    auto tile_ptr = [&](const UnitP& q, int t) -> const bf16_t* { const int row0 = t < q.ntl ? q.b * SEQ + (q.kr_lo + t) * GW : MLAT + q.b * CTX + (t - q.ntl) * 64;
        return QKV + (size_t)(row0 + lkey) * 3072 + D + h * 64 + lc16 * 8; };
    UnitP U = unit_of(0);
    bf16x8 qr[4]; v4u kreg[2], vreg[2];
#pragma unroll
    for (int f = 0; f < 4; ++f) qr[f] = *(const bf16x8*)(QKV + (size_t)(U.qrow0 + 16 * (f >> 1) + i16) * 3072 + h * 64 + (f & 1) * 32 + g4 * 8);
    { const bf16_t* kp = tile_ptr(U, 0); kreg[0] = *(const v4u*)kp; vreg[0] = *(const v4u*)(kp + D); }
    { const bf16_t* kp = tile_ptr(U, 1); kreg[1] = *(const v4u*)kp; vreg[1] = *(const v4u*)(kp + D); }
    for (int it = 0; it < 9 && U.valid; ++it) {
        const UnitP UN = unit_of(it + 1);
        const int b = U.b, r = U.r, qrow0 = U.qrow0, rs = U.rs, kr_lo = U.kr_lo, ntl = U.ntl, NT = U.NT;
        __syncthreads();
        float lsum[2] = {0.f, 0.f}; f32x4 o[8];
#pragma unroll
        for (int f = 0; f < 8; ++f) o[f] = (f32x4){0.f, 0.f, 0.f, 0.f};
        auto step = [&](auto PARC, int t, int tl) {
            constexpr int PAR = decltype(PARC)::value;
            asm volatile("" : "+v"(lk), "+v"(lv));
            const bool local = t < ntl; const int kr = kr_lo + t;
            const bool need = MODE != 1 && (!local || (kr >= rs && kr < rs + 8));
            *(LAS v4u*)(lds + KOFF + PAR * 8192 + kwoff) = kreg[PAR];
            *(LAS v4u*)(lds + VOFF + PAR * 8192 + vwoff) = vreg[PAR];
            { const bf16_t* kp = t + 2 < NT ? tile_ptr(U, t + 2) : tile_ptr(UN.valid ? UN : U, tl >= 0 ? tl : 0); kreg[PAR] = *(const v4u*)kp; vreg[PAR] = *(const v4u*)(kp + D); }
            f32x4 cb[4];
            if (need && local) { const LAS unsigned char* tp = lds + BMOFF + ((kr - r + 7) * 4 + 2 * (wave & 1)) * 2048 + lane * 16;
#pragma unroll
                for (int f = 0; f < 4; ++f) cb[f] = *(const LAS f32x4*)(tp + f * 1024); }
            __syncthreads();
            if (need) {
                const LAS unsigned char* Kb = lds + KOFF + PAR * 8192; const LAS unsigned char* Vb = lds + VOFF + PAR * 8192;
                if (local) {
                    const int sp0 = (wave & 1) ? 24 : 0, sp1 = (wave & 1) ? 32 : 8;
#pragma unroll
                    for (int qb = 0; qb < 2; ++qb) { const int sp = qb ? sp1 : sp0;
                        bf16x8 kf[4];
#pragma unroll
                        for (int kb = 0; kb < 2; ++kb)
#pragma unroll
                            for (int ks = 0; ks < 2; ++ks) kf[2 * kb + ks] = *(const LAS bf16x8*)(Kb + (sp + 16 * kb) * 128 + (lk ^ ((ks ^ ((sp >> 3) & 1)) << 6)));
                        s16x4 va[8];
#pragma unroll
                        for (int db = 0; db < 4; ++db) { const LAS unsigned char* pa = Vb + sp * 128 + (lv ^ (db << 5));
                            va[db * 2] = vtr(pa); va[db * 2 + 1] = vtr(pa + 16 * 128); }
                        f32x4 sc[2];
#pragma unroll
                        for (int kb = 0; kb < 2; ++kb) { sc[kb] = cb[2 * qb + kb];
#pragma unroll
                            for (int ks = 0; ks < 2; ++ks) sc[kb] = __builtin_amdgcn_mfma_f32_16x16x32_bf16(kf[2 * kb + ks], qr[2 * qb + ks], sc[kb], 0, 0, 0); }
                        if (MODE == 2 || MODE == 4) { o[qb * 4] = o[qb * 4] + sc[0] + sc[1]; continue; }
#pragma unroll
                        for (int kb = 0; kb < 2; ++kb)
#pragma unroll
                            for (int e2 = 0; e2 < 4; ++e2) { sc[kb][e2] = __builtin_amdgcn_exp2f(__builtin_fmaf(sc[kb][e2], LOG2E, nshift)); lsum[qb] += sc[kb][e2]; }
                        if (MODE == 3) { o[qb * 4] = o[qb * 4] + sc[0] + sc[1]; continue; }
                        v4u pw; pw.x = pg8::cvt_pk_bf16(sc[0][0], sc[0][1]); pw.y = pg8::cvt_pk_bf16(sc[0][2], sc[0][3]);
                        pw.z = pg8::cvt_pk_bf16(sc[1][0], sc[1][1]); pw.w = pg8::cvt_pk_bf16(sc[1][2], sc[1][3]);
                        const bf16x8 pf = __builtin_bit_cast(bf16x8, pw);
#pragma unroll
                        for (int db = 0; db < 4; ++db) { const s16x4 lo = va[db * 2], hi4 = va[db * 2 + 1];
                            const bf16x8 vf = {lo[0], lo[1], lo[2], lo[3], hi4[0], hi4[1], hi4[2], hi4[3]};
                            o[qb * 4 + db] = __builtin_amdgcn_mfma_f32_16x16x32_bf16(vf, pf, o[qb * 4 + db], 0, 0, 0); }
                    }
                } else {
#pragma unroll
                    for (int grp = 0; grp < 2; ++grp) {
                        bf16x8 kf[4];
#pragma unroll
                        for (int kb = 0; kb < 2; ++kb)
#pragma unroll
                            for (int ks = 0; ks < 2; ++ks) kf[2 * kb + ks] = *(const LAS bf16x8*)(Kb + (2 * grp + kb) * 2048 + (lk ^ (ks << 6)));
                        s16x4 va[8];
#pragma unroll
                        for (int db = 0; db < 4; ++db) { const LAS unsigned char* pa = Vb + grp * 4096 + (lv ^ (db << 5)); va[db * 2] = vtr(pa); va[db * 2 + 1] = vtr(pa + 16 * 128); }
#pragma unroll
                        for (int qb = 0; qb < 2; ++qb) {
                            f32x4 sc[2];
#pragma unroll
                            for (int kb = 0; kb < 2; ++kb) { sc[kb] = (f32x4){0.f, 0.f, 0.f, 0.f};
#pragma unroll
                                for (int ks = 0; ks < 2; ++ks) sc[kb] = __builtin_amdgcn_mfma_f32_16x16x32_bf16(kf[2 * kb + ks], qr[2 * qb + ks], sc[kb], 0, 0, 0); }
                            if (MODE == 2 || MODE == 4) { o[qb * 4] = o[qb * 4] + sc[0] + sc[1]; continue; }
#pragma unroll
                            for (int kb = 0; kb < 2; ++kb)
#pragma unroll
                                for (int e2 = 0; e2 < 4; ++e2) { sc[kb][e2] = __builtin_amdgcn_exp2f(__builtin_fmaf(sc[kb][e2], LOG2E, nshift)); lsum[qb] += sc[kb][e2]; }
                            if (MODE == 3) { o[qb * 4] = o[qb * 4] + sc[0] + sc[1]; continue; }
                            v4u pw; pw.x = pg8::cvt_pk_bf16(sc[0][0], sc[0][1]); pw.y = pg8::cvt_pk_bf16(sc[0][2], sc[0][3]);
                            pw.z = pg8::cvt_pk_bf16(sc[1][0], sc[1][1]); pw.w = pg8::cvt_pk_bf16(sc[1][2], sc[1][3]);
                            const bf16x8 pf = __builtin_bit_cast(bf16x8, pw);
#pragma unroll
                            for (int db = 0; db < 4; ++db) { const s16x4 lo = va[db * 2], hi4 = va[db * 2 + 1];
                                const bf16x8 vf = {lo[0], lo[1], lo[2], lo[3], hi4[0], hi4[1], hi4[2], hi4[3]};
                                o[qb * 4 + db] = __builtin_amdgcn_mfma_f32_16x16x32_bf16(vf, pf, o[qb * 4 + db], 0, 0, 0); }
                        }
                    }
                }
            }
        };
        if (NT & 1) {
            step(std::integral_constant<int, 0>{}, 0, -1);
            for (int t = 1; t < NT; t += 2) { step(std::integral_constant<int, 1>{}, t, 1); step(std::integral_constant<int, 0>{}, t + 1, 0); }
        } else {
            for (int t = 0; t < NT; t += 2) { step(std::integral_constant<int, 0>{}, t, 0); step(std::integral_constant<int, 1>{}, t + 1, 1); }
        }
#pragma unroll
        for (int qb = 0; qb < 2; ++qb) {
            float l = lsum[qb]; l += __shfl_xor(l, 16); l += __shfl_xor(l, 32);
            const float rl = 1.f / l;
            bf16_t* op = O + (size_t)(qrow0 + 16 * qb + i16) * D + h * 64 + 4 * g4;
#pragma unroll
            for (int db = 0; db < 4; ++db) { v2u w; w.x = pg8::cvt_pk_bf16(o[qb * 4 + db][0] * rl, o[qb * 4 + db][1] * rl); w.y = pg8::cvt_pk_bf16(o[qb * 4 + db][2] * rl, o[qb * 4 + db][3] * rl);
                *(v2u*)(op + 16 * db) = w; }
        }
        U = UN;
        if (U.valid) {
#pragma unroll
            for (int f = 0; f < 4; ++f) qr[f] = *(const bf16x8*)(QKV + (size_t)(U.qrow0 + 16 * (f >> 1) + i16) * 3072 + h * 64 + (f & 1) * 32 + g4 * 8); }
    }
}
}


namespace hg {
typedef short bf16x8 __attribute__((ext_vector_type(8)));
typedef short s16x4 __attribute__((ext_vector_type(4)));
constexpr int QT = 0, KT = 16384, VT = 32768, AM = 49152, EB = 57344, EK = 57856, DL = 58368, OT = 59392;
constexpr int NSLOT = 9;
constexpr size_t STATE_SLOT_F = 128 * 128;
constexpr size_t WS_DEC_OFF = (size_t)64 * NSLOT * STATE_SLOT_F * 4;
__device__ __forceinline__ s16x4 vtr(const LAS unsigned char* p) { return __builtin_bit_cast(s16x4, __builtin_amdgcn_ds_read_tr16_b64_v4i16((LAS s16x4*)p)); }
__device__ __forceinline__ int fsw(int t) { return ((t & 3) ^ ((t >> 4) & 3)) | (((t >> 3) & 1) << 2); }
__device__ __forceinline__ int toff(int t, int c16) { return t * 256 + (((c16 >> 1) ^ fsw(t)) * 32) + (c16 & 1) * 16; }
#define HG_BAR() do { asm volatile("s_waitcnt vmcnt(0) lgkmcnt(0)" ::: "memory"); __builtin_amdgcn_s_barrier(); asm volatile("" ::: "memory"); } while (0)
#define HG_LBAR() do { asm volatile("s_waitcnt lgkmcnt(0)" ::: "memory"); __builtin_amdgcn_s_barrier(); asm volatile("" ::: "memory"); } while (0)

struct Stage { v4u q[2], k[2], v[2]; };
template <bool WITH_Q> __device__ __forceinline__ void stage_load(Stage& st, const unsigned short* HGO, int row0, int h, int dir, int tid) {
#pragma unroll
    for (int i = 0; i < 2; ++i) { const int p = tid + 512 * i, row = p >> 4, c16 = p & 15;
        const unsigned short* src = HGO + (size_t)(row0 + row) * 5120 + h * 128 + c16 * 8;
        if (WITH_Q) st.q[i] = *(const v4u*)src;
        st.v[i] = *(const v4u*)(src + D); st.k[i] = *(const v4u*)(src + (3 + dir) * D); }
}
template <bool WITH_Q> __device__ __forceinline__ void stage_store(const Stage& st, LAS unsigned char* lds, int tid) {
#pragma unroll
    for (int i = 0; i < 2; ++i) { const int p = tid + 512 * i, o16 = toff(p >> 4, p & 15);
        if (WITH_Q) *(LAS v4u*)(lds + QT + o16) = st.q[i];
        *(LAS v4u*)(lds + KT + o16) = st.k[i];
        *(LAS v4u*)(lds + VT + o16) = st.v[i]; }
}
struct Bases { int b0, bq, bt, ba, bw, bo, bp, bs; };
__device__ __forceinline__ Bases make_bases(int tid) {
    const int lane = tid & 63, wave = tid >> 6, i16 = lane & 15, g = lane >> 4, kp = tid >> 3, seg = tid & 7;
    const int F0 = (i16 & 3) | (((i16 >> 3) & 1) << 2);
    Bases B;
    B.b0 = (i16 * 256) | ((F0 ^ (g >> 1)) << 5) | ((g & 1) << 4);
    B.bq = (i16 * 256) | (F0 << 5) | ((g >> 1) << 4) | ((g & 1) << 3);
    B.bt = ((8 * g + (i16 >> 2)) * 256) | ((((i16 >> 2) ^ (g >> 1)) | ((g & 1) << 2)) << 5) | (8 * (i16 & 3));
    B.ba = (i16 * 128) | ((g ^ ((i16 >> 1) & 7)) << 4);
    B.bw = (i16 * 128) | (((g >> 1) ^ ((i16 >> 1) & 7)) << 4) | ((g & 1) << 3);
    B.bo = (g * 2048) | ((wave ^ g) << 6) | (i16 << 2);
    B.bp = (seg * 2048) | (((kp >> 3) ^ (seg >> 1) ^ ((seg & 1) << 2)) << 5) | (((kp >> 2) & 1) << 4) | ((kp & 3) << 2);
    B.bs = toff(tid >> 4, tid & 15);
    return B;
}
#define HG_LAUNDER(B) asm volatile("" : "+v"((B).b0), "+v"((B).bq), "+v"((B).bt), "+v"((B).ba), "+v"((B).bw), "+v"((B).bo), "+v"((B).bp), "+v"((B).bs))
template <bool WITH_Q> __device__ __forceinline__ void stage_store2(const Stage& st, LAS unsigned char* lds, int bs) {
#pragma unroll
    for (int i = 0; i < 2; ++i) { const int o16 = (bs ^ (i << 6)) + i * 8192;
        if (WITH_Q) *(LAS v4u*)(lds + QT + o16) = st.q[i];
        *(LAS v4u*)(lds + KT + o16) = st.k[i];
        *(LAS v4u*)(lds + VT + o16) = st.v[i]; }
}
template <bool FULL> __device__ __forceinline__ void prep(LAS unsigned char* lds, int dir, int tid, int bp) {
    const int kp = tid >> 3, seg = tid & 7; const bool left = seg < 4;
    float kg[8][2], w[8][2], T[2];
#pragma unroll
    for (int i = 0; i < 8; ++i) {
        const unsigned kk = *(const LAS unsigned*)(lds + KT + (bp ^ ((i & 3) << 5)) + i * 256);
        kg[i][0] = h2f((f16_t)(kk & 0xffffu)); kg[i][1] = h2f((f16_t)(kk >> 16)); }
    const bool incl = left ? (dir == 1) : (dir == 0);
#pragma unroll
    for (int ch = 0; ch < 2; ++ch) { float run = 1.f;
        if (left) {
#pragma unroll
            for (int i = 7; i >= 0; --i) { const float f = 1.f - kg[i][ch]; const float nx = run * f; w[i][ch] = incl ? nx : run; run = nx; }
        } else {
#pragma unroll
            for (int i = 0; i < 8; ++i) { const float f = 1.f - kg[i][ch]; const float nx = run * f; w[i][ch] = incl ? nx : run; run = nx; }
        }
        T[ch] = run; }
    float totL[2], totR[2];
#pragma unroll
    for (int ch = 0; ch < 2; ++ch) {
        float inc = T[ch];
        { const float up = __shfl_up(inc, 1, 4), dn = __shfl_down(inc, 1, 4); const int q = seg & 3; if (left) { if (q + 1 < 4) inc *= dn; } else { if (q >= 1) inc *= up; } }
        { const float up = __shfl_up(inc, 2, 4), dn = __shfl_down(inc, 2, 4); const int q = seg & 3; if (left) { if (q + 2 < 4) inc *= dn; } else { if (q >= 2) inc *= up; } }
        totL[ch] = __shfl(inc, 0, 8); totR[ch] = __shfl(inc, 7, 8);
        const float cross = __shfl(inc, left ? (seg + 1 < 4 ? seg + 1 : seg) : (seg - 1 >= 4 ? seg - 1 : seg), 8);
        const float cr = left ? (seg + 1 < 4 ? cross : 1.f) : (seg - 1 >= 4 ? cross : 1.f);
#pragma unroll
        for (int i = 0; i < 8; ++i) w[i][ch] *= cr;
    }
    const bool x_is_e1 = left ? (dir == 1) : (dir == 0);
#pragma unroll
    for (int i = 0; i < 8; ++i) { const int o4 = (bp ^ ((i & 3) << 5)) + i * 256;
        const float x0 = w[i][0], x1 = w[i][1];
        const float r0 = __builtin_amdgcn_rcpf(fmaxf(x0, 1e-30f)), r1 = __builtin_amdgcn_rcpf(fmaxf(x1, 1e-30f));
        const float e20 = x_is_e1 ? r0 : x0, e21 = x_is_e1 ? r1 : x1;
        *(LAS unsigned*)(lds + KT + o4) = pg8::cvt_pk_bf16(kg[i][0] * e20, kg[i][1] * e21);
        if (FULL) {
            const unsigned qq = *(const LAS unsigned*)(lds + QT + o4);
            const float q0 = __builtin_bit_cast(float, qq << 16), q1 = __builtin_bit_cast(float, qq & 0xffff0000u);
            const float e10 = x_is_e1 ? x0 : r0, e11 = x_is_e1 ? x1 : r1;
            *(LAS unsigned*)(lds + QT + o4) = pg8::cvt_pk_bf16(q0 * e10, q1 * e11);
        }
    }
    if (seg == 0) {
        if (FULL) { f32x2 e; e.x = dir == 0 ? totL[0] : totR[0]; e.y = dir == 0 ? totL[1] : totR[1]; *(LAS f32x2*)(lds + EB + 2 * kp * 4) = e; }
        { f32x2 e; e.x = dir == 0 ? totR[0] : totL[0]; e.y = dir == 0 ? totR[1] : totL[1]; *(LAS f32x2*)(lds + EK + 2 * kp * 4) = e; }
        { f32x2 e; e.x = totL[0] * totR[0]; e.y = totL[1] * totR[1]; *(LAS f32x2*)(lds + DL + 2 * kp * 4) = e; }
    }
}
__device__ __forceinline__ void load_vB(bf16x8 (&vB)[2], const LAS unsigned char* lds, int wave, int bt) {
#pragma unroll
    for (int ks = 0; ks < 2; ++ks) {
        const LAS unsigned char* pa = lds + VT + (bt ^ ((wave ^ (2 * (ks & 1))) << 5)) + ks * 8192;
        const s16x4 lo = vtr(pa), hi4 = vtr(pa + 1024);
        vB[ks] = (bf16x8){lo[0], lo[1], lo[2], lo[3], hi4[0], hi4[1], hi4[2], hi4[3]}; }
}
__device__ __forceinline__ void state_update(f32x4 (&S)[8], const bf16x8 (&vB)[2], const LAS unsigned char* lds, int g, int bt) {
#pragma unroll
    for (int kb = 0; kb < 8; ++kb) {
        const f32x4 d4 = *(const LAS f32x4*)(lds + DL + (16 * kb + 4 * g) * 4), e4 = *(const LAS f32x4*)(lds + EK + (16 * kb + 4 * g) * 4);
        f32x4 acc = {0.f, 0.f, 0.f, 0.f};
#pragma unroll
        for (int ks = 0; ks < 2; ++ks) {
            const LAS unsigned char* pa = lds + KT + (bt ^ ((kb ^ (2 * (ks & 1))) << 5)) + ks * 8192;
            const s16x4 lo = vtr(pa), hi4 = vtr(pa + 1024);
            const bf16x8 a = {lo[0], lo[1], lo[2], lo[3], hi4[0], hi4[1], hi4[2], hi4[3]};
            acc = __builtin_amdgcn_mfma_f32_16x16x32_bf16(a, vB[ks], acc, 0, 0, 0); }
        S[kb] = S[kb] * d4 + acc * e4; }
}
__device__ __forceinline__ f32x4* state_ptr(float* base, int chain, int slot) { return (f32x4*)(base + ((size_t)chain * NSLOT + slot) * STATE_SLOT_F); }

template <int MODE> __device__ __forceinline__ void phase1(LAS unsigned char* lds, const unsigned short* HGO, float* STATE, int G, int vcu) {
    const int tid = threadIdx.x, lane = tid & 63, wave = __builtin_amdgcn_readfirstlane(tid >> 6);
    const int kp = tid >> 3, seg = tid & 7;
    float* DEC = STATE + WS_DEC_OFF / 4;
    Bases B = make_bases(tid);
    constexpr int BUFB = 32768;
    for (int it = 0;; ++it) {
        const int u = it * G + vcu; if (u >= 512) break;
        int chain, pi; if (u < 448) { chain = u / 7; pi = 1 + u % 7; } else { chain = u - 448; pi = 0; }
        const int b = chain >> 4, h = (chain >> 1) & 7, dir = chain & 1;
        const int nch = pi == 0 ? 4 : 16;
        const int base = pi == 0 ? MLAT + b * CTX : b * SEQ + (dir == 0 ? pi - 1 : 8 - pi) * 1024;
        f32x4 S[8];
#pragma unroll
        for (int kb = 0; kb < 8; ++kb) S[kb] = (f32x4){0.f, 0.f, 0.f, 0.f};
        float carry[2] = {1.f, 1.f};
        unsigned krA[8], krB[8]; v4u vrA[2], vrB[2];
        auto issue = [&](int j, unsigned (&kraw)[8], v4u (&vraw)[2]) { const int cm = dir == 0 ? nch - 1 - j : j; const int row0 = base + cm * 64;
            const unsigned short* kb_ = HGO + (size_t)(row0 + 8 * seg) * 5120 + (3 + dir) * D + h * 128 + 2 * kp;
#pragma unroll
            for (int i = 0; i < 8; ++i) kraw[i] = *(const unsigned*)(kb_ + (size_t)i * 5120);
#pragma unroll
            for (int i = 0; i < 2; ++i) { const int p = tid + 512 * i; vraw[i] = *(const v4u*)(HGO + (size_t)(row0 + (p >> 4)) * 5120 + D + h * 128 + (p & 15) * 8); } };
        auto prep_store = [&](int buf, const unsigned (&kraw)[8], const v4u (&vraw)[2]) {
            if (MODE == 2) {
#pragma unroll
                for (int i = 0; i < 8; ++i) *(LAS unsigned*)(lds + buf * BUFB + (B.bp ^ ((i & 3) << 5)) + i * 256) = kraw[i];
#pragma unroll
                for (int i = 0; i < 2; ++i) *(LAS v4u*)(lds + buf * BUFB + 16384 + (B.bs ^ (i << 6)) + i * 8192) = vraw[i];
                return; }
            float kg[8][2], ex[8][2], tot[2];
#pragma unroll
            for (int i = 0; i < 8; ++i) { kg[i][0] = h2f((f16_t)(kraw[i] & 0xffffu)); kg[i][1] = h2f((f16_t)(kraw[i] >> 16)); }
#pragma unroll
            for (int ch = 0; ch < 2; ++ch) { float run = 1.f;
                if (dir == 0) {
#pragma unroll
                    for (int i = 7; i >= 0; --i) { ex[i][ch] = run; run *= 1.f - kg[i][ch]; }
                } else {
#pragma unroll
                    for (int i = 0; i < 8; ++i) { ex[i][ch] = run; run *= 1.f - kg[i][ch]; }
                }
                tot[ch] = run; }
#pragma unroll
            for (int ch = 0; ch < 2; ++ch) { float inc = tot[ch];
#pragma unroll
                for (int d = 1; d < 8; d <<= 1) { const float up = __shfl_up(inc, d, 8), dn = __shfl_down(inc, d, 8);
                    if (dir == 0) { if (seg + d < 8) inc *= dn; } else { if (seg >= d) inc *= up; } }
                const float nb = __shfl(inc, dir == 0 ? (seg + 1 < 8 ? seg + 1 : seg) : (seg >= 1 ? seg - 1 : seg), 8);
                const float off = (dir == 0 ? (seg + 1 < 8) : (seg >= 1)) ? nb * carry[ch] : carry[ch];
                carry[ch] *= __shfl(inc, dir == 0 ? 0 : 7, 8);
#pragma unroll
                for (int i = 0; i < 8; ++i) ex[i][ch] *= off; }
#pragma unroll
            for (int i = 0; i < 8; ++i)
                *(LAS unsigned*)(lds + buf * BUFB + (B.bp ^ ((i & 3) << 5)) + i * 256) = pg8::cvt_pk_bf16(kg[i][0] * ex[i][0], kg[i][1] * ex[i][1]);
#pragma unroll
            for (int i = 0; i < 2; ++i) *(LAS v4u*)(lds + buf * BUFB + 16384 + (B.bs ^ (i << 6)) + i * 8192) = vraw[i];
        };
        auto mma = [&](int buf) {
            const LAS unsigned char* kt = lds + buf * BUFB; const LAS unsigned char* vt = kt + 16384;
            bf16x8 vB[2];
#pragma unroll
            for (int ks = 0; ks < 2; ++ks) { const LAS unsigned char* pa = vt + (B.bt ^ ((wave ^ (2 * (ks & 1))) << 5)) + ks * 8192;
                const s16x4 lo = vtr(pa), hi4 = vtr(pa + 1024); vB[ks] = (bf16x8){lo[0], lo[1], lo[2], lo[3], hi4[0], hi4[1], hi4[2], hi4[3]}; }
#pragma unroll
            for (int kb = 0; kb < 8; ++kb)
#pragma unroll
                for (int ks = 0; ks < 2; ++ks) { const LAS unsigned char* pa = kt + (B.bt ^ ((kb ^ (2 * (ks & 1))) << 5)) + ks * 8192;
                    const s16x4 lo = vtr(pa), hi4 = vtr(pa + 1024);
                    const bf16x8 a = {lo[0], lo[1], lo[2], lo[3], hi4[0], hi4[1], hi4[2], hi4[3]};
                    S[kb] = __builtin_amdgcn_mfma_f32_16x16x32_bf16(a, vB[ks], S[kb], 0, 0, 0); }
        };
        HG_LAUNDER(B);
        issue(0, krA, vrA); issue(1, krB, vrB);
        HG_LBAR();
        prep_store(0, krA, vrA);
        issue(2, krA, vrA);
        HG_LBAR();
        for (int j = 0; j < nch; j += 2) {
            HG_LAUNDER(B);
            if (MODE != 1) mma(0);
            prep_store(1, krB, vrB); if (j + 3 < nch) issue(j + 3, krB, vrB);
            HG_LBAR();
            if (MODE != 1) mma(1);
            if (j + 2 < nch) { prep_store(0, krA, vrA); if (j + 4 < nch) issue(j + 4, krA, vrA); }
            HG_LBAR();
        }
        f32x4* sp = state_ptr(STATE, chain, pi) + (size_t)wave * 8 * 64 + lane;
#pragma unroll
        for (int kb = 0; kb < 8; ++kb) sp[kb * 64] = S[kb];
        if (seg == 0) { f32x2 d2; d2.x = carry[0]; d2.y = carry[1]; *(f32x2*)(DEC + ((size_t)chain * NSLOT + pi) * 128 + 2 * kp) = d2; }
    }
}
__device__ __forceinline__ void phase2(float* STATE, int G, int bx) {
    const float* DEC = STATE + WS_DEC_OFF / 4;
    for (int e = bx * 512 + (int)threadIdx.x; e < 64 * 4096; e += G * 512) {
        const int chain = e >> 12, r = e & 4095, kb = (r >> 6) & 7, lane = r & 63;
        f32x4* sp = state_ptr(STATE, chain, 0) + r;
        f32x4 run = sp[0];
#pragma unroll
        for (int i = 1; i < NSLOT; ++i) {
            f32x4 tmp = {0.f, 0.f, 0.f, 0.f}, d4 = {0.f, 0.f, 0.f, 0.f};
            if (i < NSLOT - 1) { tmp = sp[(size_t)i * 4096]; d4 = *(const f32x4*)(DEC + ((size_t)chain * NSLOT + i) * 128 + 16 * kb + 4 * (lane >> 4)); }
            sp[(size_t)i * 4096] = run;
            run = d4 * run + tmp;
        }
    }
}
constexpr int P3BUF = 58880, P3OT = 2 * P3BUF;
__device__ __forceinline__ void phase3(LAS unsigned char* lds, unsigned short* HGO, float* STATE, const float* norm_g, int G, int vcu, volatile LAS unsigned* tacc) {
    const int tid = threadIdx.x, lane = tid & 63, wave = __builtin_amdgcn_readfirstlane(tid >> 6), i16 = lane & 15, g = lane >> 4;
    Bases B = make_bases(tid);
    for (int it = 0;; ++it) {
        const int u = it * G + vcu; if (u >= 256) break;
        const int b = u >> 6, h = (u >> 3) & 7, j = u & 7;
        const int base = b * SEQ + j * 1024;
        for (int dir = 0; dir < 2; ++dir) {
            const int chain = (b * 8 + h) * 2 + dir, pi = dir == 0 ? j + 1 : 8 - j;
            f32x4 S[8];
            { const f32x4* sp = state_ptr(STATE, chain, pi) + (size_t)wave * 8 * 64 + lane;
#pragma unroll
              for (int kb = 0; kb < 8; ++kb) S[kb] = sp[kb * 64]; }
            auto chunk_of = [&](int ci) { return dir == 0 ? ci : 15 - ci; };
            auto intra = [&](LAS unsigned char* L) {
#pragma unroll
                for (int pp = 0; pp < 2; ++pp) { const int p = 2 * wave + pp, sb = p >> 2, tb = p & 3;
                    f32x4 acc = {0.f, 0.f, 0.f, 0.f};
                    const int tr = 16 * tb + i16;
#pragma unroll
                    for (int ks = 0; ks < 4; ++ks) {
                        const bf16x8 a = *(const LAS bf16x8*)(L + KT + (B.b0 ^ ((sb << 5) ^ (ks << 6))) + sb * 4096);
                        const bf16x8 bq = *(const LAS bf16x8*)(L + QT + (B.b0 ^ ((tb << 5) ^ (ks << 6))) + tb * 4096);
                        acc = __builtin_amdgcn_mfma_f32_16x16x32_bf16(a, bq, acc, 0, 0, 0); }
#pragma unroll
                    for (int reg = 0; reg < 4; ++reg) { const int s = 16 * sb + 4 * g + reg; const bool ok = dir == 0 ? (s <= tr) : (s >= tr); if (!ok) acc[reg] = 0.f; }
                    v2u w; w.x = pg8::cvt_pk_bf16(acc[0], acc[1]); w.y = pg8::cvt_pk_bf16(acc[2], acc[3]);
                    *(LAS v2u*)(L + AM + (B.bw ^ (sb << 5)) + tb * 2048) = w; }
            };
            auto main_state = [&](LAS unsigned char* L) {
                bf16x8 vB[2]; load_vB(vB, L, wave, B.bt);
                bf16x8 sB[4];
#pragma unroll
                for (int kk = 0; kk < 4; ++kk) {
                    const f32x4 ea = *(const LAS f32x4*)(L + EB + (32 * kk + 4 * g) * 4), eb = *(const LAS f32x4*)(L + EB + (32 * kk + 16 + 4 * g) * 4);
                    const f32x4 sa = S[2 * kk] * ea, sb2 = S[2 * kk + 1] * eb;
                    v4u w; w.x = pg8::cvt_pk_bf16(sa[0], sa[1]); w.y = pg8::cvt_pk_bf16(sa[2], sa[3]); w.z = pg8::cvt_pk_bf16(sb2[0], sb2[1]); w.w = pg8::cvt_pk_bf16(sb2[2], sb2[3]);
                    sB[kk] = __builtin_bit_cast(bf16x8, w); }
#pragma unroll
                for (int tb = 0; tb < 4; ++tb) { f32x4 acc = {0.f, 0.f, 0.f, 0.f};
#pragma unroll
                    for (int ks = 0; ks < 2; ++ks) { const bf16x8 a = *(const LAS bf16x8*)(L + AM + (B.ba ^ (ks << 6)) + tb * 2048);
                        acc = __builtin_amdgcn_mfma_f32_16x16x32_bf16(a, vB[ks], acc, 0, 0, 0); }
#pragma unroll
                    for (int kk = 0; kk < 4; ++kk) {
                        const v2u lo = *(const LAS v2u*)(L + QT + (B.bq ^ (((2 * kk) ^ tb) << 5)) + tb * 4096);
                        const v2u hi2 = *(const LAS v2u*)(L + QT + (B.bq ^ (((2 * kk + 1) ^ tb) << 5)) + tb * 4096);
                        v4u w; w.x = lo.x; w.y = lo.y; w.z = hi2.x; w.w = hi2.y;
                        acc = __builtin_amdgcn_mfma_f32_16x16x32_bf16(__builtin_bit_cast(bf16x8, w), sB[kk], acc, 0, 0, 0); }
#pragma unroll
                    for (int reg = 0; reg < 4; ++reg) *(LAS float*)(lds + P3OT + (B.bo ^ ((tb & 1) << 8)) + tb * 8192 + reg * 512) = acc[reg];
                }
                state_update(S, vB, L, g, B.bt);
            };
            v4u ofp[2], gp[2];
            auto output = [&](int row0) {
                const f32x4 ng0 = *(const f32x4*)(norm_g + 8 * (tid & 15)), ng1 = *(const f32x4*)(norm_g + 8 * (tid & 15) + 4);
                const int ob0 = (tid >> 4) * 512 + ((((tid & 15) >> 1) ^ wave) * 64) + (tid & 1) * 32;
#pragma unroll
                for (int i = 0; i < 2; ++i) { const int p = tid + 512 * i, row = p >> 4, c16 = p & 15;
                    const LAS unsigned char* op = lds + P3OT + ob0 + i * 16384;
                    f32x4 o0 = *(const LAS f32x4*)op, o1 = *(const LAS f32x4*)(op + 16);
                    unsigned short* dst = HGO + (size_t)(row0 + row) * 5120 + h * 128 + c16 * 8;
                    if (dir == 0) { *(v4u*)(dst + 3 * D) = pg8::pack8(o0, o1); }
                    else {
                        const v4u f = ofp[i], gg = gp[i];
#pragma unroll
                        for (int q2 = 0; q2 < 2; ++q2) { o0[2 * q2] += __builtin_bit_cast(float, f[q2] << 16); o0[2 * q2 + 1] += __builtin_bit_cast(float, f[q2] & 0xffff0000u);
                            o1[2 * q2] += __builtin_bit_cast(float, f[2 + q2] << 16); o1[2 * q2 + 1] += __builtin_bit_cast(float, f[2 + q2] & 0xffff0000u); }
                        float ss = pg8::sq4(o0) + pg8::sq4(o1);
                        ss += __shfl_xor(ss, 1); ss += __shfl_xor(ss, 2); ss += __shfl_xor(ss, 4); ss += __shfl_xor(ss, 8);
                        const float rinv = rsqrtf(ss * (1.f / 128.f) + EPS);
                        f32x4 g0, g1;
#pragma unroll
                        for (int q2 = 0; q2 < 2; ++q2) { g0[2 * q2] = __builtin_bit_cast(float, gg[q2] << 16); g0[2 * q2 + 1] = __builtin_bit_cast(float, gg[q2] & 0xffff0000u);
                            g1[2 * q2] = __builtin_bit_cast(float, gg[2 + q2] << 16); g1[2 * q2 + 1] = __builtin_bit_cast(float, gg[2 + q2] & 0xffff0000u); }
                        *(v4u*)dst = pg8::pack8(o0 * rinv * ng0 * g0, o1 * rinv * ng1 * g1);
                    }
                }
            };
            Stage st;
            HG_LAUNDER(B);
            stage_load<true>(st, HGO, base + chunk_of(0) * 64, h, dir, tid);
            stage_store2<true>(st, lds, B.bs);
            stage_load<true>(st, HGO, base + chunk_of(1) * 64, h, dir, tid);
            HG_LBAR();
            prep<true>(lds, dir, tid, B.bp);
            HG_LBAR();
            intra(lds);
            stage_store2<true>(st, lds + P3BUF, B.bs);
            stage_load<true>(st, HGO, base + chunk_of(2) * 64, h, dir, tid);
            HG_LBAR();
            for (int ci = 0; ci < 16; ++ci) {
                LAS unsigned char* Lm = lds + (ci & 1) * P3BUF; LAS unsigned char* Ln = lds + ((ci & 1) ^ 1) * P3BUF;
                const int row0 = base + chunk_of(ci) * 64;
                HG_LAUNDER(B);
                const unsigned tp0 = tacc ? (unsigned)__builtin_amdgcn_s_memrealtime() : 0u;
                if (dir == 1) {
#pragma unroll
                    for (int i = 0; i < 2; ++i) { const int p = tid + 512 * i; const unsigned short* src = HGO + (size_t)(row0 + (p >> 4)) * 5120 + h * 128 + (p & 15) * 8;
                        ofp[i] = *(const v4u*)(src + 3 * D); gp[i] = *(const v4u*)(src + 2 * D); }
                }
                if (ci + 1 < 16) prep<true>(Ln, dir, tid, B.bp);
                main_state(Lm);
                HG_LBAR();
                const unsigned tp1 = tacc ? (unsigned)__builtin_amdgcn_s_memrealtime() : 0u;
                if (ci + 1 < 16) intra(Ln);
                output(row0);
                if (ci + 2 < 16) { stage_store2<true>(st, Lm, B.bs); if (ci + 3 < 16) stage_load<true>(st, HGO, base + chunk_of(ci + 3) * 64, h, dir, tid); }
                HG_LBAR();
                if (tacc && tid == 0) { const unsigned tp2 = (unsigned)__builtin_amdgcn_s_memrealtime(); tacc[0] += tp1 - tp0; tacc[1] += tp2 - tp1; }
            }
            HG_BAR();
        }
    }
}
}


constexpr int NWAVES = 8;
constexpr int RING_BYTES = 131072, LDS_BYTES = 163840, MISC_OFF = LDS_BYTES - 512;
typedef GAS unsigned gu32;
#define LDS_WAIT() asm volatile("s_waitcnt lgkmcnt(0)" ::: "memory")
#define VM_WAIT() asm volatile("s_waitcnt vmcnt(0)" ::: "memory")
__device__ __forceinline__ float wave_sum(float v) {
#pragma unroll
    for (int o = 1; o < 64; o <<= 1) v += __shfl_xor(v, o);
    return v;
}
#ifndef PROBE_MASK
#define PROBE_MASK 0u
#endif
#define PROBE_MUL 2u
struct Args { const float* in[19]; float* out; unsigned char* ws; int ph_lo, ph_hi; };

template <class PermF> __device__ __forceinline__ void p0_transpose_item(const float* W, int K, int N, bf16_t* WT, int k0, int n0, PermF perm, LAS float* scr, int lane) {
#pragma unroll 16
    for (int kk = 0; kk < 64; ++kk) scr[kk * 65 + lane] = W[(size_t)(k0 + kk) * N + n0 + lane];
    LDS_WAIT(); asm volatile("" ::: "memory");
    const int c = lane & 7;
#pragma unroll
    for (int j = 0; j < 8; ++j) { const int n = (lane >> 3) + 8 * j; const LAS float* s = scr + (8 * c) * 65 + n;
        v4u o; o.x = pk2(s[0 * 65], s[1 * 65]); o.y = pk2(s[2 * 65], s[3 * 65]); o.z = pk2(s[4 * 65], s[5 * 65]); o.w = pk2(s[6 * 65], s[7 * 65]);
        const int drow = perm(n0 + (n & ~31)) + (n & 31);
        *(v4u*)(WT + (size_t)drow * K + k0 + 8 * c) = o; }
    LDS_WAIT(); asm volatile("" ::: "memory");
}
__device__ __forceinline__ int perm_qkv(int n0) { const int t = n0 & 255, wc = t >> 6, bj = (t >> 5) & 1; return (n0 & ~255) + 128 * bj + 32 * wc; }
__device__ __forceinline__ int perm_ffn(int n0) { const int bj = n0 >= DFF ? 1 : 0, c = n0 - bj * DFF; return (c >> 7) * 256 + bj * 128 + (c & 127); }

__device__ __forceinline__ void naive_attn_item(const bf16_t* QKV, const float* rpb, bf16_t* O, int idx) {
    const int h = idx & 15, row = idx >> 4;
    float q[64], o[64]; float m = -INFINITY, l = 0.f;
    { const bf16_t* qp = QKV + (size_t)row * 3072 + h * 64;
#pragma unroll
      for (int i = 0; i < 64; ++i) { q[i] = bf2f(qp[i]); o[i] = 0.f; } }
    const int b = row_batch(row);
    auto visit = [&](int krow, float bias) {
        const bf16_t* kp = QKV + (size_t)krow * 3072 + D + h * 64; const bf16_t* vp = kp + D;
        float s = 0.f;
#pragma unroll
        for (int i = 0; i < 64; ++i) s += q[i] * bf2f(kp[i]);
        s += bias;
        const float mn = fmaxf(m, s), f = __expf(m - mn), p = __expf(s - mn);
        l = l * f + p;
#pragma unroll
        for (int i = 0; i < 64; ++i) o[i] = o[i] * f + p * bf2f(vp[i]);
        m = mn;
    };
    if (row < MLAT) {
        const int t = row & (SEQ - 1), r = t >> 6, c = t & 63;
        int rs = r - 4; rs = rs < 0 ? 0 : (rs > ROWS - 8 ? ROWS - 8 : rs);
        int cs = c - 8; cs = cs < 0 ? 0 : (cs > GW - 16 ? GW - 16 : cs);
        for (int j = 0; j < 8; ++j)
            for (int w = 0; w < 16; ++w) {
                const int kr = rs + j, kc = cs + w;
                visit(b * SEQ + kr * GW + kc, rpb[(h * 15 + (kr - r + 7)) * 31 + (kc - c + 15)]);
            }
    }
    for (int kk = 0; kk < CTX; ++kk) visit(MLAT + b * CTX + kk, 0.f);
    const float rl = 1.f / l;
    bf16_t* op = O + (size_t)row * D + h * 64;
#pragma unroll
    for (int i = 0; i < 64; ++i) op[i] = f2bf(o[i] * rl);
}
__device__ __forceinline__ void naive_hgscan(unsigned short* HGO, const float* norm_g, int bh, LAS float* sm) {
    LAS float (*sq)[128] = (LAS float (*)[128])sm; LAS float (*sk)[128] = (LAS float (*)[128])(sm + 256); LAS float (*red)[2] = (LAS float (*)[2])(sm + 512);
    const int b = bh >> 3, h = bh & 7, v = threadIdx.x & 127; const bool act = threadIdx.x < 128;
    const int NS = CTX + SEQ;
    const float ng = norm_g[v];
    for (int dir = 0; dir < 2; ++dir) {
        float S[128];
#pragma unroll
        for (int k = 0; k < 128; ++k) S[k] = 0.f;
        auto rowof = [&](int step) { int row; if (step < CTX) { const int j = dir == 0 ? step : CTX - 1 - step; row = MLAT + b * CTX + j; } else { const int t = dir == 0 ? step - CTX : SEQ - 1 - (step - CTX); row = b * SEQ + t; } return row; };
        { const int row = rowof(0); const unsigned short* p = HGO + (size_t)row * 5120 + h * 128;
          if (act) { sq[0][v] = bf2f(p[v]); sk[0][v] = h2f(p[(3 + dir) * D + v]); } }
        __syncthreads();
        for (int step = 0; step < NS; ++step) {
            const int cur = step & 1, row = rowof(step);
            unsigned short* p = HGO + (size_t)row * 5120 + h * 128;
            const float vv = bf2f(p[D + v]);
            if (step + 1 < NS) { const int rn = rowof(step + 1); const unsigned short* pn = HGO + (size_t)rn * 5120 + h * 128;
                if (act) { sq[cur ^ 1][v] = bf2f(pn[v]); sk[cur ^ 1][v] = h2f(pn[(3 + dir) * D + v]); } }
            float o = 0.f;
#pragma unroll
            for (int k = 0; k < 128; ++k) { const float kk = sk[cur][k]; S[k] = (1.f - kk) * S[k] + kk * vv; o += sq[cur][k] * S[k]; }
            if (row < MLAT) {
                if (dir == 0) { if (act) p[3 * D + v] = f2bf(o); }
                else {
                    const float ot = o + bf2f(p[3 * D + v]);
                    float ss = ot * ot;
#pragma unroll
                    for (int off = 1; off < 64; off <<= 1) ss += __shfl_xor(ss, off);
                    if (act && (v & 63) == 0) red[cur][v >> 6] = ss;
                    __syncthreads();
                    const float tot = red[cur][0] + red[cur][1];
                    const float rinv = rsqrtf(tot * (1.f / 128.f) + EPS);
                    const float gv = bf2f(p[2 * D + v]);
                    if (act) p[v] = f2bf(ot * rinv * ng * gv);
                }
            }
            __syncthreads();
        }
    }
}


template <int SET> __device__ __forceinline__ void convert_weights(const Args& a, unsigned char* ws, LAS unsigned char* lds, int w, int nw, int lane) {
    const float* w_qkv = a.in[8]; const float* w_o = a.in[9]; const float* hg_w_in = a.in[13]; const float* hg_w_o = a.in[16]; const float* ffn_w_in = a.in[17]; const float* ffn_w_out = a.in[18];
    bf16_t* Wqkv_t = (bf16_t*)(ws + WS_WQKV); bf16_t* Wo0_t = (bf16_t*)(ws + WS_WO0); bf16_t* Whgin_t = (bf16_t*)(ws + WS_WHGIN); bf16_t* Whgo_t = (bf16_t*)(ws + WS_WHGO);
    bf16_t* Wfin0_t = (bf16_t*)(ws + WS_WFIN0); bf16_t* Wfin1_t = (bf16_t*)(ws + WS_WFIN1); bf16_t* Wfout0_t = (bf16_t*)(ws + WS_WFOUT0); bf16_t* Wfout1_t = (bf16_t*)(ws + WS_WFOUT1);
    LAS float* scr = (LAS float*)(lds + (threadIdx.x >> 6) * 16896);
    constexpr int I_QKV = 16 * 48, I_O = 16 * 16, I_HGIN = 16 * 80, I_FIN = 16 * 88, I_FOUT = 44 * 16;
    auto ident = [](int n) { return n; };
    auto pq = [](int n) { return perm_qkv(n); };
    auto pf = [](int n) { return perm_ffn(n); };
    if (SET == 0) {
        for (int r = w; r < I_QKV; r += nw) { const int kb = r / 48, nb = r % 48; p0_transpose_item(w_qkv, D, 3 * D, Wqkv_t, kb * 64, nb * 64, pq, scr, lane); }
    } else if (SET == 1) {
        for (int it = w; it < I_O + I_FIN + I_FOUT; it += nw) { int r = it;
            if (r < I_O) { const int kb = r / 16, nb = r % 16; p0_transpose_item(w_o, D, D, Wo0_t, kb * 64, nb * 64, ident, scr, lane); continue; } r -= I_O;
            if (r < I_FIN) { const int kb = r / 88, nb = r % 88; p0_transpose_item(ffn_w_in, D, 2 * DFF, Wfin0_t, kb * 64, nb * 64, pf, scr, lane); continue; } r -= I_FIN;
            { const int kb = r / 16, nb = r % 16; p0_transpose_item(ffn_w_out, DFF, D, Wfout0_t, kb * 64, nb * 64, ident, scr, lane); } }
    } else {
        for (int it = w; it < I_HGIN + I_O + I_FIN + I_FOUT; it += nw) { int r = it;
            if (r < I_HGIN) { const int kb = r / 80, nb = r % 80; p0_transpose_item(hg_w_in, D, 5 * D, Whgin_t, kb * 64, nb * 64, ident, scr, lane); continue; } r -= I_HGIN;
            if (r < I_O) { const int kb = r / 16, nb = r % 16; p0_transpose_item(hg_w_o, D, D, Whgo_t, kb * 64, nb * 64, ident, scr, lane); continue; } r -= I_O;
            if (r < I_FIN) { const int kb = r / 88, nb = r % 88; p0_transpose_item(ffn_w_in + (size_t)D * 2 * DFF, D, 2 * DFF, Wfin1_t, kb * 64, nb * 64, pf, scr, lane); continue; } r -= I_FIN;
            { const int kb = r / 16, nb = r % 16; p0_transpose_item(ffn_w_out + (size_t)DFF * D, DFF, D, Wfout1_t, kb * 64, nb * 64, ident, scr, lane); } }
    }
}
__device__ __forceinline__ void bias_gemv(const bf16_t* Bt, int N, const float* sh, float* dst, int w, int nw, int lane) {
    for (int n = w; n < N; n += nw) {
        const v4u* wp = (const v4u*)(Bt + (size_t)n * D + lane * 16); const v4u w0 = wp[0], w1 = wp[1];
        float wf[16];
#pragma unroll
        for (int j = 0; j < 4; ++j) { wf[2 * j] = __builtin_bit_cast(float, w0[j] << 16); wf[2 * j + 1] = __builtin_bit_cast(float, w0[j] & 0xffff0000u);
            wf[8 + 2 * j] = __builtin_bit_cast(float, w1[j] << 16); wf[8 + 2 * j + 1] = __builtin_bit_cast(float, w1[j] & 0xffff0000u); }
#pragma unroll
        for (int s = 0; s < 5; ++s) { const f32x4* sp = (const f32x4*)(sh + (size_t)s * 6 * D + lane * 16); float t = 0.f;
#pragma unroll
            for (int q = 0; q < 4; ++q) { const f32x4 sv = sp[q]; t += (sv[0] * wf[4 * q] + sv[1] * wf[4 * q + 1]) + (sv[2] * wf[4 * q + 2] + sv[3] * wf[4 * q + 3]); }
            t = wave_sum(t); if (lane == 0) dst[(size_t)s * N + n] = t; }
    }
}

__global__ void __launch_bounds__(NWAVES * 64, 2) mega(Args a) {
    extern __shared__ __attribute__((aligned(16))) unsigned char lds_raw[];
    LAS unsigned char* lds = (LAS unsigned char*)lds_raw;
    volatile LAS unsigned* MISC = (volatile LAS unsigned*)(lds + MISC_OFF);
    const int tid = threadIdx.x, lane = tid & 63, wave = __builtin_amdgcn_readfirstlane(tid >> 6);
    const int G = gridDim.x, bx = blockIdx.x;
    const int vcu = (G % 8 == 0) ? (bx % 8) * (G / 8) + bx / 8 : bx;
    unsigned char* ws = a.ws;
    const float* x = a.in[0]; const float* cvec = a.in[1]; const float* ctx = a.in[2]; const float* c_ctx = a.in[3];
    const float* ada_w = a.in[4]; const float* ada_b = a.in[5]; const float* norm1_g = a.in[6]; const float* norm2_g = a.in[7];
    const float* w_qkv = a.in[8]; const float* w_o = a.in[9]; const float* q_gain = a.in[10]; const float* k_gain = a.in[11];
    const float* hg_w_in = a.in[13]; const float* hg_lower = a.in[14];
    const float* hg_w_o = a.in[16]; const float* ffn_w_in = a.in[17]; const float* ffn_w_out = a.in[18];
    float* out = a.out;
    float* mod = (float*)(ws + WS_MOD); float* lbp = (float*)(ws + WS_LB); float* Gv = (float*)(ws + WS_GV);
    float* bias_f0 = (float*)(ws + WS_BIAS_F0); float* bias_hg = (float*)(ws + WS_BIAS_HG); float* bias_f1 = (float*)(ws + WS_BIAS_F1);
    float* part = (float*)(ws + WS_PART); bf16_t* XCTX = (bf16_t*)(ws + WS_XCTX);
    bf16_t* XRES = (bf16_t*)out;
    bf16_t* Wqkv_t = (bf16_t*)(ws + WS_WQKV); bf16_t* Wo0_t = (bf16_t*)(ws + WS_WO0); bf16_t* Whgin_t = (bf16_t*)(ws + WS_WHGIN); bf16_t* Whgo_t = (bf16_t*)(ws + WS_WHGO);
    bf16_t* Wfin0_t = (bf16_t*)(ws + WS_WFIN0); bf16_t* Wfin1_t = (bf16_t*)(ws + WS_WFIN1); bf16_t* Wfout0_t = (bf16_t*)(ws + WS_WFOUT0); bf16_t* Wfout1_t = (bf16_t*)(ws + WS_WFOUT1);
    bf16_t* ABUF = (bf16_t*)(ws + WS_ABUF); bf16_t* R1 = (bf16_t*)(ws + WS_R1);
    bf16_t* X3 = R1 + 3840;

    for (int u = tid; u < 512 / 4; u += NWAVES * 64) ((LAS unsigned*)(lds + MISC_OFF))[u] = 0u;
    __syncthreads();
    XcdBarrier bar = xcd_barrier_post((unsigned*)(ws + WS_CTL) + 1024, MISC + 8);
    const int lo = a.ph_lo, hi = a.ph_hi;
#define IN(k) (lo <= (k) && (k) < hi)
#ifndef BAR_REPEAT
#define BAR_REPEAT 1
#endif
#define SEAM(k) do { if (IN(k) && IN((k) + 1)) for (int br_ = 0; br_ < BAR_REPEAT; ++br_) xcd_barrier(bar); if (PROBE_MASK && bx == 0 && tid == 0) MISC[17 + (k)] = (unsigned)__builtin_amdgcn_s_memrealtime(); } while (0)
    if (PROBE_MASK && bx == 0 && tid == 0) MISC[16] = (unsigned)__builtin_amdgcn_s_memrealtime();

    if (IN(0)) {
        if (bx < 192) {
            LAS float* sv = (LAS float*)lds; LAS float* red = (LAS float*)(lds + 20480);
            const int l = bx / 96, cb = bx % 96;
            for (int i = tid; i < 5 * D; i += 512) { const int s = i >> 10, k = i & 1023; const float v = s < 4 ? cvec[s * D + k] : c_ctx[k]; sv[i] = silu_f(v); }
            __syncthreads();
            const int col = tid & 63, kg = tid >> 6;
            float acc[5] = {0.f, 0.f, 0.f, 0.f, 0.f};
            const float* w = ada_w + (size_t)l * D * 6 * D + cb * 64 + col;
            for (int k0 = kg * 128; k0 < kg * 128 + 128; k0 += 32) {
                float wv[32];
#pragma unroll
                for (int q = 0; q < 32; ++q) wv[q] = w[(size_t)(k0 + q) * 6 * D];
#pragma unroll
                for (int q = 0; q < 32; ++q)
#pragma unroll
                    for (int s = 0; s < 5; ++s) acc[s] += sv[s * D + k0 + q] * wv[q]; }
#pragma unroll
            for (int s = 0; s < 5; ++s) red[(kg * 5 + s) * 64 + col] = acc[s];
            __syncthreads();
            if (tid < 320) { const int s = tid >> 6, c2 = tid & 63; float t = 0.f;
#pragma unroll
                for (int k2 = 0; k2 < 8; ++k2) t += red[(k2 * 5 + s) * 64 + c2];
                mod[((size_t)l * 5 + s) * 6 * D + cb * 64 + c2] = t + ada_b[l * 6 * D + cb * 64 + c2]; }
            __syncthreads();
        } else if (bx < 196) { const int i = (bx - 192) * 512 + tid; lbp[i] = sigmoid_f(hg_lower[2 * D + i] - hg_lower[i]); }
        convert_weights<0>(a, ws, lds, vcu * NWAVES + wave, G * NWAVES, lane);
    }
    SEAM(0);
    if (IN(1)) {
        const int gw = vcu * NWAVES + wave, NGW = G * NWAVES;
        na::build_bias_table((float*)(ws + WS_BTAB), a.in[12], G, bx);
        { const int i = bx * 512 + tid;
          if (i < 2 * 2 * 5 * D) { const int col = i & 1023, s = (i >> 10) % 5, w = (i / (5 * D)) & 1, l = i / (10 * D);
              Gv[i] = (w == 0 ? norm1_g : norm2_g)[l * D + col] * (1.f + mod[((size_t)l * 5 + s) * 6 * D + (w == 0 ? 1 : 4) * D + col]); } }
        LAS float* tA = (LAS float*)lds; LAS float* tB = (LAS float*)(lds + 20480);
        for (int i = tid; i < 5 * D; i += 512) { const int s5 = i >> 10, col = i & 1023; const float* mp = mod + (size_t)s5 * 6 * D;
            tA[i] = norm1_g[col] * (1.f + mp[D + col]); tB[i] = mp[col]; }
        __syncthreads();
        for (int row0 = gw; row0 < MTOT; row0 += 2 * NGW) {
            const int row1 = row0 + NGW; const bool has1 = row1 < MTOT; const int r1 = has1 ? row1 : row0;
            const float* xr0 = row0 < MLAT ? x + (size_t)row0 * D : ctx + (size_t)(row0 - MLAT) * D;
            const float* xr1 = r1 < MLAT ? x + (size_t)r1 * D : ctx + (size_t)(r1 - MLAT) * D;
            f32x4 v0[4], v1[4]; float ss0 = 0.f, ss1 = 0.f;
#pragma unroll
            for (int j = 0; j < 4; ++j) { v0[j] = ((const f32x4*)xr0)[lane + 64 * j]; v1[j] = ((const f32x4*)xr1)[lane + 64 * j]; }
#pragma unroll
            for (int j = 0; j < 4; ++j) { ss0 += pg8::sq4(v0[j]); ss1 += pg8::sq4(v1[j]); }
            const float ri0 = rsqrtf(wave_sum(ss0) * (1.f / D) + EPS), ri1 = rsqrtf(wave_sum(ss1) * (1.f / D) + EPS);
            const int s0 = row_slot(row0), s1 = row_slot(r1);
#pragma unroll
            for (int j = 0; j < 4; ++j) { const int col = 4 * lane + 256 * j;
                { const f32x4 y = (v0[j] * ri0) * *(const LAS f32x4*)(tA + s0 * D + col) + *(const LAS f32x4*)(tB + s0 * D + col);
                  v2u o; o.x = pk2(y[0], y[1]); o.y = pk2(y[2], y[3]); *(v2u*)(ABUF + (size_t)row0 * D + col) = o; }
                if (has1) { const f32x4 y = (v1[j] * ri1) * *(const LAS f32x4*)(tA + s1 * D + col) + *(const LAS f32x4*)(tB + s1 * D + col);
                  v2u o; o.x = pk2(y[0], y[1]); o.y = pk2(y[2], y[3]); *(v2u*)(ABUF + (size_t)row1 * D + col) = o; }
            }
        }
    }
    SEAM(1);
    const float* mod0 = mod; const float* mod1 = mod + 5 * 6 * D;
#define COMMA ,
#define GEMM_ALL(EPI, Aptr, Btptr, N_, K_, lda_, ...) do { \
        pg8::Gemm g_{Aptr, Btptr, MTOT, N_, K_, lda_, 0, 0}; pg8::StaticOrder S1_; S1_.init(MTOT, N_, G, bx); EPI E1_{__VA_ARGS__}; \
        pg8::gemm_phase<EPI, pg8::StaticOrder, true, true>(lds, g_, S1_, E1_); } while (0)
#define GEMM_LAT_CTX(EPI, Aptr, Btptr, N_, K_, lda_, S_, phase, ...) do { \
        pg8::Gemm g_{Aptr, Btptr, MLAT, N_, K_, lda_, 0, 0}; pg8::StaticOrder S1_; S1_.init(MLAT, N_, G, bx); EPI E1_{__VA_ARGS__}; \
        pg8::gemm_phase<EPI, pg8::StaticOrder, true, true>(lds, g_, S1_, E1_); \
        pg8::CtxTaskOrder S2_; S2_.init(N_, S_, bx); \
        pg8::Gemm g2_{Aptr, Btptr, MTOT, N_, K_, lda_, (K_) / 64 / (S_), (bx % (S_)) * ((K_) / (S_))}; \
        pg8::EpiSplit<EPI, S_> E2_{{__VA_ARGS__}, slab, scnt + (phase) * 128, sflag, bx}; \
        pg8::gemm_phase<pg8::EpiSplit<EPI, S_>, pg8::CtxTaskOrder, true, true>(lds, g2_, S2_, E2_); } while (0)
    float* slab = (float*)(ws + WS_STATE); unsigned* scnt = (unsigned*)(ws + WS_CTL) + 8192; LAS unsigned* sflag = (LAS unsigned*)(lds + MISC_OFF + 256);
    if (IN(2)) {
        GEMM_ALL(pg8::EpiQKV, ABUF, Wqkv_t, 3 * D, D, D, R1, q_gain, k_gain, 0.125f);
        { constexpr int NL = (MTOT / 256) * 12 % 256; if (G == 256 && bx >= NL) convert_weights<1>(a, ws, lds, (bx - NL) * NWAVES + wave, (G - NL) * NWAVES, lane);
          else if (G != 256) convert_weights<1>(a, ws, lds, bx * NWAVES + wave, G * NWAVES, lane); }
    }
    SEAM(2);
#ifndef ATTN_PROBE
#define ATTN_PROBE -1
#endif
    if (IN(3)) {
        if (ATTN_PROBE >= 0) { na::attn_phase<(ATTN_PROBE < 0 ? 0 : ATTN_PROBE)>(lds, R1, (const float*)(ws + WS_BTAB), q_gain, k_gain, (bf16_t*)(ws + 330 * MiB), G, vcu); __syncthreads(); }
        na::attn_phase<0>(lds, R1, (const float*)(ws + WS_BTAB), q_gain, k_gain, ABUF, G, vcu);
    }
    SEAM(3);
    if (IN(4)) {
        pg8::Gemm g{ABUF, Wo0_t, MTOT, D, D, D, 0, 0}; pg8::StaticOrder S; S.init(MTOT, D, G, bx);
        pg8::fill_res_tables(lds + RING_BYTES, S, mod0 + 2 * D, Gv + (0 * 2 + 1) * 5 * D);
        pg8::EpiRes<false, true> E{x, ctx, XRES, XCTX, lds + RING_BYTES, true, R1, part, D, D, 0};
        pg8::gemm_phase<pg8::EpiRes<false, true>, pg8::StaticOrder, true, true>(lds, g, S, E);
        { constexpr int NL = (MTOT / 256) * 4 % 256; const int w_ = G == 256 ? (bx - NL) * NWAVES + wave : bx * NWAVES + wave, nw_ = G == 256 ? (G - NL) * NWAVES : G * NWAVES;
          if (G != 256 || bx >= NL) { convert_weights<2>(a, ws, lds, w_, nw_, lane); bias_gemv(Wfin0_t, 2 * DFF, mod0 + 3 * D, bias_f0, w_, nw_, lane); } }
    }
    SEAM(4);
    bf16_t* A2 = R1; bf16_t* HID = R1 + (size_t)MTOT * D;
    if (IN(5)) {
        pg8::Gemm g{A2, Wfin0_t, MTOT, 2 * DFF, D, D, 0, 0}; pg8::StaticOrder S; S.init(MTOT, 2 * DFF, G, bx);
        pg8::fill_epi_tables(lds + RING_BYTES, S, part, bias_f0, 2 * DFF);
        pg8::EpiSwiglu E{lds + RING_BYTES, HID, DFF, 0};
        pg8::gemm_phase<pg8::EpiSwiglu, pg8::StaticOrder, true, true>(lds, g, S, E);
    }
    SEAM(5);
    if (IN(6)) {
        pg8::Gemm g{HID, Wfout0_t, MTOT, D, DFF, DFF, 0, 0}; pg8::StaticOrder S; S.init(MTOT, D, G, bx);
        pg8::fill_res_tables(lds + RING_BYTES, S, mod0 + 5 * D, Gv + (1 * 2 + 0) * 5 * D);
        pg8::EpiRes<true, true> E{XRES, XCTX, XRES, XCTX, lds + RING_BYTES, true, ABUF, part, D, D, 0};
        pg8::gemm_phase<pg8::EpiRes<true, true>, pg8::StaticOrder, true, true>(lds, g, S, E);
        { constexpr int NL = (MTOT / 256) * 4 % 256; const int w_ = G == 256 ? (bx - NL) * NWAVES + wave : bx * NWAVES + wave, nw_ = G == 256 ? (G - NL) * NWAVES : G * NWAVES;
          if (G != 256 || bx >= NL) { bias_gemv(Whgin_t, 5 * D, mod1, bias_hg, w_, nw_, lane); bias_gemv(Wfin1_t, 2 * DFF, mod1 + 3 * D, bias_f1, w_, nw_, lane); } }
    }
    SEAM(6);
    if (IN(7)) {
        pg8::Gemm g{ABUF, Whgin_t, MTOT, 5 * D, D, D, 0, 0}; pg8::StaticOrder S; S.init(MTOT, 5 * D, G, bx);
        pg8::fill_epi_tables(lds + RING_BYTES, S, part, bias_hg, 5 * D);
        pg8::EpiHg E{lds + RING_BYTES, R1, lbp, 0};
        pg8::gemm_phase<pg8::EpiHg, pg8::StaticOrder, true, true>(lds, g, S, E);
    }
    SEAM(7);
    float* STATE = (float*)(ws + WS_STATE);
#ifndef HG1_PROBE
#define HG1_PROBE -1
#endif
    if (IN(8)) { if (HG1_PROBE >= 0) { hg::phase1<(HG1_PROBE < 0 ? 0 : HG1_PROBE)>(lds, R1, STATE, G, vcu); __syncthreads(); } hg::phase1<0>(lds, R1, STATE, G, vcu); }
    SEAM(8);
    if (IN(9)) { hg::phase2(STATE, G, bx); }
    SEAM(9);
    if (IN(10)) { hg::phase3(lds, R1, STATE, a.in[15], G, vcu, (PROBE_MASK >> 14) && bx == 0 ? MISC + 48 : (volatile LAS unsigned*)nullptr); }
    SEAM(10);
    if (IN(11)) {
        pg8::Gemm g{R1, Whgo_t, MLAT, D, D, 5 * D, 0, 0}; pg8::StaticOrder S; S.init(MLAT, D, G, bx);
        pg8::fill_res_tables(lds + RING_BYTES, S, mod1 + 2 * D, Gv + (1 * 2 + 1) * 5 * D);
        pg8::EpiRes<true, true> E{XRES, XCTX, X3, XCTX, lds + RING_BYTES, true, ABUF, part, D, 5 * D, 0};
        pg8::gemm_phase<pg8::EpiRes<true, true>, pg8::StaticOrder, true, true>(lds, g, S, E);
    }
    SEAM(11);
    if (IN(12)) {
        pg8::Gemm g{ABUF, Wfin1_t, MLAT, 2 * DFF, D, D, 0, 0}; pg8::StaticOrder S; S.init(MLAT, 2 * DFF, G, bx);
        pg8::fill_epi_tables(lds + RING_BYTES, S, part, bias_f1, 2 * DFF);
        pg8::EpiSwiglu E{lds + RING_BYTES, R1 + D, 5 * D, 0};
        pg8::gemm_phase<pg8::EpiSwiglu, pg8::StaticOrder, true, true>(lds, g, S, E);
    }
    SEAM(12);
    if (IN(13)) {
        pg8::Gemm g{R1 + D, Wfout1_t, MLAT, D, DFF, 5 * D, 0, 0}; pg8::StaticOrder S; S.init(MLAT, D, G, bx);
        pg8::fill_res_tables(lds + RING_BYTES, S, mod1 + 5 * D, (const float*)nullptr);
        pg8::EpiRes<true, false> E{X3, XCTX, out, XCTX, lds + RING_BYTES, false, nullptr, nullptr, 5 * D, D, 0};
        pg8::gemm_phase<pg8::EpiRes<true, false>, pg8::StaticOrder, true, true>(lds, g, S, E);
    }
    if (PROBE_MASK && bx == 0 && tid == 0) {
        MISC[17 + 13] = (unsigned)__builtin_amdgcn_s_memrealtime();
        unsigned extra = 0;
        for (int k = 0; k < 14; ++k) if ((PROBE_MASK >> k) & 1u) extra += MISC[17 + k] - MISC[16 + k];
        if ((PROBE_MASK >> 14) & 1u) extra += MISC[48];
        if ((PROBE_MASK >> 15) & 1u) extra += MISC[49];
        const unsigned t0 = (unsigned)__builtin_amdgcn_s_memrealtime();
        while ((unsigned)__builtin_amdgcn_s_memrealtime() - t0 < extra * PROBE_MUL) __builtin_amdgcn_s_sleep(8);
    }
#undef IN
#undef SEAM
}

extern "C" void kernel_launch(void* const* d_in, const int* in_sizes, int n_in, void* d_out, int out_size, void* d_ws, size_t ws_size, hipStream_t stream) {
    static int grid = 0;
    if (grid == 0) {
        if (n_in != 19 || out_size != MLAT * D || ws_size < WS_END) { fprintf(stderr, "kernel_launch: unexpected sizes n_in %d out %d ws %zu\n", n_in, out_size, ws_size); grid = -1; return; }
        int dev = 0, cus = 0, per_cu = 0;
        if (hipGetDevice(&dev) != hipSuccess || hipDeviceGetAttribute(&cus, hipDeviceAttributeMultiprocessorCount, dev) != hipSuccess) { grid = -1; return; }
        if (hipFuncSetAttribute((const void*)mega, hipFuncAttributeMaxDynamicSharedMemorySize, LDS_BYTES) != hipSuccess) { fprintf(stderr, "kernel_launch: hipFuncSetAttribute failed\n"); grid = -1; return; }
        if (hipOccupancyMaxActiveBlocksPerMultiprocessor(&per_cu, (const void*)mega, NWAVES * 64, LDS_BYTES) != hipSuccess || per_cu < 1) { fprintf(stderr, "kernel_launch: occupancy query says %d blocks per CU\n", per_cu); grid = -1; (void)hipGetLastError(); return; }
        (void)hipGetLastError();
        grid = cus;
    }
    if (grid < 0) return;
    (void)hipMemsetAsync((char*)d_ws + WS_CTL, 0, CTL_ZERO_BYTES, stream);
    Args a{};
    for (int i = 0; i < 19; ++i) a.in[i] = (const float*)d_in[i];
    a.out = (float*)d_out; a.ws = (unsigned char*)d_ws;
    auto run = [&](int lo, int hi) { a.ph_lo = lo; a.ph_hi = hi; hipLaunchKernelGGL(mega, dim3(grid), dim3(NWAVES * 64), LDS_BYTES, stream, a); };
    run(0, 14);
}
```

```cpp
#include <hip/hip_runtime.h>
#include <cstdint>
#include <cstdio>
#include <type_traits>

constexpr int D = 1024, BATCH = 4, SEQ = 8192, CTX = 256, MLAT = BATCH * SEQ, MCTX = BATCH * CTX, MTOT = MLAT + MCTX;
constexpr int DFF = 2816, NAH = 16, HGH = 8, GW = 64, ROWS = SEQ / GW;
constexpr float EPS = 1e-6f;
typedef unsigned short bf16_t;
typedef unsigned short f16_t;
#define GAS __attribute__((address_space(1)))
#define LAS __attribute__((address_space(3)))
typedef unsigned v4u __attribute__((ext_vector_type(4)));
typedef unsigned v2u __attribute__((ext_vector_type(2)));
typedef float f32x4 __attribute__((ext_vector_type(4)));
typedef float f32x2 __attribute__((ext_vector_type(2)));
typedef _Float16 h16x2 __attribute__((ext_vector_type(2)));

__device__ __forceinline__ bf16_t f2bf(float f) { unsigned u = __builtin_bit_cast(unsigned, f); return (bf16_t)((u + 0x7fffu + ((u >> 16) & 1u)) >> 16); }
__device__ __forceinline__ float bf2f(bf16_t h) { return __builtin_bit_cast(float, (unsigned)h << 16); }
__device__ __forceinline__ f16_t f2h(float f) { _Float16 h = (_Float16)f; return __builtin_bit_cast(unsigned short, h); }
__device__ __forceinline__ float h2f(f16_t u) { return (float)__builtin_bit_cast(_Float16, u); }
__device__ __forceinline__ unsigned pk2(float lo, float hi) { return (unsigned)f2bf(lo) | ((unsigned)f2bf(hi) << 16); }
__device__ __forceinline__ unsigned pk_h2(float lo, float hi) { f32x2 v = {lo, hi}; h16x2 h = __builtin_convertvector(v, h16x2); return __builtin_bit_cast(unsigned, h); }
__device__ __forceinline__ float silu_f(float x) { return x / (1.f + __expf(-x)); }
__device__ __forceinline__ float sigmoid_f(float x) { return 1.f / (1.f + __expf(-x)); }
__device__ __forceinline__ float fast_sigmoid(float x) { return __builtin_amdgcn_rcpf(1.f + __builtin_amdgcn_exp2f(-1.4426950408889634f * x)); }
__device__ __forceinline__ float fast_silu(float x) { return x * fast_sigmoid(x); }
__device__ __forceinline__ int row_slot(int row) { return row < MLAT ? (row >> 13) : 4; }
__device__ __forceinline__ int row_batch(int row) { return row < MLAT ? (row >> 13) : ((row - MLAT) >> 8); }

constexpr size_t MiB = 1u << 20, KiB = 1024;
constexpr size_t WS_CTL = 0, CTL_ZERO_BYTES = 64 * KiB;
constexpr size_t WS_MOD = 64 * KiB;
constexpr size_t WS_LB = 320 * KiB;
constexpr size_t WS_GV = 336 * KiB;
constexpr size_t WS_BIAS_F0 = 448 * KiB;
constexpr size_t WS_BIAS_HG = 576 * KiB;
constexpr size_t WS_BIAS_F1 = 704 * KiB;
constexpr size_t WS_PART = 1 * MiB;
constexpr size_t WS_XCTX = 4 * MiB;
constexpr size_t WS_WQKV = 8 * MiB, WS_WO0 = 14 * MiB, WS_WHGIN = 16 * MiB, WS_WHGO = 26 * MiB;
constexpr size_t WS_WFIN0 = 28 * MiB, WS_WFIN1 = 39 * MiB, WS_WFOUT0 = 50 * MiB, WS_WFOUT1 = 50 * MiB + 5632 * KiB;
constexpr size_t WS_ABUF = 62 * MiB;
constexpr size_t WS_R1 = 128 * MiB;
constexpr size_t WS_STATE = 458 * MiB;
constexpr size_t WS_BTAB = 496 * MiB;
constexpr size_t WS_END = 512 * MiB;
static_assert(WS_WFOUT1 + (size_t)D * DFF * 2 <= WS_ABUF && WS_ABUF + (size_t)MTOT * D * 2 <= WS_R1 && WS_R1 + (size_t)MTOT * 5120 * 2 <= WS_STATE, "ws map");
static_assert(WS_PART + (size_t)MTOT * 16 * 4 <= WS_XCTX && WS_BIAS_F1 + 5 * 5632 * 4 <= WS_PART && WS_MOD + 2 * 5 * 6144 * 4 <= WS_LB, "ws map small");

namespace pg8 {
#define PG8_LAS __attribute__((address_space(3)))
typedef short bf16x8 __attribute__((ext_vector_type(8)));
typedef unsigned u32x4 __attribute__((ext_vector_type(4)));
constexpr int BM = 256, BK = 64, HALF = 128, HTB = HALF * BK * 2  , STAGE_BYTES = 8 * HTB, NXCD = 8, WGM = 8;

__host__ __device__ __forceinline__ int lds_byte(int r, int c) { const int st = (r >> 4) * 2 + (c >> 5), rr = r & 15, cc = c & 31, ob = rr * 64 + cc * 2; return st * 1024 + (ob ^ (((ob >> 9) & 1) << 5)); }
__host__ __device__ __forceinline__ void stage_rc(int b, int& R, int& C) { const int st = b / 1024, sb = b % 1024, swz = sb ^ (((sb >> 9) & 1) << 5); R = (st >> 1) * 16 + swz / 64; C = (st & 1) * 32 + (swz % 64) / 2; }
__host__ __device__ __forceinline__ int perm32(int rho) { const int n = rho >> 4, i = rho & 15; return 8 * (i >> 2) + 4 * n + (i & 3); }

struct Unit { int pm, pn; };
struct Gemm { const bf16_t* A; const bf16_t* Bt; int M, N, K, lda, nt, koff; };

struct StaticOrder {
    int nM, nN, nwg, G, c;
    __host__ __device__ void init(int M, int N, int G_, int c_) { nM = M / BM; nN = N / BM; nwg = nM * nN; G = G_; c = c_; }
    __host__ __device__ bool next(int i, Unit& u) const {
        const long L = (long)i * G + c; if (L >= nwg) return false;
        int wgid = (int)L; { const int q = nwg / NXCD, r = nwg % NXCD, xcd = wgid % NXCD, off = wgid / NXCD; wgid = (xcd < r ? xcd * (q + 1) : r * (q + 1) + (xcd - r) * q) + off; }
        const int nig = WGM * nN, gid = wgid / nig, fm = gid * WGM, gsz = (nM - fm) < WGM ? (nM - fm) : WGM;
        u.pm = fm + ((wgid % nig) % gsz); u.pn = (wgid % nig) / gsz; return true;
    }
    __device__ __forceinline__ void a_ready(const Unit&) const {}
    __device__ __forceinline__ void done(const Unit&) const {}
};
__device__ __forceinline__ unsigned cvt_pk_bf16(float lo, float hi) { unsigned r; asm volatile("v_cvt_pk_bf16_f32 %0, %1, %2" : "=v"(r) : "v"(lo), "v"(hi)); return r; }

struct CtxTaskOrder {
    int S, ntasks, c;
    __device__ void init(int N, int S_, int c_) { S = S_; ntasks = 4 * (N / BM) * S_; c = c_; }
    __device__ bool next(int i, Unit& u) const { if (i != 0 || c >= ntasks) return false; const int unit = c / S; u.pm = MLAT / BM + (unit & 3); u.pn = unit >> 2; return true; }
    __device__ __forceinline__ void a_ready(const Unit&) const {}
    __device__ __forceinline__ void done(const Unit&) const {}
};
template <class Epi, int S> struct EpiSplit {
    static constexpr bool PERM = Epi::PERM, AFTER_DRAIN = false;
    Epi inner; float* slab; unsigned* cnt; PG8_LAS unsigned* flag; int task;
    __device__ __forceinline__ void operator()(const f32x4 (&acc_c)[2][2][4][2], const Unit& u, int wr, int wc, int fr, int fq) const {
        f32x4 (&acc)[2][2][4][2] = const_cast<f32x4 (&)[2][2][4][2]>(acc_c);
        const int tid = threadIdx.x;
        f32x4* sp = (f32x4*)slab + (size_t)task * 32 * 512 + tid;
#pragma unroll
        for (int i = 0; i < 32; ++i) { const f32x4 v = acc[i >> 4][(i >> 3) & 1][(i >> 1) & 3][i & 1]; f32x4* q = sp + i * 512;
            asm volatile("global_store_dwordx4 %0, %1, off sc1\n\ts_nop 1" :: "v"(q), "v"(v) : "memory"); }
        asm volatile("s_waitcnt vmcnt(0) lgkmcnt(0)" ::: "memory"); __builtin_amdgcn_s_barrier(); asm volatile("" ::: "memory");
        if (tid == 0) *flag = __hip_atomic_fetch_add(cnt + task / S, 1u, __ATOMIC_RELAXED, __HIP_MEMORY_SCOPE_AGENT);
        asm volatile("s_waitcnt vmcnt(0) lgkmcnt(0)" ::: "memory"); __builtin_amdgcn_s_barrier(); asm volatile("" ::: "memory");
        const unsigned ticket = *flag;
        if (ticket + 1u != (unsigned)S) return;
        if (tid == 0) { __builtin_amdgcn_fence(__ATOMIC_ACQUIRE, "agent"); asm volatile("s_waitcnt vmcnt(0)" ::: "memory"); }
        asm volatile("s_waitcnt vmcnt(0) lgkmcnt(0)" ::: "memory"); __builtin_amdgcn_s_barrier(); asm volatile("" ::: "memory");
        f32x4* rp = (f32x4*)slab + (size_t)(task - task % S) * 32 * 512 + tid;
#pragma unroll 1
        for (int c8 = 0; c8 < 4; ++c8) {
            f32x4 t[8];
#pragma unroll
            for (int i = 0; i < 8; ++i) t[i] = rp[(size_t)(c8 * 8 + i) * 512];
#pragma unroll
            for (int s = 1; s < S; ++s)
#pragma unroll
                for (int i = 0; i < 8; ++i) t[i] += rp[((size_t)s * 32 + c8 * 8 + i) * 512];
#pragma unroll
            for (int i = 0; i < 8; ++i) rp[(size_t)(c8 * 8 + i) * 512] = t[i];
        }
        asm volatile("s_waitcnt vmcnt(0)" ::: "memory");
#pragma unroll
        for (int i = 0; i < 32; ++i) acc[i >> 4][(i >> 3) & 1][(i >> 1) & 3][i & 1] = rp[(size_t)i * 512];
        inner(acc, u, wr, wc, fr, fq);
    }
};

__device__ __forceinline__ float quad_sum(float s) { s += __shfl_xor(s, 16); s += __shfl_xor(s, 32); return s; }
__device__ __forceinline__ float sq4(f32x4 v) { return (v[0] * v[0] + v[1] * v[1]) + (v[2] * v[2] + v[3] * v[3]); }
__device__ __forceinline__ u32x4 pack8(f32x4 a, f32x4 b) { u32x4 w; w.x = cvt_pk_bf16(a[0], a[1]); w.y = cvt_pk_bf16(a[2], a[3]); w.z = cvt_pk_bf16(b[0], b[1]); w.w = cvt_pk_bf16(b[2], b[3]); return w; }
__device__ __forceinline__ float row_rinv(const float* part, int row) {
    const f32x4* p = (const f32x4*)(part + (size_t)row * 16); const f32x4 a = p[0], b = p[1], c = p[2], d = p[3];
    const float s = ((a[0] + a[1]) + (a[2] + a[3])) + ((b[0] + b[1]) + (b[2] + b[3])) + ((c[0] + c[1]) + (c[2] + c[3])) + ((d[0] + d[1]) + (d[2] + d[3]));
    return rsqrtf(s * (1.f / D) + EPS);
}

struct EpiQKV {
    static constexpr bool PERM = true, AFTER_DRAIN = false;
    bf16_t* QKV; const float* qg; const float* kg; float qscale;
    __device__ __forceinline__ void operator()(const f32x4 (&acc)[2][2][4][2], const Unit& u, int wr, int wc, int fr, int fq) const {
        const int type = u.pn >> 2, head = (u.pn & 3) * 4 + wc;
        const int row0 = u.pm * BM + wr * 64 + fr;
        bf16_t* base = QKV + (size_t)type * D + head * 64 + 8 * fq;
        f32x4 gv[2][2];
        if (type < 2) { const float* gp = (type == 0 ? qg : kg) + 8 * fq;
#pragma unroll
            for (int bj = 0; bj < 2; ++bj)
#pragma unroll
                for (int n = 0; n < 2; ++n) gv[bj][n] = *(const f32x4*)(gp + 32 * bj + 4 * n); }
        const float sc = type == 0 ? qscale : 1.f;
#pragma unroll
        for (int ai = 0; ai < 2; ++ai)
#pragma unroll
            for (int m = 0; m < 4; ++m) {
                bf16_t* rowp = base + (size_t)(row0 + ai * HALF + m * 16) * 3072;
                f32x4 v00 = acc[ai][0][m][0], v01 = acc[ai][0][m][1], v10 = acc[ai][1][m][0], v11 = acc[ai][1][m][1];
                if (type < 2) {
                    const float ss = quad_sum((sq4(v00) + sq4(v01)) + (sq4(v10) + sq4(v11)));
                    const float r = rsqrtf(ss * (1.f / 64.f) + EPS) * sc;
                    v00 = v00 * r * gv[0][0]; v01 = v01 * r * gv[0][1]; v10 = v10 * r * gv[1][0]; v11 = v11 * r * gv[1][1];
                }
                *(u32x4*)(rowp) = pack8(v00, v01); *(u32x4*)(rowp + 32) = pack8(v10, v11);
            }
    }
};
template <class Sched> __device__ __forceinline__ void fill_res_tables(PG8_LAS unsigned char* tab, const Sched& S, const float* gate, const float* Gn) {
    const int tid = threadIdx.x; Unit u;
    for (int i = 0; i < 8 && S.next(i, u); ++i) {
        const bool lat = u.pm < MLAT / BM; const int slot = lat ? (u.pm >> 5) : 4;
        if (tid < 256) *(PG8_LAS float*)(tab + i * 1024 + tid * 4) = gate[(size_t)slot * 6 * D + u.pn * BM + tid];
        else *(PG8_LAS float*)(tab + 16384 + i * 1024 + (tid - 256) * 4) = Gn ? Gn[(size_t)slot * D + u.pn * BM + (tid - 256)] : 0.f;
    }
    asm volatile("s_waitcnt vmcnt(0) lgkmcnt(0)" ::: "memory"); __builtin_amdgcn_s_barrier(); asm volatile("" ::: "memory");
}
template <bool RES_BF16, bool OUT_BF16> struct EpiRes {
    static constexpr bool PERM = true, AFTER_DRAIN = false;
    const void* res_lat; const void* res_ctx; void* out_lat; void* out_ctx; PG8_LAS unsigned char* tab; bool has_gn; bf16_t* Aout; float* part; int ldr, ldo; mutable int seq;
    __device__ __forceinline__ void operator()(const f32x4 (&acc)[2][2][4][2], const Unit& u, int wr, int wc, int fr, int fq) const {
        const bool lat = u.pm < MLAT / BM;
        const size_t trow = lat ? (size_t)u.pm * BM : (size_t)u.pm * BM - MLAT; const size_t pr = lat ? ldr : D, po = lat ? ldo : D;
        const int cl = wc * 32 + 8 * fq, col0 = u.pn * BM + cl;
        const PG8_LAS unsigned char* tg = tab + seq * 1024 + cl * 4; const PG8_LAS unsigned char* tn = tab + 16384 + seq * 1024 + cl * 4; ++seq;
        f32x4 gt[2][2], gn[2][2];
#pragma unroll
        for (int bj = 0; bj < 2; ++bj)
#pragma unroll
            for (int n = 0; n < 2; ++n) { gt[bj][n] = *(const PG8_LAS f32x4*)(tg + bj * HALF * 4 + 16 * n); gn[bj][n] = *(const PG8_LAS f32x4*)(tn + bj * HALF * 4 + 16 * n); }
        const char* rl_ = (const char*)res_lat; const char* rc_ = (const char*)res_ctx; char* ol_ = (char*)out_lat; char* oc_ = (char*)out_ctx;
        asm volatile("" : "+s"(rl_), "+s"(rc_), "+s"(ol_), "+s"(oc_));
        const char* rbase = lat ? rl_ : rc_; char* obase = lat ? ol_ : oc_;
        constexpr int MB = RES_BF16 ? 4 : 2;
#pragma unroll
        for (int ai = 0; ai < 2; ++ai)
#pragma unroll
        for (int m0 = 0; m0 < 4; m0 += MB) {
            u32x4 rb[MB][2]; f32x4 rf[MB][2][2];
#pragma unroll
            for (int mm = 0; mm < MB; ++mm) { const size_t offr = (trow + wr * 64 + ai * HALF + (m0 + mm) * 16 + fr) * pr + col0;
#pragma unroll
                for (int bj = 0; bj < 2; ++bj) {
                    if (RES_BF16) rb[mm][bj] = *(const u32x4*)((const bf16_t*)rbase + offr + bj * HALF);
                    else { const float* rp = (const float*)rbase + offr + bj * HALF; rf[mm][bj][0] = *(const f32x4*)rp; rf[mm][bj][1] = *(const f32x4*)(rp + 4); } } }
#pragma unroll
            for (int mm = 0; mm < MB; ++mm) { const int m = m0 + mm;
                const int r = wr * 64 + ai * HALF + m * 16 + fr; const size_t offo = (trow + r) * po + col0;
                f32x4 x[2][2]; float ss = 0.f;
#pragma unroll
                for (int bj = 0; bj < 2; ++bj) {
                    f32x4 r0, r1;
                    if (RES_BF16) { const u32x4 w = rb[mm][bj];
                        r0 = (f32x4){__builtin_bit_cast(float, w.x << 16), __builtin_bit_cast(float, w.x & 0xffff0000u), __builtin_bit_cast(float, w.y << 16), __builtin_bit_cast(float, w.y & 0xffff0000u)};
                        r1 = (f32x4){__builtin_bit_cast(float, w.z << 16), __builtin_bit_cast(float, w.z & 0xffff0000u), __builtin_bit_cast(float, w.w << 16), __builtin_bit_cast(float, w.w & 0xffff0000u)}; }
                    else { r0 = rf[mm][bj][0]; r1 = rf[mm][bj][1]; }
                    x[bj][0] = r0 + gt[bj][0] * acc[ai][bj][m][0]; x[bj][1] = r1 + gt[bj][1] * acc[ai][bj][m][1];
                    if (OUT_BF16) *(u32x4*)((bf16_t*)obase + offo + bj * HALF) = pack8(x[bj][0], x[bj][1]);
                    else { float* op = (float*)obase + offo + bj * HALF; *(f32x4*)op = x[bj][0]; *(f32x4*)(op + 4) = x[bj][1]; }
                    ss += sq4(x[bj][0]) + sq4(x[bj][1]);
                }
                if (has_gn) {
                    ss = quad_sum(ss);
                    const size_t grow = (size_t)u.pm * BM + r;
                    if (fq == 0) part[grow * 16 + u.pn * 4 + wc] = ss;
                    bf16_t* ap = Aout + grow * D + col0;
                    *(u32x4*)(ap) = pack8(x[0][0] * gn[0][0], x[0][1] * gn[0][1]); *(u32x4*)(ap + HALF) = pack8(x[1][0] * gn[1][0], x[1][1] * gn[1][1]);
                }
            }
            asm volatile("" ::: "memory");
        }
    }
};
constexpr int EPI_TAB_UNITS = 14;
template <class Sched> __device__ __forceinline__ void fill_epi_tables(PG8_LAS unsigned char* tab, const Sched& S, const float* part, const float* bias, int bias_ld) {
    const int tid = threadIdx.x; Unit u;
    for (int i = 0; i < EPI_TAB_UNITS && S.next(i, u); ++i) {
        const bool lat = u.pm < MLAT / BM; const int slot = lat ? (u.pm >> 5) : 4;
        if (tid < 256) *(PG8_LAS float*)(tab + i * 1024 + tid * 4) = row_rinv(part, u.pm * BM + tid);
        else *(PG8_LAS float*)(tab + 16384 + i * 1024 + (tid - 256) * 4) = bias[(size_t)slot * bias_ld + u.pn * BM + (tid - 256)];
    }
    asm volatile("s_waitcnt vmcnt(0) lgkmcnt(0)" ::: "memory"); __builtin_amdgcn_s_barrier(); asm volatile("" ::: "memory");
}
struct EpiSwiglu {
    static constexpr bool PERM = true, AFTER_DRAIN = false;
    PG8_LAS unsigned char* tab; bf16_t* HID; int ldh; mutable int seq;
    __device__ __forceinline__ void operator()(const f32x4 (&acc)[2][2][4][2], const Unit& u, int wr, int wc, int fr, int fq) const {
        const int c0 = wc * 32 + 8 * fq;
        const PG8_LAS unsigned char* tr = tab + seq * 1024; const PG8_LAS unsigned char* tb = tab + 16384 + seq * 1024 + c0 * 4; ++seq;
        f32x4 ba[2], bu[2];
#pragma unroll
        for (int n = 0; n < 2; ++n) { ba[n] = *(const PG8_LAS f32x4*)(tb + 16 * n); bu[n] = *(const PG8_LAS f32x4*)(tb + HALF * 4 + 16 * n); }
#pragma unroll
        for (int ai = 0; ai < 2; ++ai)
#pragma unroll
            for (int m = 0; m < 4; ++m) {
                const int rl = wr * 64 + ai * HALF + m * 16 + fr, row = u.pm * BM + rl;
                const float rinv = *(const PG8_LAS float*)(tr + rl * 4);
                f32x4 h[2];
#pragma unroll
                for (int n = 0; n < 2; ++n) { const f32x4 a = acc[ai][0][m][n] * rinv + ba[n], uu = acc[ai][1][m][n] * rinv + bu[n];
#pragma unroll
                    for (int j = 0; j < 4; ++j) h[n][j] = fast_silu(a[j]) * uu[j]; }
                *(u32x4*)(HID + (size_t)row * ldh + u.pn * HALF + c0) = pack8(h[0], h[1]);
            }
    }
};
struct EpiHg {
    static constexpr bool PERM = true, AFTER_DRAIN = false;
    PG8_LAS unsigned char* tab; unsigned short* HGO; const float* lb; mutable int seq;
    __device__ __forceinline__ void operator()(const f32x4 (&acc)[2][2][4][2], const Unit& u, int wr, int wc, int fr, int fq) const {
        const int type = u.pn >> 2, col0 = u.pn * BM + wc * 32 + 8 * fq;
        const PG8_LAS unsigned char* tr = tab + seq * 1024; const PG8_LAS unsigned char* tb = tab + 16384 + seq * 1024 + (wc * 32 + 8 * fq) * 4; ++seq;
        f32x4 bv[2][2], lbv[2][2];
#pragma unroll
        for (int bj = 0; bj < 2; ++bj)
#pragma unroll
            for (int n = 0; n < 2; ++n) { bv[bj][n] = *(const PG8_LAS f32x4*)(tb + bj * HALF * 4 + 16 * n);
                lbv[bj][n] = type >= 3 ? *(const f32x4*)(lb + (col0 - 3 * D) + bj * HALF + 4 * n) : (f32x4){0.f, 0.f, 0.f, 0.f}; }
#pragma unroll
        for (int ai = 0; ai < 2; ++ai)
#pragma unroll
            for (int m = 0; m < 4; ++m) {
                const int rl = wr * 64 + ai * HALF + m * 16 + fr, row = u.pm * BM + rl;
                const float rinv = *(const PG8_LAS float*)(tr + rl * 4);
#pragma unroll
                for (int bj = 0; bj < 2; ++bj) {
                    f32x4 v0 = acc[ai][bj][m][0] * rinv + bv[bj][0], v1 = acc[ai][bj][m][1] * rinv + bv[bj][1]; u32x4 w;
                    if (type == 1) w = pack8(v0, v1);
                    else if (type < 3) {
#pragma unroll
                        for (int j = 0; j < 4; ++j) { v0[j] = fast_silu(v0[j]); v1[j] = fast_silu(v1[j]); }
                        w = pack8(v0, v1);
                    } else {
#pragma unroll
                        for (int j = 0; j < 4; ++j) { v0[j] = (1.f - lbv[bj][0][j]) * fast_sigmoid(-v0[j]); v1[j] = (1.f - lbv[bj][1][j]) * fast_sigmoid(-v1[j]); }
                        w.x = pk_h2(v0[0], v0[1]); w.y = pk_h2(v0[2], v0[3]); w.z = pk_h2(v1[0], v1[1]); w.w = pk_h2(v1[2], v1[3]);
                    }
                    *(u32x4*)(HGO + (size_t)type * MTOT * D + (size_t)row * D + (col0 & (D - 1)) + bj * HALF) = w;
                }
            }
    }
};

template <class Epi, class Sched, bool ALIGN_EPI = false, bool SP2 = false>
__device__ __forceinline__ void gemm_phase(PG8_LAS unsigned char* lds, const Gemm g, const Sched& S, const Epi& E) {
    const int tid = threadIdx.x, wid = __builtin_amdgcn_readfirstlane(tid >> 6), lane = tid & 63, wr = wid >> 2, wc = wid & 3, fr = lane & 15, fq = lane >> 4;
    const int K = g.K, nt = g.nt ? g.nt : K / BK;
    unsigned voffA[2], voffB[2];
#pragma unroll
    for (int i = 0; i < 2; ++i) { int R, C; stage_rc(tid * 16 + i * 8192, R, C); const int Rb = Epi::PERM ? ((R & ~31) + perm32(R & 31)) : R;
        voffA[i] = (unsigned)(R * g.lda + C) * 2u; voffB[i] = (unsigned)(Rb * K + C) * 2u; }
    const size_t kstep = (size_t)(BK * 2);
    const size_t hsA = (size_t)HALF * g.lda * 2, hsB = (size_t)HALF * K * 2;
    const size_t tsA = 2 * hsA, tsB = 2 * hsB;
    const unsigned ldsw = (unsigned)wid * 1024u;
    const int aoff = lds_byte(wr * 64 + fr, fq * 8), boff = lds_byte(wc * 32 + fr, fq * 8);
#define PG8_SA(b, h) (((b) * 2 + (h)) * HTB)
#define PG8_SB(b, h) ((4 + (b) * 2 + (h)) * HTB)
#define PG8_STAGE(bufoff, gbase, voff) do { _Pragma("unroll") for (int _i = 0; _i < 2; ++_i) \
        __builtin_amdgcn_global_load_lds((const unsigned*)((const char*)(gbase) + (voff)[_i]), (PG8_LAS unsigned*)(lds + (bufoff) + ldsw + _i * 8192), 16, 0, 0); } while (0)
#define PG8_LDA(dst, b, h) do { _Pragma("unroll") for (int m = 0; m < 4; ++m) _Pragma("unroll") for (int k = 0; k < 2; ++k) dst[m][k] = *(const PG8_LAS bf16x8*)(lds + PG8_SA(b, h) + aoff + m * 2048 + k * 1024); } while (0)
#define PG8_LDB(dst, b, h) do { _Pragma("unroll") for (int n = 0; n < 2; ++n) _Pragma("unroll") for (int k = 0; k < 2; ++k) dst[n][k] = *(const PG8_LAS bf16x8*)(lds + PG8_SB(b, h) + boff + n * 2048 + k * 1024); } while (0)
#define PG8_MMA(ai, bj, At, Bt) do { __builtin_amdgcn_s_setprio(1); _Pragma("unroll") for (int m = 0; m < 4; ++m) _Pragma("unroll") for (int n = 0; n < 2; ++n) _Pragma("unroll") for (int k = 0; k < 2; ++k) \
        acc[ai][bj][m][n] = __builtin_amdgcn_mfma_f32_16x16x32_bf16(Bt[n][k], At[m][k], acc[ai][bj][m][n], 0, 0, 0); __builtin_amdgcn_s_setprio(0); } while (0)
#define PG8_WAIT_V(n) asm volatile("s_waitcnt vmcnt(" #n ")" ::: "memory")
#define PG8_WAIT_L(n) asm volatile("s_waitcnt lgkmcnt(" #n ")" ::: "memory")
#define PG8_BAR __builtin_amdgcn_s_barrier()
#define PG8_SCHED __builtin_amdgcn_sched_barrier(0)
    Unit cur, nxt; int ui = 0;
    if (!S.next(0, cur)) return;
    f32x4 acc[2][2][4][2];
#pragma unroll
    for (int a = 0; a < 2; ++a)
#pragma unroll
        for (int b = 0; b < 2; ++b)
#pragma unroll
            for (int m = 0; m < 4; ++m)
#pragma unroll
                for (int n = 0; n < 2; ++n) acc[a][b][m][n] = (f32x4){0.f, 0.f, 0.f, 0.f};
    bf16x8 At[4][2], B0[2][2], B1[2][2];
    const char* cA = (const char*)g.A + (size_t)cur.pm * tsA + (size_t)g.koff * 2; const char* cB = (const char*)g.Bt + (size_t)cur.pn * tsB + (size_t)g.koff * 2;
    S.a_ready(cur);
    if constexpr (SP2) {
        PG8_STAGE(PG8_SB(0, 0), cB, voffB); PG8_STAGE(PG8_SB(0, 1), cB + hsB, voffB); PG8_STAGE(PG8_SA(0, 0), cA, voffA); PG8_STAGE(PG8_SA(0, 1), cA + hsA, voffA);
        if (wr == 1) PG8_BAR;
        PG8_WAIT_V(2); PG8_BAR;
        PG8_STAGE(PG8_SB(1, 0), cB + kstep, voffB); PG8_STAGE(PG8_SA(1, 0), cA + kstep, voffA); PG8_STAGE(PG8_SB(1, 1), cB + hsB + kstep, voffB);
        PG8_WAIT_V(6); PG8_BAR;
    } else {
        PG8_STAGE(PG8_SB(0, 0), cB, voffB); PG8_STAGE(PG8_SA(0, 0), cA, voffA); PG8_STAGE(PG8_SB(0, 1), cB + hsB, voffB); PG8_STAGE(PG8_SA(0, 1), cA + hsA, voffA);
        if (wr == 1) PG8_BAR;
        PG8_WAIT_V(4); PG8_BAR;
        PG8_STAGE(PG8_SB(1, 0), cB + kstep, voffB); PG8_STAGE(PG8_SA(1, 0), cA + kstep, voffA); PG8_STAGE(PG8_SB(1, 1), cB + hsB + kstep, voffB);
        PG8_WAIT_V(6); PG8_BAR;
    }
    for (;;) {
        const bool has_next = S.next(ui + 1, nxt);
        const char* nA = has_next ? (const char*)g.A + (size_t)nxt.pm * tsA + (size_t)g.koff * 2 : cA; const char* nB = has_next ? (const char*)g.Bt + (size_t)nxt.pn * tsB + (size_t)g.koff * 2 : cB;
        for (int t = 0; t < nt; t += 2) {
            const bool last = (t == nt - 2);
            const char* a1 = cA + (size_t)(t + 1) * kstep;
            const char* a2 = last ? nA : cA + (size_t)(t + 2) * kstep; const char* b2 = last ? nB : cB + (size_t)(t + 2) * kstep;
            const char* a3 = a2 + kstep; const char* b3 = b2 + kstep;
            if (last && has_next) S.a_ready(nxt);
            if constexpr (SP2) {
            PG8_LDB(B0, 0, 0); PG8_LDB(B1, 0, 1); PG8_SCHED; PG8_LDA(At, 0, 0); PG8_STAGE(PG8_SA(1, 1), a1 + hsA, voffA);
            PG8_WAIT_V(8); PG8_WAIT_L(0); PG8_BAR; PG8_MMA(0, 0, At, B0); PG8_MMA(0, 1, At, B1); PG8_BAR; PG8_SCHED;
            PG8_LDA(At, 0, 1); PG8_STAGE(PG8_SB(0, 0), b2, voffB); PG8_STAGE(PG8_SB(0, 1), b2 + hsB, voffB); PG8_STAGE(PG8_SA(0, 0), a2, voffA);
            PG8_WAIT_V(8); PG8_WAIT_L(0); PG8_BAR; PG8_MMA(1, 0, At, B0); PG8_MMA(1, 1, At, B1); PG8_BAR; PG8_SCHED;
            PG8_LDB(B0, 1, 0); PG8_LDB(B1, 1, 1); PG8_SCHED; PG8_LDA(At, 1, 0); PG8_STAGE(PG8_SA(0, 1), a2 + hsA, voffA);
            PG8_WAIT_V(8); PG8_WAIT_L(0); PG8_BAR; PG8_MMA(0, 0, At, B0); PG8_MMA(0, 1, At, B1); PG8_BAR; PG8_SCHED;
            PG8_LDA(At, 1, 1); PG8_STAGE(PG8_SB(1, 0), b3, voffB); PG8_STAGE(PG8_SB(1, 1), b3 + hsB, voffB); PG8_STAGE(PG8_SA(1, 0), a3, voffA);
            PG8_WAIT_V(8); PG8_WAIT_L(0); PG8_BAR; PG8_MMA(1, 0, At, B0); PG8_MMA(1, 1, At, B1); PG8_BAR; PG8_SCHED;
            } else {
            PG8_LDB(B0, 0, 0); PG8_SCHED; PG8_LDA(At, 0, 0); PG8_STAGE(PG8_SA(1, 1), a1 + hsA, voffA);
            PG8_WAIT_L(8); PG8_BAR; PG8_WAIT_L(0); PG8_MMA(0, 0, At, B0); PG8_BAR; PG8_SCHED;
            PG8_LDB(B1, 0, 1); PG8_STAGE(PG8_SB(0, 0), b2, voffB);
            PG8_BAR; PG8_WAIT_L(0); PG8_MMA(0, 1, At, B1); PG8_BAR;
            PG8_LDA(At, 0, 1); PG8_STAGE(PG8_SA(0, 0), a2, voffA);
            PG8_BAR; PG8_WAIT_L(0); PG8_MMA(1, 0, At, B0); PG8_BAR; PG8_SCHED;
            PG8_STAGE(PG8_SB(0, 1), b2 + hsB, voffB);
            PG8_WAIT_V(6); PG8_BAR; PG8_MMA(1, 1, At, B1); PG8_BAR;
            PG8_LDB(B0, 1, 0); PG8_SCHED; PG8_LDA(At, 1, 0); PG8_STAGE(PG8_SA(0, 1), a2 + hsA, voffA);
            PG8_WAIT_L(8); PG8_BAR; PG8_WAIT_L(0); PG8_MMA(0, 0, At, B0); PG8_BAR; PG8_SCHED;
            PG8_LDB(B1, 1, 1); PG8_STAGE(PG8_SB(1, 0), b3, voffB);
            PG8_BAR; PG8_WAIT_L(0); PG8_MMA(0, 1, At, B1); PG8_BAR;
            PG8_LDA(At, 1, 1); PG8_STAGE(PG8_SA(1, 0), a3, voffA);
            PG8_BAR; PG8_WAIT_L(0); PG8_MMA(1, 0, At, B0); PG8_BAR; PG8_SCHED;
            PG8_STAGE(PG8_SB(1, 1), b3 + hsB, voffB);
            PG8_WAIT_V(6); PG8_BAR; PG8_MMA(1, 1, At, B1); PG8_BAR;
            }
        }
        if constexpr (ALIGN_EPI) { if (wr == 0) PG8_BAR; }
        if constexpr (!Epi::AFTER_DRAIN) { E(acc, cur, wr, wc, fr, fq); S.done(cur); }
        if (!has_next) break;
#pragma unroll
        for (int a = 0; a < 2; ++a)
#pragma unroll
            for (int b = 0; b < 2; ++b)
#pragma unroll
                for (int m = 0; m < 4; ++m)
#pragma unroll
                    for (int n = 0; n < 2; ++n) acc[a][b][m][n] = (f32x4){0.f, 0.f, 0.f, 0.f};
        cur = nxt; cA = nA; cB = nB; ++ui;
        if constexpr (ALIGN_EPI) { if (wr == 1) PG8_BAR; }
    }
    PG8_WAIT_V(0);
    if constexpr (!ALIGN_EPI) { if (wr == 0) PG8_BAR; }
    PG8_BAR;
    if constexpr (Epi::AFTER_DRAIN) { E.fused(acc, cur, wr, wc, fr, fq, lds, wid, lane); S.done(cur); }
#undef PG8_SA
#undef PG8_SB
#undef PG8_STAGE
#undef PG8_LDA
#undef PG8_LDB
#undef PG8_MMA
#undef PG8_WAIT_V
#undef PG8_WAIT_L
#undef PG8_BAR
#undef PG8_SCHED
}

}


#define XB_TMO      128
#define XB_XCNT(j)  (256  + 64 * (j))
#define XB_XSUB(j)  (1280 + 64 * (j))
#define XB_XGEN(j)  (2304 + 64 * (j))
#define XB_TOP      3328
#define XB_TOPGEN   3392
#define XCD_BAR_WORDS 3456
#define XB_SPIN_CAP (1u << 20)

__device__ __forceinline__ unsigned xb_ld(unsigned* p)              { return __hip_atomic_load(p, __ATOMIC_RELAXED, __HIP_MEMORY_SCOPE_AGENT); }
__device__ __forceinline__ unsigned xb_add(unsigned* p, unsigned v) { return __hip_atomic_fetch_add(p, v, __ATOMIC_RELAXED, __HIP_MEMORY_SCOPE_AGENT); }
__device__ __forceinline__ unsigned xb_xcc_id() { return (unsigned)__builtin_amdgcn_s_getreg((3 << 11) | 20) & 0xFu; }
#define XB_SPIN(cond, bar) do { unsigned _sp = 0; while (cond) { __builtin_amdgcn_s_sleep(1); \
    if ((++_sp & 255u) == 0u) { if (xb_ld(&(bar)[XB_TMO])) break; if (_sp > XB_SPIN_CAP) { atomicAdd(&(bar)[XB_TMO], 1u); break; } } } } while (0)

struct XcdBarrier {
    unsigned* bar; unsigned x;
    volatile LAS unsigned* st;
};

__device__ __forceinline__ XcdBarrier xcd_barrier_post(unsigned* bar, volatile LAS unsigned* st) {
    XcdBarrier b; b.bar = bar; b.x = xb_xcc_id(); b.st = st;
    if (threadIdx.x == 0) (void)xb_add(&bar[XB_XCNT(b.x)], 1u);
    return b;
}
__device__ __forceinline__ void xcd_barrier_complete(unsigned* bar, unsigned x, unsigned& nloc, unsigned& nx) {
    const unsigned G = gridDim.x * gridDim.y * gridDim.z;
    unsigned sum, cnt, mine, sp = 0u;
    for (;;) {
        sum = 0u; cnt = 0u; mine = 0u;
#pragma unroll
        for (unsigned j = 0; j < 16; ++j) { const unsigned c = xb_ld(&bar[XB_XCNT(j)]); sum += c; cnt += (c > 0u) ? 1u : 0u; mine = (j == x) ? c : mine; }
        if (sum == G) break;
        __builtin_amdgcn_s_sleep(1);
        if ((++sp & 255u) == 0u) { if (xb_ld(&bar[XB_TMO])) break; if (sp > XB_SPIN_CAP) { atomicAdd(&bar[XB_TMO], 1u); break; } }
    }
    nloc = mine > 0u ? mine : 1u; nx = cnt > 0u ? cnt : 1u;
}

__device__ __forceinline__ void xcd_barrier(const XcdBarrier& b) {
    asm volatile("s_waitcnt vmcnt(0)" ::: "memory");
    __syncthreads();
    if (threadIdx.x == 0) {
        unsigned* bar = b.bar;
        __builtin_amdgcn_s_waitcnt(0);
        unsigned nloc = b.st[0], nx = b.st[1];
        if (nloc == 0u) { xcd_barrier_complete(bar, b.x, nloc, nx); b.st[0] = nloc; b.st[1] = nx; }
        const unsigned old = xb_add(&bar[XB_XSUB(b.x)], 1u);
        const unsigned gen = old / nloc;
        if (old + 1u == (gen + 1u) * nloc) {
            __builtin_amdgcn_fence(__ATOMIC_RELEASE, "agent");
            asm volatile("s_waitcnt vmcnt(0)" ::: "memory");
            const unsigned og = xb_add(&bar[XB_TOP], 1u);
            const unsigned tg = og / nx;
            if (og + 1u == (tg + 1u) * nx) xb_add(&bar[XB_TOPGEN], 1u);
            else XB_SPIN(xb_ld(&bar[XB_TOPGEN]) == tg, bar);
            __builtin_amdgcn_fence(__ATOMIC_ACQUIRE, "agent");
            xb_add(&bar[XB_XGEN(b.x)], 1u);
            asm volatile("s_waitcnt vmcnt(0)" ::: "memory");
        } else {
            XB_SPIN(xb_ld(&bar[XB_XGEN(b.x)]) == gen, bar);
            __builtin_amdgcn_fence(__ATOMIC_ACQUIRE, "agent");
            asm volatile("s_waitcnt vmcnt(0)" ::: "memory");
        }
    }
    __syncthreads();
}

namespace na {
typedef short bf16x8 __attribute__((ext_vector_type(8)));
typedef short s16x4 __attribute__((ext_vector_type(4)));
typedef float f32x16 __attribute__((ext_vector_type(16)));
constexpr float LOG2E = 1.4426950408889634f;
constexpr int KOFF = 0, VOFF = 16384;
constexpr int N_LAT_UNITS = BATCH * NAH * (ROWS / 4), N_UNITS = N_LAT_UNITS + BATCH * NAH;
__device__ __forceinline__ s16x4 vtr(const LAS unsigned char* p) { return __builtin_bit_cast(s16x4, __builtin_amdgcn_ds_read_tr16_b64_v4i16((LAS s16x4*)p)); }
__device__ __forceinline__ int clampi(int v, int lo, int hi) { return v < lo ? lo : (v > hi ? hi : v); }

constexpr int BM_HEAD_BYTES = 15 * 4 * 2 * 64 * 16;
__device__ __forceinline__ void build_bias_table(float* BM, const float* rpb, int G, int bx) {
    for (int idx = bx * 512 + (int)threadIdx.x; idx < NAH * 15 * 4 * 2 * 64 * 4; idx += G * 512) {
        const int reg = idx & 3, lane = (idx >> 2) & 63, kb = (idx >> 8) & 1, jq = (idx >> 9) & 3, hd = idx >> 11;
        const int qc = 16 * jq + (lane & 15), kc = clampi(16 * jq - 8, 0, 32) + 16 * kb + 4 * (lane >> 4) + reg, cs = clampi(qc - 8, 0, GW - 16);
        BM[idx] = (kc >= cs && kc < cs + 16) ? rpb[hd * 31 + kc - qc + 15] : -INFINITY;
    }
}
constexpr int BMOFF = 32768;
template <int MODE> __device__ __forceinline__ void attn_phase(LAS unsigned char* lds, const bf16_t* QKV, const float* BM, const float* qg, const float* kg, bf16_t* O, int G, int vcu) {
    const int tid = threadIdx.x, lane = tid & 63, wave = __builtin_amdgcn_readfirstlane(tid >> 6), r32 = lane & 31, hi = lane >> 5;
    const int lkey = tid >> 3, lc16 = tid & 7;
    const int kwoff = lkey * 128 + ((lc16 ^ ((lkey >> 1) & 7)) * 16);
    const int vwoff = lkey * 128 + (((lc16 >> 1) ^ ((lkey >> 1) & 3)) * 32) + (lc16 & 1) * 16;
    const int i16 = lane & 15, g4 = lane >> 4;
    int lk = i16 * 128 + ((g4 ^ ((i16 >> 1) & 7)) * 16), lv = (4 * g4 + (i16 >> 2)) * 128 + (((2 * (g4 & 1) + (i16 >> 3)) & 3) << 5) + 8 * (i16 & 3);
    const int h = (vcu >> 4) & 15, wl = vcu & 15;
    float nshift;
    { const float gq = fabsf(qg[lane] * kg[lane]); float mxg = gq;
#pragma unroll
      for (int o = 1; o < 64; o <<= 1) mxg = fmaxf(mxg, __shfl_xor(mxg, o));
      nshift = -(8.f * mxg * 1.03f + 0.25f) * LOG2E; }
    { const v4u* src = (const v4u*)(BM + (size_t)h * (BM_HEAD_BYTES / 4));
      for (int i = tid; i < BM_HEAD_BYTES / 16; i += 512) *(LAS v4u*)(lds + BMOFF + i * 16) = src[i]; }
    struct UnitP { int b, R, r, qrow0, rs, kr_lo, ntl, NT; bool is_ctx, valid; };
    auto unit_of = [&](int it) { UnitP q; q.is_ctx = it == 8; q.valid = it < 8 || (it == 8 && wl < 4);
        const int kk = it * 16 + wl; q.b = q.is_ctx ? wl : (kk >> 5); q.R = q.is_ctx ? 0 : (kk & 31);
        q.r = 4 * q.R + (wave >> 1); const int c0 = 32 * (wave & 1);
        q.qrow0 = q.is_ctx ? MLAT + q.b * CTX + wave * 32 : q.b * SEQ + q.r * GW + c0;
        q.rs = clampi(q.r - 4, 0, ROWS - 8);
        q.kr_lo = q.is_ctx ? 0 : clampi(4 * q.R - 4, 0, ROWS - 8); const int kr_hi = q.is_ctx ? 0 : clampi(4 * q.R - 1, 0, ROWS - 8) + 8;
        q.ntl = kr_hi - q.kr_lo; q.NT = q.ntl + 4; return q; };
    auto tile_ptr = [&](const UnitP& q, int t) -> const bf16_t* { const int row0 = t < q.ntl ? q.b * SEQ + (q.kr_lo + t) * GW : MLAT + q.b * CTX + (t - q.ntl) * 64;
        return QKV + (size_t)(row0 + lkey) * 3072 + D + h * 64 + lc16 * 8; };
    UnitP U = unit_of(0);
    bf16x8 qr[4]; v4u kreg[2], vreg[2];
#pragma unroll
    for (int f = 0; f < 4; ++f) qr[f] = *(const bf16x8*)(QKV + (size_t)(U.qrow0 + 16 * (f >> 1) + i16) * 3072 + h * 64 + (f & 1) * 32 + g4 * 8);
    { const bf16_t* kp = tile_ptr(U, 0); kreg[0] = *(const v4u*)kp; vreg[0] = *(const v4u*)(kp + D); }
    { const bf16_t* kp = tile_ptr(U, 1); kreg[1] = *(const v4u*)kp; vreg[1] = *(const v4u*)(kp + D); }
    for (int it = 0; it < 9 && U.valid; ++it) {
        const UnitP UN = unit_of(it + 1);
        const int b = U.b, r = U.r, qrow0 = U.qrow0, rs = U.rs, kr_lo = U.kr_lo, ntl = U.ntl, NT = U.NT;
        __syncthreads();
        float lsum[2] = {0.f, 0.f}; f32x4 o[8];
#pragma unroll
        for (int f = 0; f < 8; ++f) o[f] = (f32x4){0.f, 0.f, 0.f, 0.f};
        auto step = [&](auto PARC, int t, int tl) {
            constexpr int PAR = decltype(PARC)::value;
            asm volatile("" : "+v"(lk), "+v"(lv));
            const bool local = t < ntl; const int kr = kr_lo + t;
            const bool need = MODE != 1 && (!local || (kr >= rs && kr < rs + 8));
            *(LAS v4u*)(lds + KOFF + PAR * 8192 + kwoff) = kreg[PAR];
            *(LAS v4u*)(lds + VOFF + PAR * 8192 + vwoff) = vreg[PAR];
            { const bf16_t* kp = t + 2 < NT ? tile_ptr(U, t + 2) : tile_ptr(UN.valid ? UN : U, tl >= 0 ? tl : 0); kreg[PAR] = *(const v4u*)kp; vreg[PAR] = *(const v4u*)(kp + D); }
            f32x4 cb[4];
            if (need && local) { const LAS unsigned char* tp = lds + BMOFF + ((kr - r + 7) * 4 + 2 * (wave & 1)) * 2048 + lane * 16;
#pragma unroll
                for (int f = 0; f < 4; ++f) cb[f] = *(const LAS f32x4*)(tp + f * 1024); }
            __syncthreads();
            if (need) {
                const LAS unsigned char* Kb = lds + KOFF + PAR * 8192; const LAS unsigned char* Vb = lds + VOFF + PAR * 8192;
                if (local) {
                    const int sp0 = (wave & 1) ? 24 : 0, sp1 = (wave & 1) ? 32 : 8;
#pragma unroll
                    for (int qb = 0; qb < 2; ++qb) { const int sp = qb ? sp1 : sp0;
                        bf16x8 kf[4];
#pragma unroll
                        for (int kb = 0; kb < 2; ++kb)
#pragma unroll
                            for (int ks = 0; ks < 2; ++ks) kf[2 * kb + ks] = *(const LAS bf16x8*)(Kb + (sp + 16 * kb) * 128 + (lk ^ ((ks ^ ((sp >> 3) & 1)) << 6)));
                        s16x4 va[8];
#pragma unroll
                        for (int db = 0; db < 4; ++db) { const LAS unsigned char* pa = Vb + sp * 128 + (lv ^ (db << 5));
                            va[db * 2] = vtr(pa); va[db * 2 + 1] = vtr(pa + 16 * 128); }
                        f32x4 sc[2];
#pragma unroll
                        for (int kb = 0; kb < 2; ++kb) { sc[kb] = cb[2 * qb + kb];
#pragma unroll
                            for (int ks = 0; ks < 2; ++ks) sc[kb] = __builtin_amdgcn_mfma_f32_16x16x32_bf16(kf[2 * kb + ks], qr[2 * qb + ks], sc[kb], 0, 0, 0); }
                        if (MODE == 2 || MODE == 4) { o[qb * 4] = o[qb * 4] + sc[0] + sc[1]; continue; }
#pragma unroll
                        for (int kb = 0; kb < 2; ++kb)
#pragma unroll
                            for (int e2 = 0; e2 < 4; ++e2) { sc[kb][e2] = __builtin_amdgcn_exp2f(__builtin_fmaf(sc[kb][e2], LOG2E, nshift)); lsum[qb] += sc[kb][e2]; }
                        if (MODE == 3) { o[qb * 4] = o[qb * 4] + sc[0] + sc[1]; continue; }
                        v4u pw; pw.x = pg8::cvt_pk_bf16(sc[0][0], sc[0][1]); pw.y = pg8::cvt_pk_bf16(sc[0][2], sc[0][3]);
                        pw.z = pg8::cvt_pk_bf16(sc[1][0], sc[1][1]); pw.w = pg8::cvt_pk_bf16(sc[1][2], sc[1][3]);
                        const bf16x8 pf = __builtin_bit_cast(bf16x8, pw);
#pragma unroll
                        for (int db = 0; db < 4; ++db) { const s16x4 lo = va[db * 2], hi4 = va[db * 2 + 1];
                            const bf16x8 vf = {lo[0], lo[1], lo[2], lo[3], hi4[0], hi4[1], hi4[2], hi4[3]};
                            o[qb * 4 + db] = __builtin_amdgcn_mfma_f32_16x16x32_bf16(vf, pf, o[qb * 4 + db], 0, 0, 0); }
                    }
                } else {
#pragma unroll
                    for (int grp = 0; grp < 2; ++grp) {
                        bf16x8 kf[4];
#pragma unroll
                        for (int kb = 0; kb < 2; ++kb)
#pragma unroll
                            for (int ks = 0; ks < 2; ++ks) kf[2 * kb + ks] = *(const LAS bf16x8*)(Kb + (2 * grp + kb) * 2048 + (lk ^ (ks << 6)));
                        s16x4 va[8];
#pragma unroll
                        for (int db = 0; db < 4; ++db) { const LAS unsigned char* pa = Vb + grp * 4096 + (lv ^ (db << 5)); va[db * 2] = vtr(pa); va[db * 2 + 1] = vtr(pa + 16 * 128); }
#pragma unroll
                        for (int qb = 0; qb < 2; ++qb) {
                            f32x4 sc[2];
#pragma unroll
                            for (int kb = 0; kb < 2; ++kb) { sc[kb] = (f32x4){0.f, 0.f, 0.f, 0.f};
#pragma unroll
                                for (int ks = 0; ks < 2; ++ks) sc[kb] = __builtin_amdgcn_mfma_f32_16x16x32_bf16(kf[2 * kb + ks], qr[2 * qb + ks], sc[kb], 0, 0, 0); }
                            if (MODE == 2 || MODE == 4) { o[qb * 4] = o[qb * 4] + sc[0] + sc[1]; continue; }
#pragma unroll
                            for (int kb = 0; kb < 2; ++kb)
#pragma unroll
                                for (int e2 = 0; e2 < 4; ++e2) { sc[kb][e2] = __builtin_amdgcn_exp2f(__builtin_fmaf(sc[kb][e2], LOG2E, nshift)); lsum[qb] += sc[kb][e2]; }
                            if (MODE == 3) { o[qb * 4] = o[qb * 4] + sc[0] + sc[1]; continue; }
                            v4u pw; pw.x = pg8::cvt_pk_bf16(sc[0][0], sc[0][1]); pw.y = pg8::cvt_pk_bf16(sc[0][2], sc[0][3]);
                            pw.z = pg8::cvt_pk_bf16(sc[1][0], sc[1][1]); pw.w = pg8::cvt_pk_bf16(sc[1][2], sc[1][3]);
                            const bf16x8 pf = __builtin_bit_cast(bf16x8, pw);
#pragma unroll
                            for (int db = 0; db < 4; ++db) { const s16x4 lo = va[db * 2], hi4 = va[db * 2 + 1];
                                const bf16x8 vf = {lo[0], lo[1], lo[2], lo[3], hi4[0], hi4[1], hi4[2], hi4[3]};
                                o[qb * 4 + db] = __builtin_amdgcn_mfma_f32_16x16x32_bf16(vf, pf, o[qb * 4 + db], 0, 0, 0); }
                        }
                    }
                }
            }
        };
        if (NT & 1) {
            step(std::integral_constant<int, 0>{}, 0, -1);
            for (int t = 1; t < NT; t += 2) { step(std::integral_constant<int, 1>{}, t, 1); step(std::integral_constant<int, 0>{}, t + 1, 0); }
        } else {
            for (int t = 0; t < NT; t += 2) { step(std::integral_constant<int, 0>{}, t, 0); step(std::integral_constant<int, 1>{}, t + 1, 1); }
        }
#pragma unroll
        for (int qb = 0; qb < 2; ++qb) {
            float l = lsum[qb]; l += __shfl_xor(l, 16); l += __shfl_xor(l, 32);
            const float rl = 1.f / l;
            bf16_t* op = O + (size_t)(qrow0 + 16 * qb + i16) * D + h * 64 + 4 * g4;
#pragma unroll
            for (int db = 0; db < 4; ++db) { v2u w; w.x = pg8::cvt_pk_bf16(o[qb * 4 + db][0] * rl, o[qb * 4 + db][1] * rl); w.y = pg8::cvt_pk_bf16(o[qb * 4 + db][2] * rl, o[qb * 4 + db][3] * rl);
                *(v2u*)(op + 16 * db) = w; }
        }
        U = UN;
        if (U.valid) {
#pragma unroll
            for (int f = 0; f < 4; ++f) qr[f] = *(const bf16x8*)(QKV + (size_t)(U.qrow0 + 16 * (f >> 1) + i16) * 3072 + h * 64 + (f & 1) * 32 + g4 * 8); }
    }
}
}


namespace hg {
typedef short bf16x8 __attribute__((ext_vector_type(8)));
typedef short s16x4 __attribute__((ext_vector_type(4)));
constexpr int QT = 0, KT = 16384, VT = 32768, AM = 49152, EB = 57344, EK = 57856, DL = 58368, OT = 59392;
constexpr int NSLOT = 9;
constexpr size_t STATE_SLOT_F = 128 * 128;
constexpr size_t WS_DEC_OFF = (size_t)64 * NSLOT * STATE_SLOT_F * 4;
__device__ __forceinline__ s16x4 vtr(const LAS unsigned char* p) { return __builtin_bit_cast(s16x4, __builtin_amdgcn_ds_read_tr16_b64_v4i16((LAS s16x4*)p)); }
__device__ __forceinline__ int fsw(int t) { return ((t & 3) ^ ((t >> 4) & 3)) | (((t >> 3) & 1) << 2); }
__device__ __forceinline__ int toff(int t, int c16) { return t * 256 + (((c16 >> 1) ^ fsw(t)) * 32) + (c16 & 1) * 16; }
#define HG_BAR() do { asm volatile("s_waitcnt vmcnt(0) lgkmcnt(0)" ::: "memory"); __builtin_amdgcn_s_barrier(); asm volatile("" ::: "memory"); } while (0)
#define HG_LBAR() do { asm volatile("s_waitcnt lgkmcnt(0)" ::: "memory"); __builtin_amdgcn_s_barrier(); asm volatile("" ::: "memory"); } while (0)

constexpr size_t HPL = (size_t)MTOT * D;
struct Stage { v4u q[2], k[2], v[2]; };
template <bool WITH_Q> __device__ __forceinline__ void stage_load(Stage& st, const unsigned short* HGO, int row0, int h, int dir, int tid) {
#pragma unroll
    for (int i = 0; i < 2; ++i) { const int p = tid + 512 * i, row = p >> 4, c16 = p & 15;
        const unsigned short* src = HGO + (size_t)(row0 + row) * D + h * 128 + c16 * 8;
        if (WITH_Q) st.q[i] = *(const v4u*)src;
        st.v[i] = *(const v4u*)(src + HPL); st.k[i] = *(const v4u*)(src + (3 + dir) * HPL); }
}
template <bool WITH_Q> __device__ __forceinline__ void stage_store(const Stage& st, LAS unsigned char* lds, int tid) {
#pragma unroll
    for (int i = 0; i < 2; ++i) { const int p = tid + 512 * i, o16 = toff(p >> 4, p & 15);
        if (WITH_Q) *(LAS v4u*)(lds + QT + o16) = st.q[i];
        *(LAS v4u*)(lds + KT + o16) = st.k[i];
        *(LAS v4u*)(lds + VT + o16) = st.v[i]; }
}
struct Bases { int b0, bq, bt, ba, bw, bo, bp, bs; };
__device__ __forceinline__ Bases make_bases(int tid) {
    const int lane = tid & 63, wave = tid >> 6, i16 = lane & 15, g = lane >> 4, kp = tid >> 3, seg = tid & 7;
    const int F0 = (i16 & 3) | (((i16 >> 3) & 1) << 2);
    Bases B;
    B.b0 = (i16 * 256) | ((F0 ^ (g >> 1)) << 5) | ((g & 1) << 4);
    B.bq = (i16 * 256) | (F0 << 5) | ((g >> 1) << 4) | ((g & 1) << 3);
    B.bt = ((8 * g + (i16 >> 2)) * 256) | ((((i16 >> 2) ^ (g >> 1)) | ((g & 1) << 2)) << 5) | (8 * (i16 & 3));
    B.ba = (i16 * 128) | ((g ^ ((i16 >> 1) & 7)) << 4);
    B.bw = (i16 * 128) | (((g >> 1) ^ ((i16 >> 1) & 7)) << 4) | ((g & 1) << 3);
    B.bo = (g * 2048) | ((wave ^ g) << 6) | (i16 << 2);
    B.bp = (seg * 2048) | (((kp >> 3) ^ (seg >> 1) ^ ((seg & 1) << 2)) << 5) | (((kp >> 2) & 1) << 4) | ((kp & 3) << 2);
    B.bs = toff(tid >> 4, tid & 15);
    return B;
}
#define HG_LAUNDER(B) asm volatile("" : "+v"((B).b0), "+v"((B).bq), "+v"((B).bt), "+v"((B).ba), "+v"((B).bw), "+v"((B).bo), "+v"((B).bp), "+v"((B).bs))
template <bool WITH_Q> __device__ __forceinline__ void stage_store2(const Stage& st, LAS unsigned char* lds, int bs) {
#pragma unroll
    for (int i = 0; i < 2; ++i) { const int o16 = (bs ^ (i << 6)) + i * 8192;
        if (WITH_Q) *(LAS v4u*)(lds + QT + o16) = st.q[i];
        *(LAS v4u*)(lds + KT + o16) = st.k[i];
        *(LAS v4u*)(lds + VT + o16) = st.v[i]; }
}
template <bool FULL> __device__ __forceinline__ void prep(LAS unsigned char* lds, int dir, int tid, int bp) {
    const int kp = tid >> 3, seg = tid & 7; const bool left = seg < 4;
    float kg[8][2], w[8][2], T[2];
#pragma unroll
    for (int i = 0; i < 8; ++i) {
        const unsigned kk = *(const LAS unsigned*)(lds + KT + (bp ^ ((i & 3) << 5)) + i * 256);
        kg[i][0] = h2f((f16_t)(kk & 0xffffu)); kg[i][1] = h2f((f16_t)(kk >> 16)); }
    const bool incl = left ? (dir == 1) : (dir == 0);
#pragma unroll
    for (int ch = 0; ch < 2; ++ch) { float run = 1.f;
        if (left) {
#pragma unroll
            for (int i = 7; i >= 0; --i) { const float f = 1.f - kg[i][ch]; const float nx = run * f; w[i][ch] = incl ? nx : run; run = nx; }
        } else {
#pragma unroll
            for (int i = 0; i < 8; ++i) { const float f = 1.f - kg[i][ch]; const float nx = run * f; w[i][ch] = incl ? nx : run; run = nx; }
        }
        T[ch] = run; }
    float totL[2], totR[2];
#pragma unroll
    for (int ch = 0; ch < 2; ++ch) {
        float inc = T[ch];
        { const float up = __shfl_up(inc, 1, 4), dn = __shfl_down(inc, 1, 4); const int q = seg & 3; if (left) { if (q + 1 < 4) inc *= dn; } else { if (q >= 1) inc *= up; } }
        { const float up = __shfl_up(inc, 2, 4), dn = __shfl_down(inc, 2, 4); const int q = seg & 3; if (left) { if (q + 2 < 4) inc *= dn; } else { if (q >= 2) inc *= up; } }
        totL[ch] = __shfl(inc, 0, 8); totR[ch] = __shfl(inc, 7, 8);
        const float cross = __shfl(inc, left ? (seg + 1 < 4 ? seg + 1 : seg) : (seg - 1 >= 4 ? seg - 1 : seg), 8);
        const float cr = left ? (seg + 1 < 4 ? cross : 1.f) : (seg - 1 >= 4 ? cross : 1.f);
#pragma unroll
        for (int i = 0; i < 8; ++i) w[i][ch] *= cr;
    }
    const bool x_is_e1 = left ? (dir == 1) : (dir == 0);
#pragma unroll
    for (int i = 0; i < 8; ++i) { const int o4 = (bp ^ ((i & 3) << 5)) + i * 256;
        const float x0 = w[i][0], x1 = w[i][1];
        const float r0 = __builtin_amdgcn_rcpf(fmaxf(x0, 1e-30f)), r1 = __builtin_amdgcn_rcpf(fmaxf(x1, 1e-30f));
        const float e20 = x_is_e1 ? r0 : x0, e21 = x_is_e1 ? r1 : x1;
        *(LAS unsigned*)(lds + KT + o4) = pg8::cvt_pk_bf16(kg[i][0] * e20, kg[i][1] * e21);
        if (FULL) {
            const unsigned qq = *(const LAS unsigned*)(lds + QT + o4);
            const float q0 = __builtin_bit_cast(float, qq << 16), q1 = __builtin_bit_cast(float, qq & 0xffff0000u);
            const float e10 = x_is_e1 ? x0 : r0, e11 = x_is_e1 ? x1 : r1;
            *(LAS unsigned*)(lds + QT + o4) = pg8::cvt_pk_bf16(q0 * e10, q1 * e11);
        }
    }
    if (seg == 0) {
        if (FULL) { f32x2 e; e.x = dir == 0 ? totL[0] : totR[0]; e.y = dir == 0 ? totL[1] : totR[1]; *(LAS f32x2*)(lds + EB + 2 * kp * 4) = e; }
        { f32x2 e; e.x = dir == 0 ? totR[0] : totL[0]; e.y = dir == 0 ? totR[1] : totL[1]; *(LAS f32x2*)(lds + EK + 2 * kp * 4) = e; }
        { f32x2 e; e.x = totL[0] * totR[0]; e.y = totL[1] * totR[1]; *(LAS f32x2*)(lds + DL + 2 * kp * 4) = e; }
    }
}
__device__ __forceinline__ void load_vB(bf16x8 (&vB)[2], const LAS unsigned char* lds, int wave, int bt) {
#pragma unroll
    for (int ks = 0; ks < 2; ++ks) {
        const LAS unsigned char* pa = lds + VT + (bt ^ ((wave ^ (2 * (ks & 1))) << 5)) + ks * 8192;
        const s16x4 lo = vtr(pa), hi4 = vtr(pa + 1024);
        vB[ks] = (bf16x8){lo[0], lo[1], lo[2], lo[3], hi4[0], hi4[1], hi4[2], hi4[3]}; }
}
__device__ __forceinline__ void state_update(f32x4 (&S)[8], const bf16x8 (&vB)[2], const LAS unsigned char* lds, int g, int bt) {
#pragma unroll
    for (int kb = 0; kb < 8; ++kb) {
        const f32x4 d4 = *(const LAS f32x4*)(lds + DL + (16 * kb + 4 * g) * 4), e4 = *(const LAS f32x4*)(lds + EK + (16 * kb + 4 * g) * 4);
        f32x4 acc = {0.f, 0.f, 0.f, 0.f};
#pragma unroll
        for (int ks = 0; ks < 2; ++ks) {
            const LAS unsigned char* pa = lds + KT + (bt ^ ((kb ^ (2 * (ks & 1))) << 5)) + ks * 8192;
            const s16x4 lo = vtr(pa), hi4 = vtr(pa + 1024);
            const bf16x8 a = {lo[0], lo[1], lo[2], lo[3], hi4[0], hi4[1], hi4[2], hi4[3]};
            acc = __builtin_amdgcn_mfma_f32_16x16x32_bf16(a, vB[ks], acc, 0, 0, 0); }
        S[kb] = S[kb] * d4 + acc * e4; }
}
__device__ __forceinline__ f32x4* state_ptr(float* base, int chain, int slot) { return (f32x4*)(base + ((size_t)chain * NSLOT + slot) * STATE_SLOT_F); }

template <int MODE> __device__ __forceinline__ void phase1(LAS unsigned char* lds, const unsigned short* HGO, float* STATE, int G, int vcu) {
    const int tid = threadIdx.x, lane = tid & 63, wave = __builtin_amdgcn_readfirstlane(tid >> 6);
    const int kp = tid >> 3, seg = tid & 7;
    float* DEC = STATE + WS_DEC_OFF / 4;
    Bases B = make_bases(tid);
    constexpr int BUFB = 32768;
    for (int it = 0;; ++it) {
        const int u = it * G + vcu; if (u >= 512) break;
        int chain, pi; if (u < 448) { chain = u / 7; pi = 1 + u % 7; } else { chain = u - 448; pi = 0; }
        const int b = chain >> 4, h = (chain >> 1) & 7, dir = chain & 1;
        const int nch = pi == 0 ? 4 : 16;
        const int base = pi == 0 ? MLAT + b * CTX : b * SEQ + (dir == 0 ? pi - 1 : 8 - pi) * 1024;
        f32x4 S[8];
#pragma unroll
        for (int kb = 0; kb < 8; ++kb) S[kb] = (f32x4){0.f, 0.f, 0.f, 0.f};
        float carry[2] = {1.f, 1.f};
        unsigned krA[8], krB[8]; v4u vrA[2], vrB[2];
        auto issue = [&](int j, unsigned (&kraw)[8], v4u (&vraw)[2]) { const int cm = dir == 0 ? nch - 1 - j : j; const int row0 = base + cm * 64;
            const unsigned short* kb_ = HGO + (3 + dir) * HPL + (size_t)(row0 + 8 * seg) * D + h * 128 + 2 * kp;
#pragma unroll
            for (int i = 0; i < 8; ++i) kraw[i] = *(const unsigned*)(kb_ + (size_t)i * D);
#pragma unroll
            for (int i = 0; i < 2; ++i) { const int p = tid + 512 * i; vraw[i] = *(const v4u*)(HGO + HPL + (size_t)(row0 + (p >> 4)) * D + h * 128 + (p & 15) * 8); } };
        auto prep_store = [&](int buf, const unsigned (&kraw)[8], const v4u (&vraw)[2]) {
            if (MODE == 2) {
#pragma unroll
                for (int i = 0; i < 8; ++i) *(LAS unsigned*)(lds + buf * BUFB + (B.bp ^ ((i & 3) << 5)) + i * 256) = kraw[i];
#pragma unroll
                for (int i = 0; i < 2; ++i) *(LAS v4u*)(lds + buf * BUFB + 16384 + (B.bs ^ (i << 6)) + i * 8192) = vraw[i];
                return; }
            float kg[8][2], ex[8][2], tot[2];
#pragma unroll
            for (int i = 0; i < 8; ++i) { kg[i][0] = h2f((f16_t)(kraw[i] & 0xffffu)); kg[i][1] = h2f((f16_t)(kraw[i] >> 16)); }
#pragma unroll
            for (int ch = 0; ch < 2; ++ch) { float run = 1.f;
                if (dir == 0) {
#pragma unroll
                    for (int i = 7; i >= 0; --i) { ex[i][ch] = run; run *= 1.f - kg[i][ch]; }
                } else {
#pragma unroll
                    for (int i = 0; i < 8; ++i) { ex[i][ch] = run; run *= 1.f - kg[i][ch]; }
                }
                tot[ch] = run; }
#pragma unroll
            for (int ch = 0; ch < 2; ++ch) { float inc = tot[ch];
#pragma unroll
                for (int d = 1; d < 8; d <<= 1) { const float up = __shfl_up(inc, d, 8), dn = __shfl_down(inc, d, 8);
                    if (dir == 0) { if (seg + d < 8) inc *= dn; } else { if (seg >= d) inc *= up; } }
                const float nb = __shfl(inc, dir == 0 ? (seg + 1 < 8 ? seg + 1 : seg) : (seg >= 1 ? seg - 1 : seg), 8);
                const float off = (dir == 0 ? (seg + 1 < 8) : (seg >= 1)) ? nb * carry[ch] : carry[ch];
                carry[ch] *= __shfl(inc, dir == 0 ? 0 : 7, 8);
#pragma unroll
                for (int i = 0; i < 8; ++i) ex[i][ch] *= off; }
#pragma unroll
            for (int i = 0; i < 8; ++i)
                *(LAS unsigned*)(lds + buf * BUFB + (B.bp ^ ((i & 3) << 5)) + i * 256) = pg8::cvt_pk_bf16(kg[i][0] * ex[i][0], kg[i][1] * ex[i][1]);
#pragma unroll
            for (int i = 0; i < 2; ++i) *(LAS v4u*)(lds + buf * BUFB + 16384 + (B.bs ^ (i << 6)) + i * 8192) = vraw[i];
        };
        auto mma = [&](int buf) {
            const LAS unsigned char* kt = lds + buf * BUFB; const LAS unsigned char* vt = kt + 16384;
            bf16x8 vB[2];
#pragma unroll
            for (int ks = 0; ks < 2; ++ks) { const LAS unsigned char* pa = vt + (B.bt ^ ((wave ^ (2 * (ks & 1))) << 5)) + ks * 8192;
                const s16x4 lo = vtr(pa), hi4 = vtr(pa + 1024); vB[ks] = (bf16x8){lo[0], lo[1], lo[2], lo[3], hi4[0], hi4[1], hi4[2], hi4[3]}; }
#pragma unroll
            for (int kb = 0; kb < 8; ++kb)
#pragma unroll
                for (int ks = 0; ks < 2; ++ks) { const LAS unsigned char* pa = kt + (B.bt ^ ((kb ^ (2 * (ks & 1))) << 5)) + ks * 8192;
                    const s16x4 lo = vtr(pa), hi4 = vtr(pa + 1024);
                    const bf16x8 a = {lo[0], lo[1], lo[2], lo[3], hi4[0], hi4[1], hi4[2], hi4[3]};
                    S[kb] = __builtin_amdgcn_mfma_f32_16x16x32_bf16(a, vB[ks], S[kb], 0, 0, 0); }
        };
        HG_LAUNDER(B);
        issue(0, krA, vrA); issue(1, krB, vrB);
        HG_LBAR();
        prep_store(0, krA, vrA);
        issue(2, krA, vrA);
        HG_LBAR();
        for (int j = 0; j < nch; j += 2) {
            HG_LAUNDER(B);
            if (MODE != 1) mma(0);
            prep_store(1, krB, vrB); if (j + 3 < nch) issue(j + 3, krB, vrB);
            HG_LBAR();
            if (MODE != 1) mma(1);
            if (j + 2 < nch) { prep_store(0, krA, vrA); if (j + 4 < nch) issue(j + 4, krA, vrA); }
            HG_LBAR();
        }
        f32x4* sp = state_ptr(STATE, chain, pi) + (size_t)wave * 8 * 64 + lane;
#pragma unroll
        for (int kb = 0; kb < 8; ++kb) sp[kb * 64] = S[kb];
        if (seg == 0) { f32x2 d2; d2.x = carry[0]; d2.y = carry[1]; *(f32x2*)(DEC + ((size_t)chain * NSLOT + pi) * 128 + 2 * kp) = d2; }
    }
}
__device__ __forceinline__ void phase2(float* STATE, int G, int bx) {
    const float* DEC = STATE + WS_DEC_OFF / 4;
    for (int e = bx * 512 + (int)threadIdx.x; e < 64 * 4096; e += G * 512) {
        const int chain = e >> 12, r = e & 4095, kb = (r >> 6) & 7, lane = r & 63;
        f32x4* sp = state_ptr(STATE, chain, 0) + r;
        f32x4 run = sp[0];
#pragma unroll
        for (int i = 1; i < NSLOT; ++i) {
            f32x4 tmp = {0.f, 0.f, 0.f, 0.f}, d4 = {0.f, 0.f, 0.f, 0.f};
            if (i < NSLOT - 1) { tmp = sp[(size_t)i * 4096]; d4 = *(const f32x4*)(DEC + ((size_t)chain * NSLOT + i) * 128 + 16 * kb + 4 * (lane >> 4)); }
            sp[(size_t)i * 4096] = run;
            run = d4 * run + tmp;
        }
    }
}
constexpr int P3BUF = 58880, P3OT = 2 * P3BUF;
__device__ __forceinline__ void phase3(LAS unsigned char* lds, unsigned short* HGO, float* STATE, const float* norm_g, int G, int vcu, volatile LAS unsigned* tacc) {
    const int tid = threadIdx.x, lane = tid & 63, wave = __builtin_amdgcn_readfirstlane(tid >> 6), i16 = lane & 15, g = lane >> 4;
    Bases B = make_bases(tid);
    for (int it = 0;; ++it) {
        const int u = it * G + vcu; if (u >= 256) break;
        const int b = u >> 6, h = (u >> 3) & 7, j = u & 7;
        const int base = b * SEQ + j * 1024;
        for (int dir = 0; dir < 2; ++dir) {
            const int chain = (b * 8 + h) * 2 + dir, pi = dir == 0 ? j + 1 : 8 - j;
            f32x4 S[8];
            { const f32x4* sp = state_ptr(STATE, chain, pi) + (size_t)wave * 8 * 64 + lane;
#pragma unroll
              for (int kb = 0; kb < 8; ++kb) S[kb] = sp[kb * 64]; }
            auto chunk_of = [&](int ci) { return dir == 0 ? ci : 15 - ci; };
            auto intra = [&](LAS unsigned char* L) {
#pragma unroll
                for (int pp = 0; pp < 2; ++pp) { const int p = 2 * wave + pp, sb = p >> 2, tb = p & 3;
                    f32x4 acc = {0.f, 0.f, 0.f, 0.f};
                    const int tr = 16 * tb + i16;
#pragma unroll
                    for (int ks = 0; ks < 4; ++ks) {
                        const bf16x8 a = *(const LAS bf16x8*)(L + KT + (B.b0 ^ ((sb << 5) ^ (ks << 6))) + sb * 4096);
                        const bf16x8 bq = *(const LAS bf16x8*)(L + QT + (B.b0 ^ ((tb << 5) ^ (ks << 6))) + tb * 4096);
                        acc = __builtin_amdgcn_mfma_f32_16x16x32_bf16(a, bq, acc, 0, 0, 0); }
#pragma unroll
                    for (int reg = 0; reg < 4; ++reg) { const int s = 16 * sb + 4 * g + reg; const bool ok = dir == 0 ? (s <= tr) : (s >= tr); if (!ok) acc[reg] = 0.f; }
                    v2u w; w.x = pg8::cvt_pk_bf16(acc[0], acc[1]); w.y = pg8::cvt_pk_bf16(acc[2], acc[3]);
                    *(LAS v2u*)(L + AM + (B.bw ^ (sb << 5)) + tb * 2048) = w; }
            };
            auto main_state = [&](LAS unsigned char* L) {
                bf16x8 vB[2]; load_vB(vB, L, wave, B.bt);
                bf16x8 sB[4];
#pragma unroll
                for (int kk = 0; kk < 4; ++kk) {
                    const f32x4 ea = *(const LAS f32x4*)(L + EB + (32 * kk + 4 * g) * 4), eb = *(const LAS f32x4*)(L + EB + (32 * kk + 16 + 4 * g) * 4);
                    const f32x4 sa = S[2 * kk] * ea, sb2 = S[2 * kk + 1] * eb;
                    v4u w; w.x = pg8::cvt_pk_bf16(sa[0], sa[1]); w.y = pg8::cvt_pk_bf16(sa[2], sa[3]); w.z = pg8::cvt_pk_bf16(sb2[0], sb2[1]); w.w = pg8::cvt_pk_bf16(sb2[2], sb2[3]);
                    sB[kk] = __builtin_bit_cast(bf16x8, w); }
#pragma unroll
                for (int tb = 0; tb < 4; ++tb) { f32x4 acc = {0.f, 0.f, 0.f, 0.f};
#pragma unroll
                    for (int ks = 0; ks < 2; ++ks) { const bf16x8 a = *(const LAS bf16x8*)(L + AM + (B.ba ^ (ks << 6)) + tb * 2048);
                        acc = __builtin_amdgcn_mfma_f32_16x16x32_bf16(a, vB[ks], acc, 0, 0, 0); }
#pragma unroll
                    for (int kk = 0; kk < 4; ++kk) {
                        const v2u lo = *(const LAS v2u*)(L + QT + (B.bq ^ (((2 * kk) ^ tb) << 5)) + tb * 4096);
                        const v2u hi2 = *(const LAS v2u*)(L + QT + (B.bq ^ (((2 * kk + 1) ^ tb) << 5)) + tb * 4096);
                        v4u w; w.x = lo.x; w.y = lo.y; w.z = hi2.x; w.w = hi2.y;
                        acc = __builtin_amdgcn_mfma_f32_16x16x32_bf16(__builtin_bit_cast(bf16x8, w), sB[kk], acc, 0, 0, 0); }
#pragma unroll
                    for (int reg = 0; reg < 4; ++reg) *(LAS float*)(lds + P3OT + (B.bo ^ ((tb & 1) << 8)) + tb * 8192 + reg * 512) = acc[reg];
                }
                state_update(S, vB, L, g, B.bt);
            };
            v4u ofp[2], gp[2];
            auto output = [&](int row0) {
                const f32x4 ng0 = *(const f32x4*)(norm_g + 8 * (tid & 15)), ng1 = *(const f32x4*)(norm_g + 8 * (tid & 15) + 4);
                const int ob0 = (tid >> 4) * 512 + ((((tid & 15) >> 1) ^ wave) * 64) + (tid & 1) * 32;
#pragma unroll
                for (int i = 0; i < 2; ++i) { const int p = tid + 512 * i, row = p >> 4, c16 = p & 15;
                    const LAS unsigned char* op = lds + P3OT + ob0 + i * 16384;
                    f32x4 o0 = *(const LAS f32x4*)op, o1 = *(const LAS f32x4*)(op + 16);
                    unsigned short* dst = HGO + (size_t)(row0 + row) * D + h * 128 + c16 * 8;
                    if (dir == 0) { *(v4u*)(dst + 3 * HPL) = pg8::pack8(o0, o1); }
                    else {
                        const v4u f = ofp[i], gg = gp[i];
#pragma unroll
                        for (int q2 = 0; q2 < 2; ++q2) { o0[2 * q2] += __builtin_bit_cast(float, f[q2] << 16); o0[2 * q2 + 1] += __builtin_bit_cast(float, f[q2] & 0xffff0000u);
                            o1[2 * q2] += __builtin_bit_cast(float, f[2 + q2] << 16); o1[2 * q2 + 1] += __builtin_bit_cast(float, f[2 + q2] & 0xffff0000u); }
                        float ss = pg8::sq4(o0) + pg8::sq4(o1);
                        ss += __shfl_xor(ss, 1); ss += __shfl_xor(ss, 2); ss += __shfl_xor(ss, 4); ss += __shfl_xor(ss, 8);
                        const float rinv = rsqrtf(ss * (1.f / 128.f) + EPS);
                        f32x4 g0, g1;
#pragma unroll
                        for (int q2 = 0; q2 < 2; ++q2) { g0[2 * q2] = __builtin_bit_cast(float, gg[q2] << 16); g0[2 * q2 + 1] = __builtin_bit_cast(float, gg[q2] & 0xffff0000u);
                            g1[2 * q2] = __builtin_bit_cast(float, gg[2 + q2] << 16); g1[2 * q2 + 1] = __builtin_bit_cast(float, gg[2 + q2] & 0xffff0000u); }
                        *(v4u*)dst = pg8::pack8(o0 * rinv * ng0 * g0, o1 * rinv * ng1 * g1);
                    }
                }
            };
            Stage st;
            HG_LAUNDER(B);
            stage_load<true>(st, HGO, base + chunk_of(0) * 64, h, dir, tid);
            stage_store2<true>(st, lds, B.bs);
            stage_load<true>(st, HGO, base + chunk_of(1) * 64, h, dir, tid);
            HG_LBAR();
            prep<true>(lds, dir, tid, B.bp);
            HG_LBAR();
            intra(lds);
            stage_store2<true>(st, lds + P3BUF, B.bs);
            stage_load<true>(st, HGO, base + chunk_of(2) * 64, h, dir, tid);
            HG_LBAR();
            for (int ci = 0; ci < 16; ++ci) {
                LAS unsigned char* Lm = lds + (ci & 1) * P3BUF; LAS unsigned char* Ln = lds + ((ci & 1) ^ 1) * P3BUF;
                const int row0 = base + chunk_of(ci) * 64;
                HG_LAUNDER(B);
                const unsigned tp0 = tacc ? (unsigned)__builtin_amdgcn_s_memrealtime() : 0u;
                if (dir == 1) {
#pragma unroll
                    for (int i = 0; i < 2; ++i) { const int p = tid + 512 * i; const unsigned short* src = HGO + (size_t)(row0 + (p >> 4)) * D + h * 128 + (p & 15) * 8;
                        ofp[i] = *(const v4u*)(src + 3 * HPL); gp[i] = *(const v4u*)(src + 2 * HPL); }
                }
                if (ci + 1 < 16) prep<true>(Ln, dir, tid, B.bp);
                main_state(Lm);
                HG_LBAR();
                const unsigned tp1 = tacc ? (unsigned)__builtin_amdgcn_s_memrealtime() : 0u;
                if (ci + 1 < 16) intra(Ln);
                output(row0);
                if (ci + 2 < 16) { stage_store2<true>(st, Lm, B.bs); if (ci + 3 < 16) stage_load<true>(st, HGO, base + chunk_of(ci + 3) * 64, h, dir, tid); }
                HG_LBAR();
                if (tacc && tid == 0) { const unsigned tp2 = (unsigned)__builtin_amdgcn_s_memrealtime(); tacc[0] += tp1 - tp0; tacc[1] += tp2 - tp1; }
            }
            HG_BAR();
        }
    }
}
}


constexpr int NWAVES = 8;
constexpr int RING_BYTES = 131072, LDS_BYTES = 163840, MISC_OFF = LDS_BYTES - 512;
typedef GAS unsigned gu32;
#define LDS_WAIT() asm volatile("s_waitcnt lgkmcnt(0)" ::: "memory")
#define VM_WAIT() asm volatile("s_waitcnt vmcnt(0)" ::: "memory")
__device__ __forceinline__ float wave_sum(float v) {
#pragma unroll
    for (int o = 1; o < 64; o <<= 1) v += __shfl_xor(v, o);
    return v;
}
#ifndef PROBE_MASK
#define PROBE_MASK 0u
#endif
#define PROBE_MUL 2u
struct Args { const float* in[19]; float* out; unsigned char* ws; int ph_lo, ph_hi; };

template <class PermF> __device__ __forceinline__ void p0_transpose_item(const float* W, int K, int N, bf16_t* WT, int k0, int n0, PermF perm, LAS float* scr, int lane) {
#pragma unroll 16
    for (int kk = 0; kk < 64; ++kk) scr[kk * 65 + lane] = W[(size_t)(k0 + kk) * N + n0 + lane];
    LDS_WAIT(); asm volatile("" ::: "memory");
    const int c = lane & 7;
#pragma unroll
    for (int j = 0; j < 8; ++j) { const int n = (lane >> 3) + 8 * j; const LAS float* s = scr + (8 * c) * 65 + n;
        v4u o; o.x = pk2(s[0 * 65], s[1 * 65]); o.y = pk2(s[2 * 65], s[3 * 65]); o.z = pk2(s[4 * 65], s[5 * 65]); o.w = pk2(s[6 * 65], s[7 * 65]);
        const int drow = perm(n0 + (n & ~31)) + (n & 31);
        *(v4u*)(WT + (size_t)drow * K + k0 + 8 * c) = o; }
    LDS_WAIT(); asm volatile("" ::: "memory");
}
__device__ __forceinline__ int perm_qkv(int n0) { const int t = n0 & 255, wc = t >> 6, bj = (t >> 5) & 1; return (n0 & ~255) + 128 * bj + 32 * wc; }
__device__ __forceinline__ int perm_ffn(int n0) { const int bj = n0 >= DFF ? 1 : 0, c = n0 - bj * DFF; return (c >> 7) * 256 + bj * 128 + (c & 127); }

__device__ __forceinline__ void naive_attn_item(const bf16_t* QKV, const float* rpb, bf16_t* O, int idx) {
    const int h = idx & 15, row = idx >> 4;
    float q[64], o[64]; float m = -INFINITY, l = 0.f;
    { const bf16_t* qp = QKV + (size_t)row * 3072 + h * 64;
#pragma unroll
      for (int i = 0; i < 64; ++i) { q[i] = bf2f(qp[i]); o[i] = 0.f; } }
    const int b = row_batch(row);
    auto visit = [&](int krow, float bias) {
        const bf16_t* kp = QKV + (size_t)krow * 3072 + D + h * 64; const bf16_t* vp = kp + D;
        float s = 0.f;
#pragma unroll
        for (int i = 0; i < 64; ++i) s += q[i] * bf2f(kp[i]);
        s += bias;
        const float mn = fmaxf(m, s), f = __expf(m - mn), p = __expf(s - mn);
        l = l * f + p;
#pragma unroll
        for (int i = 0; i < 64; ++i) o[i] = o[i] * f + p * bf2f(vp[i]);
        m = mn;
    };
    if (row < MLAT) {
        const int t = row & (SEQ - 1), r = t >> 6, c = t & 63;
        int rs = r - 4; rs = rs < 0 ? 0 : (rs > ROWS - 8 ? ROWS - 8 : rs);
        int cs = c - 8; cs = cs < 0 ? 0 : (cs > GW - 16 ? GW - 16 : cs);
        for (int j = 0; j < 8; ++j)
            for (int w = 0; w < 16; ++w) {
                const int kr = rs + j, kc = cs + w;
                visit(b * SEQ + kr * GW + kc, rpb[(h * 15 + (kr - r + 7)) * 31 + (kc - c + 15)]);
            }
    }
    for (int kk = 0; kk < CTX; ++kk) visit(MLAT + b * CTX + kk, 0.f);
    const float rl = 1.f / l;
    bf16_t* op = O + (size_t)row * D + h * 64;
#pragma unroll
    for (int i = 0; i < 64; ++i) op[i] = f2bf(o[i] * rl);
}
__device__ __forceinline__ void naive_hgscan(unsigned short* HGO, const float* norm_g, int bh, LAS float* sm) {
    LAS float (*sq)[128] = (LAS float (*)[128])sm; LAS float (*sk)[128] = (LAS float (*)[128])(sm + 256); LAS float (*red)[2] = (LAS float (*)[2])(sm + 512);
    const int b = bh >> 3, h = bh & 7, v = threadIdx.x & 127; const bool act = threadIdx.x < 128;
    const int NS = CTX + SEQ;
    const float ng = norm_g[v];
    for (int dir = 0; dir < 2; ++dir) {
        float S[128];
#pragma unroll
        for (int k = 0; k < 128; ++k) S[k] = 0.f;
        auto rowof = [&](int step) { int row; if (step < CTX) { const int j = dir == 0 ? step : CTX - 1 - step; row = MLAT + b * CTX + j; } else { const int t = dir == 0 ? step - CTX : SEQ - 1 - (step - CTX); row = b * SEQ + t; } return row; };
        { const int row = rowof(0); const unsigned short* p = HGO + (size_t)row * 5120 + h * 128;
          if (act) { sq[0][v] = bf2f(p[v]); sk[0][v] = h2f(p[(3 + dir) * D + v]); } }
        __syncthreads();
        for (int step = 0; step < NS; ++step) {
            const int cur = step & 1, row = rowof(step);
            unsigned short* p = HGO + (size_t)row * 5120 + h * 128;
            const float vv = bf2f(p[D + v]);
            if (step + 1 < NS) { const int rn = rowof(step + 1); const unsigned short* pn = HGO + (size_t)rn * 5120 + h * 128;
                if (act) { sq[cur ^ 1][v] = bf2f(pn[v]); sk[cur ^ 1][v] = h2f(pn[(3 + dir) * D + v]); } }
            float o = 0.f;
#pragma unroll
            for (int k = 0; k < 128; ++k) { const float kk = sk[cur][k]; S[k] = (1.f - kk) * S[k] + kk * vv; o += sq[cur][k] * S[k]; }
            if (row < MLAT) {
                if (dir == 0) { if (act) p[3 * D + v] = f2bf(o); }
                else {
                    const float ot = o + bf2f(p[3 * D + v]);
                    float ss = ot * ot;
#pragma unroll
                    for (int off = 1; off < 64; off <<= 1) ss += __shfl_xor(ss, off);
                    if (act && (v & 63) == 0) red[cur][v >> 6] = ss;
                    __syncthreads();
                    const float tot = red[cur][0] + red[cur][1];
                    const float rinv = rsqrtf(tot * (1.f / 128.f) + EPS);
                    const float gv = bf2f(p[2 * D + v]);
                    if (act) p[v] = f2bf(ot * rinv * ng * gv);
                }
            }
            __syncthreads();
        }
    }
}


template <int SET> __device__ __forceinline__ void convert_weights(const Args& a, unsigned char* ws, LAS unsigned char* lds, int w, int nw, int lane) {
    const float* w_qkv = a.in[8]; const float* w_o = a.in[9]; const float* hg_w_in = a.in[13]; const float* hg_w_o = a.in[16]; const float* ffn_w_in = a.in[17]; const float* ffn_w_out = a.in[18];
    bf16_t* Wqkv_t = (bf16_t*)(ws + WS_WQKV); bf16_t* Wo0_t = (bf16_t*)(ws + WS_WO0); bf16_t* Whgin_t = (bf16_t*)(ws + WS_WHGIN); bf16_t* Whgo_t = (bf16_t*)(ws + WS_WHGO);
    bf16_t* Wfin0_t = (bf16_t*)(ws + WS_WFIN0); bf16_t* Wfin1_t = (bf16_t*)(ws + WS_WFIN1); bf16_t* Wfout0_t = (bf16_t*)(ws + WS_WFOUT0); bf16_t* Wfout1_t = (bf16_t*)(ws + WS_WFOUT1);
    LAS float* scr = (LAS float*)(lds + (threadIdx.x >> 6) * 16896);
    constexpr int I_QKV = 16 * 48, I_O = 16 * 16, I_HGIN = 16 * 80, I_FIN = 16 * 88, I_FOUT = 44 * 16;
    auto ident = [](int n) { return n; };
    auto pq = [](int n) { return perm_qkv(n); };
    auto pf = [](int n) { return perm_ffn(n); };
    if (SET == 0) {
        for (int r = w; r < I_QKV; r += nw) { const int kb = r / 48, nb = r % 48; p0_transpose_item(w_qkv, D, 3 * D, Wqkv_t, kb * 64, nb * 64, pq, scr, lane); }
    } else if (SET == 1) {
        for (int it = w; it < I_O + I_FIN + I_FOUT; it += nw) { int r = it;
            if (r < I_O) { const int kb = r / 16, nb = r % 16; p0_transpose_item(w_o, D, D, Wo0_t, kb * 64, nb * 64, ident, scr, lane); continue; } r -= I_O;
            if (r < I_FIN) { const int kb = r / 88, nb = r % 88; p0_transpose_item(ffn_w_in, D, 2 * DFF, Wfin0_t, kb * 64, nb * 64, pf, scr, lane); continue; } r -= I_FIN;
            { const int kb = r / 16, nb = r % 16; p0_transpose_item(ffn_w_out, DFF, D, Wfout0_t, kb * 64, nb * 64, ident, scr, lane); } }
    } else {
        for (int it = w; it < I_HGIN + I_O + I_FIN + I_FOUT; it += nw) { int r = it;
            if (r < I_HGIN) { const int kb = r / 80, nb = r % 80; p0_transpose_item(hg_w_in, D, 5 * D, Whgin_t, kb * 64, nb * 64, ident, scr, lane); continue; } r -= I_HGIN;
            if (r < I_O) { const int kb = r / 16, nb = r % 16; p0_transpose_item(hg_w_o, D, D, Whgo_t, kb * 64, nb * 64, ident, scr, lane); continue; } r -= I_O;
            if (r < I_FIN) { const int kb = r / 88, nb = r % 88; p0_transpose_item(ffn_w_in + (size_t)D * 2 * DFF, D, 2 * DFF, Wfin1_t, kb * 64, nb * 64, pf, scr, lane); continue; } r -= I_FIN;
            { const int kb = r / 16, nb = r % 16; p0_transpose_item(ffn_w_out + (size_t)DFF * D, DFF, D, Wfout1_t, kb * 64, nb * 64, ident, scr, lane); } }
    }
}
__device__ __forceinline__ void bias_gemv(const bf16_t* Bt, int N, const float* sh, float* dst, int w, int nw, int lane) {
    for (int n = w; n < N; n += nw) {
        const v4u* wp = (const v4u*)(Bt + (size_t)n * D + lane * 16); const v4u w0 = wp[0], w1 = wp[1];
        float wf[16];
#pragma unroll
        for (int j = 0; j < 4; ++j) { wf[2 * j] = __builtin_bit_cast(float, w0[j] << 16); wf[2 * j + 1] = __builtin_bit_cast(float, w0[j] & 0xffff0000u);
            wf[8 + 2 * j] = __builtin_bit_cast(float, w1[j] << 16); wf[8 + 2 * j + 1] = __builtin_bit_cast(float, w1[j] & 0xffff0000u); }
#pragma unroll
        for (int s = 0; s < 5; ++s) { const f32x4* sp = (const f32x4*)(sh + (size_t)s * 6 * D + lane * 16); float t = 0.f;
#pragma unroll
            for (int q = 0; q < 4; ++q) { const f32x4 sv = sp[q]; t += (sv[0] * wf[4 * q] + sv[1] * wf[4 * q + 1]) + (sv[2] * wf[4 * q + 2] + sv[3] * wf[4 * q + 3]); }
            t = wave_sum(t); if (lane == 0) dst[(size_t)s * N + n] = t; }
    }
}

__global__ void __launch_bounds__(NWAVES * 64, 2) mega(Args a) {
    extern __shared__ __attribute__((aligned(16))) unsigned char lds_raw[];
    LAS unsigned char* lds = (LAS unsigned char*)lds_raw;
    volatile LAS unsigned* MISC = (volatile LAS unsigned*)(lds + MISC_OFF);
    const int tid = threadIdx.x, lane = tid & 63, wave = __builtin_amdgcn_readfirstlane(tid >> 6);
    const int G = gridDim.x, bx = blockIdx.x;
    const int vcu = (G % 8 == 0) ? (bx % 8) * (G / 8) + bx / 8 : bx;
    unsigned char* ws = a.ws;
    const float* x = a.in[0]; const float* cvec = a.in[1]; const float* ctx = a.in[2]; const float* c_ctx = a.in[3];
    const float* ada_w = a.in[4]; const float* ada_b = a.in[5]; const float* norm1_g = a.in[6]; const float* norm2_g = a.in[7];
    const float* w_qkv = a.in[8]; const float* w_o = a.in[9]; const float* q_gain = a.in[10]; const float* k_gain = a.in[11];
    const float* hg_w_in = a.in[13]; const float* hg_lower = a.in[14];
    const float* hg_w_o = a.in[16]; const float* ffn_w_in = a.in[17]; const float* ffn_w_out = a.in[18];
    float* out = a.out;
    float* mod = (float*)(ws + WS_MOD); float* lbp = (float*)(ws + WS_LB); float* Gv = (float*)(ws + WS_GV);
    float* bias_f0 = (float*)(ws + WS_BIAS_F0); float* bias_hg = (float*)(ws + WS_BIAS_HG); float* bias_f1 = (float*)(ws + WS_BIAS_F1);
    float* part = (float*)(ws + WS_PART); bf16_t* XCTX = (bf16_t*)(ws + WS_XCTX);
    bf16_t* XRES = (bf16_t*)out;
    bf16_t* Wqkv_t = (bf16_t*)(ws + WS_WQKV); bf16_t* Wo0_t = (bf16_t*)(ws + WS_WO0); bf16_t* Whgin_t = (bf16_t*)(ws + WS_WHGIN); bf16_t* Whgo_t = (bf16_t*)(ws + WS_WHGO);
    bf16_t* Wfin0_t = (bf16_t*)(ws + WS_WFIN0); bf16_t* Wfin1_t = (bf16_t*)(ws + WS_WFIN1); bf16_t* Wfout0_t = (bf16_t*)(ws + WS_WFOUT0); bf16_t* Wfout1_t = (bf16_t*)(ws + WS_WFOUT1);
    bf16_t* ABUF = (bf16_t*)(ws + WS_ABUF); bf16_t* R1 = (bf16_t*)(ws + WS_R1);
    bf16_t* X3 = R1 + 4 * (size_t)MTOT * D;

    for (int u = tid; u < 512 / 4; u += NWAVES * 64) ((LAS unsigned*)(lds + MISC_OFF))[u] = 0u;
    __syncthreads();
    XcdBarrier bar = xcd_barrier_post((unsigned*)(ws + WS_CTL) + 1024, MISC + 8);
    const int lo = a.ph_lo, hi = a.ph_hi;
#define IN(k) (lo <= (k) && (k) < hi)
#ifndef BAR_REPEAT
#define BAR_REPEAT 1
#endif
#define SEAM(k) do { if (IN(k) && IN((k) + 1)) for (int br_ = 0; br_ < BAR_REPEAT; ++br_) xcd_barrier(bar); if (PROBE_MASK && bx == 0 && tid == 0) MISC[17 + (k)] = (unsigned)__builtin_amdgcn_s_memrealtime(); } while (0)
    if (PROBE_MASK && bx == 0 && tid == 0) MISC[16] = (unsigned)__builtin_amdgcn_s_memrealtime();

    if (IN(0)) {
        if (bx < 192) {
            LAS float* sv = (LAS float*)lds; LAS float* red = (LAS float*)(lds + 20480);
            const int l = bx / 96, cb = bx % 96;
            for (int i = tid; i < 5 * D; i += 512) { const int s = i >> 10, k = i & 1023; const float v = s < 4 ? cvec[s * D + k] : c_ctx[k]; sv[i] = silu_f(v); }
            __syncthreads();
            const int col = tid & 63, kg = tid >> 6;
            float acc[5] = {0.f, 0.f, 0.f, 0.f, 0.f};
            const float* w = ada_w + (size_t)l * D * 6 * D + cb * 64 + col;
            for (int k0 = kg * 128; k0 < kg * 128 + 128; k0 += 32) {
                float wv[32];
#pragma unroll
                for (int q = 0; q < 32; ++q) wv[q] = w[(size_t)(k0 + q) * 6 * D];
#pragma unroll
                for (int q = 0; q < 32; ++q)
#pragma unroll
                    for (int s = 0; s < 5; ++s) acc[s] += sv[s * D + k0 + q] * wv[q]; }
#pragma unroll
            for (int s = 0; s < 5; ++s) red[(kg * 5 + s) * 64 + col] = acc[s];
            __syncthreads();
            if (tid < 320) { const int s = tid >> 6, c2 = tid & 63; float t = 0.f;
#pragma unroll
                for (int k2 = 0; k2 < 8; ++k2) t += red[(k2 * 5 + s) * 64 + c2];
                mod[((size_t)l * 5 + s) * 6 * D + cb * 64 + c2] = t + ada_b[l * 6 * D + cb * 64 + c2]; }
            __syncthreads();
        } else if (bx < 196) { const int i = (bx - 192) * 512 + tid; lbp[i] = sigmoid_f(hg_lower[2 * D + i] - hg_lower[i]); }
        convert_weights<0>(a, ws, lds, vcu * NWAVES + wave, G * NWAVES, lane);
    }
    SEAM(0);
    if (IN(1)) {
        const int gw = vcu * NWAVES + wave, NGW = G * NWAVES;
        na::build_bias_table((float*)(ws + WS_BTAB), a.in[12], G, bx);
        { const int i = bx * 512 + tid;
          if (i < 2 * 2 * 5 * D) { const int col = i & 1023, s = (i >> 10) % 5, w = (i / (5 * D)) & 1, l = i / (10 * D);
              Gv[i] = (w == 0 ? norm1_g : norm2_g)[l * D + col] * (1.f + mod[((size_t)l * 5 + s) * 6 * D + (w == 0 ? 1 : 4) * D + col]); } }
        LAS float* tA = (LAS float*)lds; LAS float* tB = (LAS float*)(lds + 20480);
        for (int i = tid; i < 5 * D; i += 512) { const int s5 = i >> 10, col = i & 1023; const float* mp = mod + (size_t)s5 * 6 * D;
            tA[i] = norm1_g[col] * (1.f + mp[D + col]); tB[i] = mp[col]; }
        __syncthreads();
        for (int row0 = gw; row0 < MTOT; row0 += 2 * NGW) {
            const int row1 = row0 + NGW; const bool has1 = row1 < MTOT; const int r1 = has1 ? row1 : row0;
            const float* xr0 = row0 < MLAT ? x + (size_t)row0 * D : ctx + (size_t)(row0 - MLAT) * D;
            const float* xr1 = r1 < MLAT ? x + (size_t)r1 * D : ctx + (size_t)(r1 - MLAT) * D;
            f32x4 v0[4], v1[4]; float ss0 = 0.f, ss1 = 0.f;
#pragma unroll
            for (int j = 0; j < 4; ++j) { v0[j] = ((const f32x4*)xr0)[lane + 64 * j]; v1[j] = ((const f32x4*)xr1)[lane + 64 * j]; }
#pragma unroll
            for (int j = 0; j < 4; ++j) { ss0 += pg8::sq4(v0[j]); ss1 += pg8::sq4(v1[j]); }
            const float ri0 = rsqrtf(wave_sum(ss0) * (1.f / D) + EPS), ri1 = rsqrtf(wave_sum(ss1) * (1.f / D) + EPS);
            const int s0 = row_slot(row0), s1 = row_slot(r1);
#pragma unroll
            for (int j = 0; j < 4; ++j) { const int col = 4 * lane + 256 * j;
                { const f32x4 y = (v0[j] * ri0) * *(const LAS f32x4*)(tA + s0 * D + col) + *(const LAS f32x4*)(tB + s0 * D + col);
                  v2u o; o.x = pk2(y[0], y[1]); o.y = pk2(y[2], y[3]); *(v2u*)(ABUF + (size_t)row0 * D + col) = o; }
                if (has1) { const f32x4 y = (v1[j] * ri1) * *(const LAS f32x4*)(tA + s1 * D + col) + *(const LAS f32x4*)(tB + s1 * D + col);
                  v2u o; o.x = pk2(y[0], y[1]); o.y = pk2(y[2], y[3]); *(v2u*)(ABUF + (size_t)row1 * D + col) = o; }
            }
        }
    }
    SEAM(1);
    const float* mod0 = mod; const float* mod1 = mod + 5 * 6 * D;
#define COMMA ,
#define GEMM_ALL(EPI, Aptr, Btptr, N_, K_, lda_, ...) do { \
        pg8::Gemm g_{Aptr, Btptr, MTOT, N_, K_, lda_, 0, 0}; pg8::StaticOrder S1_; S1_.init(MTOT, N_, G, bx); EPI E1_{__VA_ARGS__}; \
        pg8::gemm_phase<EPI, pg8::StaticOrder, true, true>(lds, g_, S1_, E1_); } while (0)
#define GEMM_LAT_CTX(EPI, Aptr, Btptr, N_, K_, lda_, S_, phase, ...) do { \
        pg8::Gemm g_{Aptr, Btptr, MLAT, N_, K_, lda_, 0, 0}; pg8::StaticOrder S1_; S1_.init(MLAT, N_, G, bx); EPI E1_{__VA_ARGS__}; \
        pg8::gemm_phase<EPI, pg8::StaticOrder, true, true>(lds, g_, S1_, E1_); \
        pg8::CtxTaskOrder S2_; S2_.init(N_, S_, bx); \
        pg8::Gemm g2_{Aptr, Btptr, MTOT, N_, K_, lda_, (K_) / 64 / (S_), (bx % (S_)) * ((K_) / (S_))}; \
        pg8::EpiSplit<EPI, S_> E2_{{__VA_ARGS__}, slab, scnt + (phase) * 128, sflag, bx}; \
        pg8::gemm_phase<pg8::EpiSplit<EPI, S_>, pg8::CtxTaskOrder, true, true>(lds, g2_, S2_, E2_); } while (0)
    float* slab = (float*)(ws + WS_STATE); unsigned* scnt = (unsigned*)(ws + WS_CTL) + 8192; LAS unsigned* sflag = (LAS unsigned*)(lds + MISC_OFF + 256);
    if (IN(2)) {
        GEMM_ALL(pg8::EpiQKV, ABUF, Wqkv_t, 3 * D, D, D, R1, q_gain, k_gain, 0.125f);
        { constexpr int NL = (MTOT / 256) * 12 % 256; if (G == 256 && bx >= NL) convert_weights<1>(a, ws, lds, (bx - NL) * NWAVES + wave, (G - NL) * NWAVES, lane);
          else if (G != 256) convert_weights<1>(a, ws, lds, bx * NWAVES + wave, G * NWAVES, lane); }
    }
    SEAM(2);
#ifndef ATTN_PROBE
#define ATTN_PROBE -1
#endif
    if (IN(3)) {
        if (ATTN_PROBE >= 0) { na::attn_phase<(ATTN_PROBE < 0 ? 0 : ATTN_PROBE)>(lds, R1, (const float*)(ws + WS_BTAB), q_gain, k_gain, (bf16_t*)(ws + 330 * MiB), G, vcu); __syncthreads(); }
        na::attn_phase<0>(lds, R1, (const float*)(ws + WS_BTAB), q_gain, k_gain, ABUF, G, vcu);
    }
    SEAM(3);
    if (IN(4)) {
        pg8::Gemm g{ABUF, Wo0_t, MTOT, D, D, D, 0, 0}; pg8::StaticOrder S; S.init(MTOT, D, G, bx);
        pg8::fill_res_tables(lds + RING_BYTES, S, mod0 + 2 * D, Gv + (0 * 2 + 1) * 5 * D);
        pg8::EpiRes<false, true> E{x, ctx, XRES, XCTX, lds + RING_BYTES, true, R1, part, D, D, 0};
        pg8::gemm_phase<pg8::EpiRes<false, true>, pg8::StaticOrder, true, true>(lds, g, S, E);
        { constexpr int NL = (MTOT / 256) * 4 % 256; const int w_ = G == 256 ? (bx - NL) * NWAVES + wave : bx * NWAVES + wave, nw_ = G == 256 ? (G - NL) * NWAVES : G * NWAVES;
          if (G != 256 || bx >= NL) { convert_weights<2>(a, ws, lds, w_, nw_, lane); bias_gemv(Wfin0_t, 2 * DFF, mod0 + 3 * D, bias_f0, w_, nw_, lane); } }
    }
    SEAM(4);
    bf16_t* A2 = R1; bf16_t* HID = R1 + (size_t)MTOT * D;
    if (IN(5)) {
        pg8::Gemm g{A2, Wfin0_t, MTOT, 2 * DFF, D, D, 0, 0}; pg8::StaticOrder S; S.init(MTOT, 2 * DFF, G, bx);
        pg8::fill_epi_tables(lds + RING_BYTES, S, part, bias_f0, 2 * DFF);
        pg8::EpiSwiglu E{lds + RING_BYTES, HID, DFF, 0};
        pg8::gemm_phase<pg8::EpiSwiglu, pg8::StaticOrder, true, true>(lds, g, S, E);
    }
    SEAM(5);
    if (IN(6)) {
        pg8::Gemm g{HID, Wfout0_t, MTOT, D, DFF, DFF, 0, 0}; pg8::StaticOrder S; S.init(MTOT, D, G, bx);
        pg8::fill_res_tables(lds + RING_BYTES, S, mod0 + 5 * D, Gv + (1 * 2 + 0) * 5 * D);
        pg8::EpiRes<true, true> E{XRES, XCTX, XRES, XCTX, lds + RING_BYTES, true, ABUF, part, D, D, 0};
        pg8::gemm_phase<pg8::EpiRes<true, true>, pg8::StaticOrder, true, true>(lds, g, S, E);
        { constexpr int NL = (MTOT / 256) * 4 % 256; const int w_ = G == 256 ? (bx - NL) * NWAVES + wave : bx * NWAVES + wave, nw_ = G == 256 ? (G - NL) * NWAVES : G * NWAVES;
          if (G != 256 || bx >= NL) { bias_gemv(Whgin_t, 5 * D, mod1, bias_hg, w_, nw_, lane); bias_gemv(Wfin1_t, 2 * DFF, mod1 + 3 * D, bias_f1, w_, nw_, lane); } }
    }
    SEAM(6);
    if (IN(7)) {
        pg8::Gemm g{ABUF, Whgin_t, MTOT, 5 * D, D, D, 0, 0}; pg8::StaticOrder S; S.init(MTOT, 5 * D, G, bx);
        pg8::fill_epi_tables(lds + RING_BYTES, S, part, bias_hg, 5 * D);
        pg8::EpiHg E{lds + RING_BYTES, R1, lbp, 0};
        pg8::gemm_phase<pg8::EpiHg, pg8::StaticOrder, true, true>(lds, g, S, E);
    }
    SEAM(7);
    float* STATE = (float*)(ws + WS_STATE);
#ifndef HG1_PROBE
#define HG1_PROBE -1
#endif
    if (IN(8)) { if (HG1_PROBE >= 0) { hg::phase1<(HG1_PROBE < 0 ? 0 : HG1_PROBE)>(lds, R1, STATE, G, vcu); __syncthreads(); } hg::phase1<0>(lds, R1, STATE, G, vcu); }
    SEAM(8);
    if (IN(9)) { hg::phase2(STATE, G, bx); }
    SEAM(9);
    if (IN(10)) { hg::phase3(lds, R1, STATE, a.in[15], G, vcu, (PROBE_MASK >> 14) && bx == 0 ? MISC + 48 : (volatile LAS unsigned*)nullptr); }
    SEAM(10);
    if (IN(11)) {
        pg8::Gemm g{R1, Whgo_t, MLAT, D, D, D, 0, 0}; pg8::StaticOrder S; S.init(MLAT, D, G, bx);
        pg8::fill_res_tables(lds + RING_BYTES, S, mod1 + 2 * D, Gv + (1 * 2 + 1) * 5 * D);
        pg8::EpiRes<true, true> E{XRES, XCTX, X3, XCTX, lds + RING_BYTES, true, ABUF, part, D, D, 0};
        pg8::gemm_phase<pg8::EpiRes<true, true>, pg8::StaticOrder, true, true>(lds, g, S, E);
    }
    SEAM(11);
    if (IN(12)) {
        pg8::Gemm g{ABUF, Wfin1_t, MLAT, 2 * DFF, D, D, 0, 0}; pg8::StaticOrder S; S.init(MLAT, 2 * DFF, G, bx);
        pg8::fill_epi_tables(lds + RING_BYTES, S, part, bias_f1, 2 * DFF);
        pg8::EpiSwiglu E{lds + RING_BYTES, R1 + (size_t)MTOT * D, DFF, 0};
        pg8::gemm_phase<pg8::EpiSwiglu, pg8::StaticOrder, true, true>(lds, g, S, E);
    }
    SEAM(12);
    if (IN(13)) {
        pg8::Gemm g{R1 + (size_t)MTOT * D, Wfout1_t, MLAT, D, DFF, DFF, 0, 0}; pg8::StaticOrder S; S.init(MLAT, D, G, bx);
        pg8::fill_res_tables(lds + RING_BYTES, S, mod1 + 5 * D, (const float*)nullptr);
        pg8::EpiRes<true, false> E{X3, XCTX, out, XCTX, lds + RING_BYTES, false, nullptr, nullptr, D, D, 0};
        pg8::gemm_phase<pg8::EpiRes<true, false>, pg8::StaticOrder, true, true>(lds, g, S, E);
    }
    if (PROBE_MASK && bx == 0 && tid == 0) {
        MISC[17 + 13] = (unsigned)__builtin_amdgcn_s_memrealtime();
        unsigned extra = 0;
        for (int k = 0; k < 14; ++k) if ((PROBE_MASK >> k) & 1u) extra += MISC[17 + k] - MISC[16 + k];
        if ((PROBE_MASK >> 14) & 1u) extra += MISC[48];
        if ((PROBE_MASK >> 15) & 1u) extra += MISC[49];
        const unsigned t0 = (unsigned)__builtin_amdgcn_s_memrealtime();
        while ((unsigned)__builtin_amdgcn_s_memrealtime() - t0 < extra * PROBE_MUL) __builtin_amdgcn_s_sleep(8);
    }
#undef IN
#undef SEAM
}

extern "C" void kernel_launch(void* const* d_in, const int* in_sizes, int n_in, void* d_out, int out_size, void* d_ws, size_t ws_size, hipStream_t stream) {
    static int grid = 0;
    if (grid == 0) {
        if (n_in != 19 || out_size != MLAT * D || ws_size < WS_END) { fprintf(stderr, "kernel_launch: unexpected sizes n_in %d out %d ws %zu\n", n_in, out_size, ws_size); grid = -1; return; }
        int dev = 0, cus = 0, per_cu = 0;
        if (hipGetDevice(&dev) != hipSuccess || hipDeviceGetAttribute(&cus, hipDeviceAttributeMultiprocessorCount, dev) != hipSuccess) { grid = -1; return; }
        if (hipFuncSetAttribute((const void*)mega, hipFuncAttributeMaxDynamicSharedMemorySize, LDS_BYTES) != hipSuccess) { fprintf(stderr, "kernel_launch: hipFuncSetAttribute failed\n"); grid = -1; return; }
        if (hipOccupancyMaxActiveBlocksPerMultiprocessor(&per_cu, (const void*)mega, NWAVES * 64, LDS_BYTES) != hipSuccess || per_cu < 1) { fprintf(stderr, "kernel_launch: occupancy query says %d blocks per CU\n", per_cu); grid = -1; (void)hipGetLastError(); return; }
        (void)hipGetLastError();
        grid = cus;
    }
    if (grid < 0) return;
    (void)hipMemsetAsync((char*)d_ws + WS_CTL, 0, CTL_ZERO_BYTES, stream);
    Args a{};
    for (int i = 0; i < 19; ++i) a.in[i] = (const float*)d_in[i];
    a.out = (float*)d_out; a.ws = (unsigned char*)d_ws;
    auto run = [&](int lo, int hi) { a.ph_lo = lo; a.ph_hi = hi; hipLaunchKernelGGL(mega, dim3(grid), dim3(NWAVES * 64), LDS_BYTES, stream, a); };
    run(0, 14);
}
```
